# Optimizing an MI355X kernel written in HIP

```python
import jax
import jax.numpy as jnp
from jax import lax
import numpy as np

D_MODEL = 2048
BATCH = 2
SEQ = 8192
DEPTH = 4

SB_HEADS = 8
SB_HEAD_DIM = 128
SB_WIDTH = SB_HEADS * SB_HEAD_DIM
GLA_HEADS = 4
GLA_KEY_DIM = 128
GLA_VAL_DIM = 256
GLA_KEY_WIDTH = GLA_HEADS * GLA_KEY_DIM
GLA_VAL_WIDTH = GLA_HEADS * GLA_VAL_DIM
GLA_GATE_RANK = 16
GLA_GATE_NORM = 16.0
GLA_CHUNK = 64
MLA_HEADS = 16
MLA_Q_RANK = 512
MLA_KV_RANK = 512
MLA_NOPE_DIM = 128
MLA_ROPE_DIM = 64
MLA_V_DIM = 128
MLA_WIDTH = MLA_HEADS * MLA_V_DIM
ROPE_THETA = 10000.0
Q_BLOCK = 128
NORM_EPS = 1e-6

EVEN_SIZES = (SB_WIDTH, SB_WIDTH, SB_WIDTH, SB_WIDTH,
              GLA_KEY_WIDTH, GLA_KEY_WIDTH, GLA_VAL_WIDTH, GLA_VAL_WIDTH, GLA_GATE_RANK)
EVEN_IN = sum(EVEN_SIZES)
EVEN_MIX = SB_WIDTH + GLA_VAL_WIDTH
ODD_SIZES = (MLA_Q_RANK, MLA_KV_RANK, MLA_ROPE_DIM, MLA_WIDTH)
ODD_IN = sum(ODD_SIZES)
N_EVEN = (DEPTH + 1) // 2
N_ODD = DEPTH // 2

kernel_name = 'hybrid_stickbreak_gla_mla_trunk'


def _split_points(sizes):
    return [int(v) for v in np.cumsum(sizes)[:-1]]


def rmsnorm(x, g):
    xf = x.astype(jnp.float32)
    y = xf * lax.rsqrt(jnp.mean(xf * xf, axis=-1, keepdims=True) + NORM_EPS)
    return (y * g.astype(jnp.float32)).astype(x.dtype)


def stick_breaking_attention(q, k, v):
    B, S, H, Dh = q.shape
    nb = S // Q_BLOCK
    scale = Dh ** -0.5
    qb = q.reshape(B, nb, Q_BLOCK, H, Dh).transpose(1, 0, 3, 2, 4)
    kh = k.transpose(0, 2, 1, 3)
    vh = v.transpose(0, 2, 1, 3)
    key_pos = jnp.arange(S)

    def block(args):
        q_blk, blk = args
        q_pos = blk * Q_BLOCK + jnp.arange(Q_BLOCK)
        z = jnp.einsum('bhqd,bhkd->bhqk', q_blk, kh).astype(jnp.float32) * scale
        mask = key_pos[None, :] < q_pos[:, None]
        log_stay = jnp.where(mask, jax.nn.log_sigmoid(-z), 0.0)
        later = lax.cumsum(log_stay, axis=3, reverse=True) - log_stay
        w = jnp.where(mask, jnp.exp(jax.nn.log_sigmoid(z) + later), 0.0)
        return jnp.einsum('bhqk,bhkd->bhqd', w.astype(vh.dtype), vh)

    o = lax.map(block, (qb, jnp.arange(nb)))
    return o.transpose(1, 0, 3, 2, 4).reshape(B, S, H * Dh)


def gla_chunked(q, k, v, log_f):
    B, S, H, Dk = q.shape
    Dv = v.shape[-1]
    C = GLA_CHUNK
    nc = S // C

    def to_chunks(t):
        return t.astype(jnp.float32).reshape(B, nc, C, H, t.shape[-1]).transpose(1, 0, 3, 2, 4)

    qc = to_chunks(q) * (Dk ** -0.5)
    kc, vc, gc = to_chunks(k), to_chunks(v), to_chunks(log_f)
    causal = jnp.tril(jnp.ones((C, C), dtype=bool))[None, None, :, :, None]

    def step(state, inp):
        q_c, k_c, v_c, g_c = inp
        b = jnp.cumsum(g_c, axis=2)
        o_inter = jnp.einsum('bhcd,bhde->bhce', q_c * jnp.exp(b), state)
        diff = b[:, :, :, None, :] - b[:, :, None, :, :]
        decay = jnp.where(causal, jnp.exp(jnp.minimum(diff, 0.0)), 0.0)
        att = jnp.einsum('bhijd,bhjd->bhij', q_c[:, :, :, None, :] * decay, k_c)
        o_intra = jnp.einsum('bhij,bhje->bhie', att, v_c)
        b_last = b[:, :, -1:, :]
        new_state = (jnp.exp(b_last[:, :, 0, :])[..., None] * state
                     + jnp.einsum('bhcd,bhce->bhde', k_c * jnp.exp(b_last - b), v_c))
        return new_state, o_inter + o_intra

    state0 = jnp.zeros((B, H, Dk, Dv), jnp.float32)
    _, o = lax.scan(step, state0, (qc, kc, vc, gc))
    return o.transpose(1, 0, 3, 2, 4).reshape(B, S, H, Dv)


def rope_tables(positions, dim):
    half = dim // 2
    inv = ROPE_THETA ** (-jnp.arange(half, dtype=jnp.float32) / half)
    ang = positions.astype(jnp.float32)[..., None] * inv
    return jnp.cos(ang), jnp.sin(ang)


def apply_rope(x, cos, sin):
    half = x.shape[-1] // 2
    x1, x2 = x[..., :half], x[..., half:]
    cos = cos.astype(x.dtype)
    sin = sin.astype(x.dtype)
    return jnp.concatenate([x1 * cos - x2 * sin, x2 * cos + x1 * sin], axis=-1)


def mla_attention(q_nope, q_rope, k_nope, k_rope, v):
    B, S, H, Dn = q_nope.shape
    Dr = q_rope.shape[-1]
    Dv = v.shape[-1]
    nb = S // Q_BLOCK
    scale = (Dn + Dr) ** -0.5
    qn = q_nope.reshape(B, nb, Q_BLOCK, H, Dn).transpose(1, 0, 3, 2, 4)
    qr = q_rope.reshape(B, nb, Q_BLOCK, H, Dr).transpose(1, 0, 3, 2, 4)
    kn = k_nope.transpose(0, 2, 1, 3)
    vh = v.transpose(0, 2, 1, 3)
    key_pos = jnp.arange(S)

    def block(args):
        qn_b, qr_b, blk = args
        q_pos = blk * Q_BLOCK + jnp.arange(Q_BLOCK)
        s = (jnp.einsum('bhqd,bhkd->bhqk', qn_b, kn)
             + jnp.einsum('bhqd,bkd->bhqk', qr_b, k_rope)).astype(jnp.float32) * scale
        s = jnp.where(key_pos[None, :] <= q_pos[:, None], s, -jnp.inf)
        p = jax.nn.softmax(s, axis=-1)
        return jnp.einsum('bhqk,bhkd->bhqd', p.astype(vh.dtype), vh)

    o = lax.map(block, (qn, qr, jnp.arange(nb)))
    return o.transpose(1, 0, 3, 2, 4).reshape(B, S, H * Dv)


def even_layer(x, norm_g, w_in, alpha_up, alpha_bias, gla_norm_g, w_out):
    B, S, _ = x.shape
    h = rmsnorm(x, norm_g)
    z = h @ w_in
    sb_q, sb_k, sb_v, sb_g, gq, gk, gv, gg, ga = jnp.split(z, _split_points(EVEN_SIZES), axis=-1)
    o_a = stick_breaking_attention(sb_q.reshape(B, S, SB_HEADS, SB_HEAD_DIM),
                                   sb_k.reshape(B, S, SB_HEADS, SB_HEAD_DIM),
                                   sb_v.reshape(B, S, SB_HEADS, SB_HEAD_DIM))
    y_a = o_a * jax.nn.silu(sb_g)
    log_f = jax.nn.log_sigmoid((ga @ alpha_up + alpha_bias).astype(jnp.float32)) / GLA_GATE_NORM
    o_b = gla_chunked(gq.reshape(B, S, GLA_HEADS, GLA_KEY_DIM),
                      gk.reshape(B, S, GLA_HEADS, GLA_KEY_DIM),
                      gv.reshape(B, S, GLA_HEADS, GLA_VAL_DIM),
                      log_f.reshape(B, S, GLA_HEADS, GLA_KEY_DIM))
    o_b = rmsnorm(o_b.astype(x.dtype), gla_norm_g).reshape(B, S, GLA_VAL_WIDTH)
    y_b = o_b * jax.nn.silu(gg)
    y = jnp.concatenate([y_a, y_b], axis=-1) @ w_out
    return x + y


def odd_layer(x, positions, norm_g, w_in, q_norm_g, w_q_up, kv_norm_g, w_kv_up, w_out):
    B, S, _ = x.shape
    h = rmsnorm(x, norm_g)
    q_lat, kv_lat, k_rope, gate = jnp.split(h @ w_in, _split_points(ODD_SIZES), axis=-1)
    cos, sin = rope_tables(positions, MLA_ROPE_DIM)
    q = (rmsnorm(q_lat, q_norm_g) @ w_q_up).reshape(B, S, MLA_HEADS, MLA_NOPE_DIM + MLA_ROPE_DIM)
    q_nope = q[..., :MLA_NOPE_DIM]
    q_rope = apply_rope(q[..., MLA_NOPE_DIM:], cos[:, :, None, :], sin[:, :, None, :])
    kv = (rmsnorm(kv_lat, kv_norm_g) @ w_kv_up).reshape(B, S, MLA_HEADS, MLA_NOPE_DIM + MLA_V_DIM)
    k_nope = kv[..., :MLA_NOPE_DIM]
    v = kv[..., MLA_NOPE_DIM:]
    k_rope = apply_rope(k_rope, cos, sin)
    o = mla_attention(q_nope, q_rope, k_nope, k_rope, v)
    y = (o * jax.nn.silu(gate)) @ w_out
    return x + y


def setup_inputs(seed: int = 0) -> dict:
    key = jax.random.key(seed)
    ks = jax.random.split(key, 20)
    f32 = jnp.float32

    def dense(k, shape, fan_in):
        return jax.random.normal(k, shape, f32) * (fan_in ** -0.5)

    def gain(k, shape):
        return 1.0 + 0.02 * jax.random.normal(k, shape, f32)

    x = jax.random.normal(ks[0], (BATCH, SEQ, D_MODEL), f32)
    offset = jax.random.randint(ks[1], (BATCH, 1), 0, 1024, dtype=jnp.int32)
    positions = jnp.arange(SEQ, dtype=jnp.int32)[None, :] + offset
    return {
        'x': x,
        'positions': positions,
        'ln_even': gain(ks[2], (N_EVEN, D_MODEL)),
        'w_in_even': dense(ks[3], (N_EVEN, D_MODEL, EVEN_IN), D_MODEL),
        'gla_alpha_up': dense(ks[4], (N_EVEN, GLA_GATE_RANK, GLA_KEY_WIDTH), GLA_GATE_RANK),
        'gla_alpha_bias': 0.1 * jax.random.normal(ks[5], (N_EVEN, GLA_KEY_WIDTH), f32),
        'gla_norm': gain(ks[6], (N_EVEN, GLA_VAL_DIM)),
        'w_out_even': dense(ks[7], (N_EVEN, EVEN_MIX, D_MODEL), EVEN_MIX),
        'ln_odd': gain(ks[8], (N_ODD, D_MODEL)),
        'w_in_odd': dense(ks[9], (N_ODD, D_MODEL, ODD_IN), D_MODEL),
        'q_norm': gain(ks[10], (N_ODD, MLA_Q_RANK)),
        'w_q_up': dense(ks[11], (N_ODD, MLA_Q_RANK, MLA_HEADS * (MLA_NOPE_DIM + MLA_ROPE_DIM)), MLA_Q_RANK),
        'kv_norm': gain(ks[12], (N_ODD, MLA_KV_RANK)),
        'w_kv_up': dense(ks[13], (N_ODD, MLA_KV_RANK, MLA_HEADS * (MLA_NOPE_DIM + MLA_V_DIM)), MLA_KV_RANK),
        'w_out_odd': dense(ks[14], (N_ODD, MLA_WIDTH, D_MODEL), MLA_WIDTH),
        'final_norm': gain(ks[15], (D_MODEL,)),
    }


def reference(x, positions, ln_even, w_in_even, gla_alpha_up, gla_alpha_bias, gla_norm, w_out_even,
              ln_odd, w_in_odd, q_norm, w_q_up, kv_norm, w_kv_up, w_out_odd, final_norm):
    for layer in range(DEPTH):
        i = layer // 2
        if layer % 2 == 0:
            x = even_layer(x, ln_even[i], w_in_even[i], gla_alpha_up[i], gla_alpha_bias[i],
                           gla_norm[i], w_out_even[i])
        else:
            x = odd_layer(x, positions, ln_odd[i], w_in_odd[i], q_norm[i], w_q_up[i],
                          kv_norm[i], w_kv_up[i], w_out_odd[i])
    return rmsnorm(x, final_norm)
```

```cpp
#include <hip/hip_runtime.h>
#include <hip/hip_cooperative_groups.h>
#include <cstdio>
#include <cstdint>
#include <type_traits>
namespace cg = cooperative_groups;

#ifndef ONE_LAUNCH
#define ONE_LAUNCH 1
#endif

#ifndef REPEAT_MASK
#define REPEAT_MASK 0
#endif
#ifndef PROBE_MODE
#define PROBE_MODE 0
#endif
#ifndef PH_MASK
#define PH_MASK 0xFFFF
#endif
#define DI __device__ __forceinline__
typedef unsigned short u16;
using bf16x8 = __attribute__((ext_vector_type(8))) short;
using s16x4  = __attribute__((ext_vector_type(4))) short;
using f32x16 = __attribute__((ext_vector_type(16))) float;
using u32x4  = __attribute__((ext_vector_type(4))) unsigned;
using u32x2  = __attribute__((ext_vector_type(2))) unsigned;
#define MFMA32(a, b, c) __builtin_amdgcn_mfma_f32_32x32x16_bf16((a), (b), (c), 0, 0, 0)

constexpr int S_ = 8192;
constexpr int T_ = 16384;
constexpr size_t MiB = (size_t)1 << 20;

constexpr size_t OFF_WL = 0;
constexpr size_t OFF_H  = 40 * MiB;
constexpr size_t OFF_L  = 104 * MiB;
constexpr size_t E_SQ  = OFF_L + 0 * MiB;
constexpr size_t E_SK  = OFF_L + 32 * MiB;
constexpr size_t E_SVT = OFF_L + 64 * MiB;
constexpr size_t E_SG  = OFF_L + 96 * MiB;
constexpr size_t E_GQ  = OFF_L + 128 * MiB;
constexpr size_t E_GK  = OFF_L + 144 * MiB;
constexpr size_t E_GVT = OFF_L + 160 * MiB;
constexpr size_t E_GG  = OFF_L + 192 * MiB;
constexpr size_t E_GA  = OFF_L + 224 * MiB;
constexpr size_t E_EBL = OFF_L + 225 * MiB;
constexpr size_t E_SC  = OFF_L + 226 * MiB;
constexpr size_t O_QL   = OFF_L + 0 * MiB;
constexpr size_t O_KVL  = OFF_L + 16 * MiB;
constexpr size_t O_GATE = OFF_L + 32 * MiB;
constexpr size_t O_KR   = OFF_L + 96 * MiB;
constexpr size_t O_RSQ  = OFF_L + 98 * MiB;
constexpr size_t O_RSKV = OFF_L + 98 * MiB + 65536;
constexpr size_t O_QN   = OFF_L + 99 * MiB;
constexpr size_t O_QR   = OFF_L + 163 * MiB;
constexpr size_t O_KN   = OFF_L + 195 * MiB;
constexpr size_t O_VT   = OFF_L + 259 * MiB;
constexpr size_t OFF_COS = 460 * MiB;
constexpr size_t OFF_SIN = 462 * MiB;
constexpr size_t OFF_CTR = 464 * MiB;
constexpr size_t OFF_BAR = 464 * MiB + 1024;
constexpr size_t WS_NEED = 465 * MiB;

constexpr size_t WE_IN = 0;
constexpr size_t WE_OUT = (size_t)7168 * 2048;
constexpr size_t WO_IN = 0;
constexpr size_t WO_Q = (size_t)3328 * 2048;
constexpr size_t WO_KV = WO_Q + (size_t)3072 * 512;
constexpr size_t WO_OUT = WO_KV + (size_t)4096 * 512;

constexpr int NPHASE = 25;
constexpr int SMEM_BYTES = 147456;

struct Params {
  const float* x; const int* pos;
  const float* ln_even; const float* w_in_even; const float* alpha_up; const float* alpha_bias;
  const float* gla_norm; const float* w_out_even;
  const float* ln_odd; const float* w_in_odd; const float* q_norm; const float* w_q_up;
  const float* kv_norm; const float* w_kv_up; const float* w_out_odd;
  const float* final_norm;
  float* out; unsigned char* ws;
};

DI unsigned pack_bf16(float a, float b) {
  typedef __bf16 bf2 __attribute__((ext_vector_type(2)));
  typedef float f2 __attribute__((ext_vector_type(2)));
  f2 v = {a, b};
  bf2 r = __builtin_convertvector(v, bf2);
  return __builtin_bit_cast(unsigned, r);
}
DI u16 to_bf16(float a) { return (u16)(pack_bf16(a, 0.f) & 0xffffu); }
DI float bf_lo(unsigned w) { return __uint_as_float(w << 16); }
DI float bf_hi(unsigned w) { return __uint_as_float(w & 0xffff0000u); }
DI int TIDX() { int t = __builtin_amdgcn_workitem_id_x(); asm volatile("" : "+v"(t)); return t; }
DI int crow(int reg, int h) { return (reg & 3) + 8 * (reg >> 2) + 4 * h; }
DI float xh_max(float x) {
  const auto r = __builtin_amdgcn_permlane32_swap(__float_as_uint(x), __float_as_uint(x), false, false);
  return fmaxf(__uint_as_float(r[0]), __uint_as_float(r[1]));
}
DI float xh_sum(float x) {
  const auto r = __builtin_amdgcn_permlane32_swap(__float_as_uint(x), __float_as_uint(x), false, false);
  return __uint_as_float(r[0]) + __uint_as_float(r[1]);
}
DI float xh_partner(float x, int h) {
  const auto r = __builtin_amdgcn_permlane32_swap(__float_as_uint(x), __float_as_uint(x), false, false);
  return h ? __uint_as_float(r[0]) : __uint_as_float(r[1]);
}
DI void lds_barrier() {
  asm volatile("s_waitcnt lgkmcnt(0)" ::: "memory");
  __builtin_amdgcn_s_barrier();
  asm volatile("" ::: "memory");
}
DI float wave_sum(float v) {
  v = xh_sum(v); v += __shfl_xor(v, 16); v += __shfl_xor(v, 8);
  v += __shfl_xor(v, 4);  v += __shfl_xor(v, 2);  v += __shfl_xor(v, 1);
  return v;
}
DI float silu_f(float v) { return v * __builtin_amdgcn_rcpf(1.f + __expf(-v)); }
DI bf16x8 pack8(const f32x16& x, int s) {
  u32x4 p;
  p[0] = pack_bf16(x[8 * s + 0], x[8 * s + 1]);
  p[1] = pack_bf16(x[8 * s + 2], x[8 * s + 3]);
  p[2] = pack_bf16(x[8 * s + 4], x[8 * s + 5]);
  p[3] = pack_bf16(x[8 * s + 6], x[8 * s + 7]);
  return __builtin_bit_cast(bf16x8, p);
}

DI void convert_tile(const float* __restrict__ src, int ldn, const float* __restrict__ gain,
                     u16* __restrict__ dst, int K, int k0, int nd0, int ns0, int nvalid, float* lds) {
  const int tid = TIDX();
  const int c = tid & 63, r0 = tid >> 6;
#pragma unroll
  for (int i = 0; i < 8; ++i) {
    const int r = r0 + 8 * i;
    float v = 0.f;
    if (c < nvalid) {
      v = src[(size_t)(k0 + r) * ldn + ns0 + c];
      if (gain) v *= gain[k0 + r];
    }
    lds[r * 65 + c] = v;
  }
  __syncthreads();
  const int kk = (tid & 31) * 2, n = tid >> 5;
#pragma unroll
  for (int i = 0; i < 4; ++i) {
    const int nn = n + 16 * i;
    const unsigned pk = pack_bf16(lds[kk * 65 + nn], lds[(kk + 1) * 65 + nn]);
    *(unsigned*)(dst + (size_t)(nd0 + nn) * K + k0 + kk) = pk;
  }
  __syncthreads();
}

DI int src_col(int mode, int nd) {
  if (mode == 0) return nd;
  if (mode == 1) return nd < 1024 ? nd : (nd < 3072 ? nd + 64 : (nd < 3136 ? nd - 2048 : -1));
  if (mode == 2) return nd < 2048 ? (nd >> 7) * 192 + (nd & 127) : ((nd - 2048) >> 6) * 192 + 128;
  return nd < 2048 ? (nd >> 7) * 256 + (nd & 127) : ((nd - 2048) >> 7) * 256 + 128 + ((nd - 2048) & 127);
}
DI void convert_tile256(const float* __restrict__ src, int ldn, const float* __restrict__ gain,
                        u16* __restrict__ dst, int K, int k0, int nd0, int mode, float* lds) {
  constexpr int LDW = 260;
  const int tid = TIDX();
  {
    const int col4 = tid & 63, row0 = tid >> 6;
    const int nd = nd0 + col4 * 4;
    const int sc = src_col(mode, nd & ~63);
    const float* sp = src + (size_t)(k0 + row0) * ldn + (sc + (nd & 63));
#pragma unroll
    for (int i = 0; i < 8; ++i) {
      float z = 0.f;
      asm volatile("" : "+v"(z));
      float4 v = make_float4(z, z, z, z);
      if (sc >= 0) {
        v = *(const float4*)(sp + (size_t)(8 * i) * ldn);
        if (gain) { const float gg = gain[k0 + row0 + 8 * i]; v.x *= gg; v.y *= gg; v.z *= gg; v.w *= gg; }
      }
      *(float4*)(lds + (row0 + 8 * i) * LDW + col4 * 4) = v;
    }
  }
  lds_barrier();
  {
    const int kc = tid & 7;
#pragma unroll
    for (int j = 0; j < 4; ++j) {
      const int n = (tid >> 3) + 64 * j;
      const float* lp = lds + (kc * 8) * LDW + n;
      u32x4 pk;
      pk[0] = pack_bf16(lp[0 * LDW], lp[1 * LDW]);
      pk[1] = pack_bf16(lp[2 * LDW], lp[3 * LDW]);
      pk[2] = pack_bf16(lp[4 * LDW], lp[5 * LDW]);
      pk[3] = pack_bf16(lp[6 * LDW], lp[7 * LDW]);
      *(u32x4*)(dst + (size_t)(nd0 + n) * K + k0 + kc * 8) = pk;
    }
  }
  lds_barrier();
}

template <bool GA>
DI void norm_row(const float* __restrict__ xrow, const float* __restrict__ g, u16* __restrict__ hrow,
                 float* __restrict__ orow, const float* wg, float* __restrict__ garow) {
  const int lane = TIDX() & 63;
  float4 v[8];
  float ss = 0.f;
#pragma unroll
  for (int i = 0; i < 8; ++i) {
    v[i] = ((const float4*)xrow)[lane + 64 * i];
    ss += v[i].x * v[i].x + v[i].y * v[i].y + v[i].z * v[i].z + v[i].w * v[i].w;
  }
  ss = wave_sum(ss);
  const float rstd = rsqrtf(ss * (1.f / 2048.f) + 1e-6f);
  float ga[16];
  if constexpr (GA) {
#pragma unroll
    for (int c = 0; c < 16; ++c) ga[c] = 0.f;
  }
#pragma unroll
  for (int i = 0; i < 8; ++i) {
    const float4 gg = ((const float4*)g)[lane + 64 * i];
    const float a = v[i].x * rstd * gg.x, b = v[i].y * rstd * gg.y, c = v[i].z * rstd * gg.z, d = v[i].w * rstd * gg.w;
    if (hrow) {
      u32x2 o; o[0] = pack_bf16(a, b); o[1] = pack_bf16(c, d);
      ((u32x2*)hrow)[lane + 64 * i] = o;
    } else {
      ((float4*)orow)[lane + 64 * i] = make_float4(a, b, c, d);
    }
    if constexpr (GA) {
#pragma unroll
      for (int cc = 0; cc < 16; ++cc) {
        const float4 w = ((const float4*)(wg + cc * 2052))[lane + 64 * i];
        ga[cc] += a * w.x + b * w.y + c * w.z + d * w.w;
      }
    }
  }
  if constexpr (GA) {
    float mine = 0.f;
#pragma unroll
    for (int cc = 0; cc < 16; ++cc) {
      const float t = wave_sum(ga[cc]);
      if (lane == cc) mine = t;
    }
    if (lane < 16) garow[lane] = mine;
  }
}

enum { M_BF16 = 0, M_SILU = 1, M_TRANS = 2, M_ROPE = 4, M_RESID = 5 };
struct GemmT {
  const u16* A; const u16* B; int lda, ldb, K;
  int mode, R0, C0, ld, aux, nact, probe, perm;
  u16* d16; float* d32; float scale; const float* rs; const float* xin; const float* cs; const float* sn;
};
constexpr int LDT = 72;

DI void gemm_tile(const GemmT& g, unsigned char* smem) {
  const int tid = TIDX(), lane = tid & 63, wave = tid >> 6;
  const int wm = (wave >> 2) * 128, wn = (wave & 3) * 64;
  const int r = lane & 31, h = lane >> 5;
  u16* sA = (u16*)smem;
  u16* sB = sA + 2 * 256 * LDT;
  const int lrow = tid >> 3, lch = (tid & 7) * 8;
  const u16* Ag = g.A + (size_t)lrow * g.lda + lch;
  const u16* Bg = g.B + (size_t)lrow * g.ldb + lch;
  const bool active = wm < g.nact;
  u32x4 ra[4], rb[4];
  f32x16 acc[4][2];
#pragma unroll
  for (int i = 0; i < 4; ++i)
#pragma unroll
    for (int j = 0; j < 2; ++j)
#pragma unroll
      for (int q = 0; q < 16; ++q) acc[i][j][q] = 0.f;

#pragma unroll
  for (int i = 0; i < 4; ++i) {
    ra[i] = *(const u32x4*)(Ag + (size_t)(64 * i) * g.lda);
    rb[i] = *(const u32x4*)(Bg + (size_t)(64 * i) * g.ldb);
  }
  __syncthreads();
#pragma unroll
  for (int i = 0; i < 4; ++i) {
    *(u32x4*)(sA + (lrow + 64 * i) * LDT + lch) = ra[i];
    *(u32x4*)(sB + (lrow + 64 * i) * LDT + lch) = rb[i];
  }
#pragma unroll
  for (int i = 0; i < 4; ++i) {
    ra[i] = *(const u32x4*)(Ag + (size_t)(64 * i) * g.lda + 64);
    rb[i] = *(const u32x4*)(Bg + (size_t)(64 * i) * g.ldb + 64);
  }
  __syncthreads();
  const int KT = g.K >> 6;
  for (int kt = 0; kt < KT; ++kt) {
    if (kt + 1 < KT) {
      u16* a_d = sA + ((kt + 1) & 1) * 256 * LDT;
      u16* b_d = sB + ((kt + 1) & 1) * 256 * LDT;
#pragma unroll
      for (int i = 0; i < 4; ++i) {
        *(u32x4*)(a_d + (lrow + 64 * i) * LDT + lch) = ra[i];
        *(u32x4*)(b_d + (lrow + 64 * i) * LDT + lch) = rb[i];
      }
    }
    if (kt + 2 < KT && !(PROBE_MODE == 1 && g.probe)) {
#pragma unroll
      for (int i = 0; i < 4; ++i) {
        ra[i] = *(const u32x4*)(Ag + (size_t)(64 * i) * g.lda + (kt + 2) * 64);
        rb[i] = *(const u32x4*)(Bg + (size_t)(64 * i) * g.ldb + (kt + 2) * 64);
      }
    }
    __builtin_amdgcn_sched_barrier(0);
    if (active) {
      const u16* a_s = sA + (kt & 1) * 256 * LDT + (wm + r) * LDT + 8 * h;
      const u16* b_s = sB + (kt & 1) * 256 * LDT + (wn + r) * LDT + 8 * h;
#pragma unroll
      for (int ks = 0; ks < 4; ++ks) {
        bf16x8 af[4], bf[2];
#pragma unroll
        for (int i = 0; i < 4; ++i) af[i] = *(const bf16x8*)(a_s + 32 * i * LDT + ks * 16);
#pragma unroll
        for (int j = 0; j < 2; ++j) bf[j] = *(const bf16x8*)(b_s + 32 * j * LDT + ks * 16);
#pragma unroll
        for (int i = 0; i < 4; ++i)
#pragma unroll
          for (int j = 0; j < 2; ++j) acc[i][j] = MFMA32(af[i], bf[j], acc[i][j]);
      }
    }
    __syncthreads();
  }
  if (!active) return;
  if (PROBE_MODE && g.probe) {
    float sacc = 0.f;
#pragma unroll
    for (int i = 0; i < 4; ++i)
#pragma unroll
      for (int j = 0; j < 2; ++j)
#pragma unroll
        for (int q = 0; q < 16; ++q) sacc += acc[i][j][q];
    if (sacc == 1.2345e-30f) g.d16[0] = 0;
    return;
  }

  const int mode = g.mode;
  if (mode == M_ROPE) {
#pragma unroll
    for (int j = 0; j < 2; ++j) {
      const int tok = g.C0 + wn + 32 * j + r;
      const float sc = g.scale * (g.rs ? g.rs[tok] : 1.f);
#pragma unroll
      for (int ip = 0; ip < 2; ++ip) {
        if (wm + 64 * ip < g.aux) {
#pragma unroll
          for (int g4 = 0; g4 < 4; ++g4) {
            const int c0 = 8 * g4 + 4 * h;
            const float4 cs = *(const float4*)(g.cs + (size_t)tok * 32 + c0);
            const float4 sn = *(const float4*)(g.sn + (size_t)tok * 32 + c0);
            const float a0 = acc[2 * ip][j][4 * g4 + 0] * sc, a1 = acc[2 * ip][j][4 * g4 + 1] * sc;
            const float a2 = acc[2 * ip][j][4 * g4 + 2] * sc, a3 = acc[2 * ip][j][4 * g4 + 3] * sc;
            const float b0 = acc[2 * ip + 1][j][4 * g4 + 0] * sc, b1 = acc[2 * ip + 1][j][4 * g4 + 1] * sc;
            const float b2 = acc[2 * ip + 1][j][4 * g4 + 2] * sc, b3 = acc[2 * ip + 1][j][4 * g4 + 3] * sc;
            u32x2 o1, o2;
            o1[0] = pack_bf16(a0 * cs.x - b0 * sn.x, a1 * cs.y - b1 * sn.y);
            o1[1] = pack_bf16(a2 * cs.z - b2 * sn.z, a3 * cs.w - b3 * sn.w);
            o2[0] = pack_bf16(b0 * cs.x + a0 * sn.x, b1 * cs.y + a1 * sn.y);
            o2[1] = pack_bf16(b2 * cs.z + a2 * sn.z, b3 * cs.w + a3 * sn.w);
            u16* dp = g.d16 + (size_t)tok * g.ld + g.R0 + wm + 64 * ip + c0;
            *(u32x2*)dp = o1;
            *(u32x2*)(dp + 32) = o2;
          }
        }
      }
    }
    return;
  }
  unsigned char* wreg = smem + wave * 17408;
  if (mode == M_RESID) {
#pragma unroll
    for (int j = 0; j < 2; ++j) {
#pragma unroll
      for (int i = 0; i < 4; ++i)
#pragma unroll
        for (int g4 = 0; g4 < 4; ++g4)
          *(float4*)(wreg + r * 528 + (32 * i + 8 * g4 + 4 * h) * 4) =
              make_float4(acc[i][j][4 * g4 + 0], acc[i][j][4 * g4 + 1], acc[i][j][4 * g4 + 2], acc[i][j][4 * g4 + 3]);
#pragma unroll
      for (int it = 0; it < 16; ++it) {
        const int row = 2 * it + h;
        const float4 v = *(const float4*)(wreg + row * 528 + r * 16);
        const size_t o = (size_t)(g.C0 + wn + 32 * j + row) * 2048 + g.R0 + wm + r * 4;
        const float4 x = *(const float4*)(g.xin + o);
        *(float4*)(g.d32 + o) = make_float4(x.x + v.x, x.y + v.y, x.z + v.z, x.w + v.w);
      }
    }
    return;
  }
#pragma unroll
  for (int j = 0; j < 2; ++j) {
    const int outer = g.C0 + wn + 32 * j + r;
    const float sc = (mode == M_BF16) ? g.scale * (g.rs ? g.rs[outer] : 1.f) : 1.f;
#pragma unroll
    for (int i = 0; i < 4; ++i)
#pragma unroll
      for (int g4 = 0; g4 < 4; ++g4) {
        float v0 = acc[i][j][4 * g4 + 0], v1 = acc[i][j][4 * g4 + 1], v2 = acc[i][j][4 * g4 + 2], v3 = acc[i][j][4 * g4 + 3];
        if (mode == M_BF16) { v0 *= sc; v1 *= sc; v2 *= sc; v3 *= sc; }
        else if (mode == M_SILU) { v0 = silu_f(v0); v1 = silu_f(v1); v2 = silu_f(v2); v3 = silu_f(v3); }
        else if (g.rs) {
          const float4 r4 = *(const float4*)(g.rs + g.R0 + wm + 32 * i + 8 * g4 + 4 * h);
          v0 *= r4.x; v1 *= r4.y; v2 *= r4.z; v3 *= r4.w;
        }
        u32x2 pk; pk[0] = pack_bf16(v0, v1); pk[1] = pack_bf16(v2, v3);
        *(u32x2*)(wreg + (32 * j + r) * 272 + (32 * i + 8 * g4 + 4 * h) * 2) = pk;
      }
  }
  {
    const int inner0 = g.R0 + wm;
#pragma unroll
    for (int it = 0; it < 16; ++it) {
      const int row = 4 * it + (lane >> 4), ch = lane & 15;
      const u32x4 v = *(const u32x4*)(wreg + row * 272 + ch * 16);
      const int outer = g.C0 + wn + row;
      size_t o;
      if (mode == M_TRANS) o = ((size_t)(inner0 >> 13) * g.aux + outer) * 8192 + (inner0 & 8191);
      else o = (size_t)outer * g.ld + inner0;
      *(u32x4*)(g.d16 + o + ch * 8) = v;
    }
  }
}

using f32x4v = __attribute__((ext_vector_type(4))) float;
DI int lds_byte8(int r, int c) {
  const int st = (r >> 4) * 2 + (c >> 5), rr = r & 15, cc = c & 31, ob = rr * 64 + cc * 2;
  return st * 1024 + (ob ^ (((ob >> 9) & 1) << 5));
}
DI void stage_rc8(int b, int& R, int& C) {
  const int st = b / 1024, sb = b % 1024, swz = sb ^ (((sb >> 9) & 1) << 5);
  R = (st >> 1) * 16 + swz / 64; C = (st & 1) * 32 + (swz % 64) / 2;
}
DI void gemm_tile8(const GemmT& g, unsigned char* smem) {
  constexpr int BK = 64, HALF = 128, HT = HALF * BK;
  u16* shm = (u16*)smem;
  const u16* A = g.A; const u16* Bt = g.B; const int K = g.K;
  const int tid = TIDX();
  #define SA8(b,h) (shm+((b)*2+(h))*HT)
  #define SB8(b,h) (shm+(4+(b)*2+(h))*HT)
  unsigned soff0, soff1;
  { int r_, c_; stage_rc8(tid * 16, r_, c_); soff0 = (unsigned)(r_ * K + c_); stage_rc8(tid * 16 + 8192, r_, c_); soff1 = (unsigned)(r_ * K + c_); }
  #define STAGE8(P,BASE,br,kt) do{ const u16* _gb = (BASE) + ((long)(br)*K+(long)(kt)*BK); \
      __builtin_amdgcn_global_load_lds((const unsigned*)(_gb + soff0), (unsigned*)((char*)(P)+tid*16),16,0,0); \
      __builtin_amdgcn_global_load_lds((const unsigned*)(_gb + soff1), (unsigned*)((char*)(P)+tid*16+8192),16,0,0); }while(0)
  #define LDA8(dst,b,h) _Pragma("unroll") for(int m=0;m<4;++m) _Pragma("unroll") for(int k=0;k<2;++k) \
    dst[m][k]=*reinterpret_cast<const bf16x8*>((const char*)SA8(b,h)+lds_byte8(wr*64+m*16+fr,k*32+fq*8))
  #define LDB8(dst,b,h) _Pragma("unroll") for(int n=0;n<2;++n) _Pragma("unroll") for(int k=0;k<2;++k) \
    dst[n][k]=*reinterpret_cast<const bf16x8*>((const char*)SB8(b,h)+lds_byte8(wc*32+n*16+fr,k*32+fq*8))
  #define MMA8(ai,bj,At_,Bt_) do{__builtin_amdgcn_s_setprio(1); \
    _Pragma("unroll") for(int m=0;m<4;++m) _Pragma("unroll") for(int n=0;n<2;++n) _Pragma("unroll") for(int k=0;k<2;++k) \
      acc[ai][bj][m][n]=__builtin_amdgcn_mfma_f32_16x16x32_bf16(At_[m][k],Bt_[n][k],acc[ai][bj][m][n],0,0,0); \
    __builtin_amdgcn_s_setprio(0);}while(0)
  #define WAIT_V8(n) asm volatile("s_waitcnt vmcnt(" #n ")":::"memory")
  #define WAIT_L8(n) asm volatile("s_waitcnt lgkmcnt(" #n ")":::"memory")
  #define BAR8 __builtin_amdgcn_s_barrier()
  #define SCHED8 __builtin_amdgcn_sched_barrier(0)
  f32x4v acc[2][2][4][2];
#pragma unroll
  for (int a = 0; a < 2; ++a)
#pragma unroll
    for (int b = 0; b < 2; ++b)
#pragma unroll
      for (int m = 0; m < 4; ++m)
#pragma unroll
        for (int n = 0; n < 2; ++n) acc[a][b][m][n] = f32x4v{0.f, 0.f, 0.f, 0.f};
  {
  const int wid = tid >> 6, lane = tid & 63, wr = wid >> 2, wc = wid & 3, fr = lane & 15, fq = lane >> 4;
  bf16x8 At[4][2], B0[2][2], B1[2][2];
  const int nt = K / BK;
  asm volatile("s_waitcnt lgkmcnt(0)" ::: "memory");
  __builtin_amdgcn_s_barrier();
  STAGE8(SB8(0,0),Bt,0,0); STAGE8(SA8(0,0),A,0,0);
  STAGE8(SB8(0,1),Bt,HALF,0); STAGE8(SA8(0,1),A,HALF,0);
  if (wr == 1) BAR8;
  WAIT_V8(4); BAR8;
  STAGE8(SB8(1,0),Bt,0,1); STAGE8(SA8(1,0),A,0,1); STAGE8(SB8(1,1),Bt,HALF,1);
  WAIT_V8(6); BAR8;
  for (int t = 0; t < nt - 2; t += 2) {
    LDB8(B0,0,0); SCHED8; LDA8(At,0,0); STAGE8(SA8(1,1),A,HALF,t+1);
    WAIT_L8(8); BAR8; WAIT_L8(0); MMA8(0,0,At,B0); BAR8; SCHED8;
    LDB8(B1,0,1); STAGE8(SB8(0,0),Bt,0,t+2);
    BAR8; WAIT_L8(0); MMA8(0,1,At,B1); BAR8;
    LDA8(At,0,1); STAGE8(SA8(0,0),A,0,t+2);
    BAR8; WAIT_L8(0); MMA8(1,0,At,B0); BAR8; SCHED8;
    STAGE8(SB8(0,1),Bt,HALF,t+2);
    WAIT_V8(6); BAR8; MMA8(1,1,At,B1); BAR8;
    LDB8(B0,1,0); SCHED8; LDA8(At,1,0); STAGE8(SA8(0,1),A,HALF,t+2);
    WAIT_L8(8); BAR8; WAIT_L8(0); MMA8(0,0,At,B0); BAR8; SCHED8;
    LDB8(B1,1,1); STAGE8(SB8(1,0),Bt,0,t+3);
    BAR8; WAIT_L8(0); MMA8(0,1,At,B1); BAR8;
    LDA8(At,1,1); STAGE8(SA8(1,0),A,0,t+3);
    BAR8; WAIT_L8(0); MMA8(1,0,At,B0); BAR8; SCHED8;
    STAGE8(SB8(1,1),Bt,HALF,t+3);
    WAIT_V8(6); BAR8; MMA8(1,1,At,B1); BAR8;
  }
  { LDB8(B0,0,0); LDA8(At,0,0); STAGE8(SA8(1,1),A,HALF,nt-1);
    BAR8; WAIT_L8(0); MMA8(0,0,At,B0); BAR8;
    LDB8(B1,0,1); BAR8; WAIT_L8(0); MMA8(0,1,At,B1); BAR8;
    LDA8(At,0,1); WAIT_V8(4); BAR8; WAIT_L8(0); MMA8(1,0,At,B0); MMA8(1,1,At,B1); BAR8; }
  { LDB8(B0,1,0); LDA8(At,1,0); WAIT_V8(2); BAR8; WAIT_L8(0); MMA8(0,0,At,B0); BAR8;
    LDB8(B1,1,1); WAIT_V8(0); BAR8; WAIT_L8(0); MMA8(0,1,At,B1); BAR8;
    LDA8(At,1,1); BAR8; WAIT_L8(0); MMA8(1,0,At,B0); MMA8(1,1,At,B1); BAR8; }
  if (wr == 0) BAR8;
  }

  const int mode = g.mode;
  unsigned char* wreg;
  int lane, wr, wc, fr, fq;
  { const int t2 = TIDX(); const int w2 = t2 >> 6; lane = t2 & 63; wr = w2 >> 2; wc = w2 & 3; fr = lane & 15; fq = lane >> 4; wreg = smem + w2 * 17408; }
  if (mode == M_RESID) {
#pragma unroll
    for (int bj = 0; bj < 2; ++bj) {
#pragma unroll
      for (int ai = 0; ai < 2; ++ai)
#pragma unroll
        for (int m = 0; m < 4; ++m)
#pragma unroll
          for (int n = 0; n < 2; ++n)
            *(f32x4v*)(wreg + (n * 16 + fr) * 528 + (ai * 64 + m * 16 + fq * 4) * 4) = acc[ai][bj][m][n];
#pragma unroll
      for (int it = 0; it < 16; ++it) {
        const int row = 2 * it + (lane >> 5), c4 = lane & 31;
        const float4 v = *(const float4*)(wreg + row * 528 + c4 * 16);
        const int ai = c4 >> 4, iin = (c4 & 15) * 4;
        const size_t o = (size_t)(g.C0 + bj * 128 + wc * 32 + row) * 2048 + g.R0 + ai * 128 + wr * 64 + iin;
        const float4 x = *(const float4*)(g.xin + o);
        *(float4*)(g.d32 + o) = make_float4(x.x + v.x, x.y + v.y, x.z + v.z, x.w + v.w);
      }
    }
    return;
  }
  if (mode == M_ROPE) {
#pragma unroll
    for (int bj = 0; bj < 2; ++bj)
#pragma unroll
      for (int n = 0; n < 2; ++n) {
        const int tok = g.C0 + bj * 128 + wc * 32 + n * 16 + fr;
        const float sc = g.scale * (g.rs ? g.rs[tok] : 1.f);
#pragma unroll
        for (int ai = 0; ai < 2; ++ai) {
          if (ai * 128 + wr * 64 < g.aux) {
#pragma unroll
            for (int m = 0; m < 2; ++m) {
              const int c0 = m * 16 + fq * 4;
              const float4 cs = *(const float4*)(g.cs + (size_t)tok * 32 + c0);
              const float4 sn = *(const float4*)(g.sn + (size_t)tok * 32 + c0);
              const f32x4v a = acc[ai][bj][m][n] * sc, b = acc[ai][bj][m + 2][n] * sc;
              u32x2 o1, o2;
              o1[0] = pack_bf16(a[0] * cs.x - b[0] * sn.x, a[1] * cs.y - b[1] * sn.y);
              o1[1] = pack_bf16(a[2] * cs.z - b[2] * sn.z, a[3] * cs.w - b[3] * sn.w);
              o2[0] = pack_bf16(b[0] * cs.x + a[0] * sn.x, b[1] * cs.y + a[1] * sn.y);
              o2[1] = pack_bf16(b[2] * cs.z + a[2] * sn.z, b[3] * cs.w + a[3] * sn.w);
              u16* dp = g.d16 + (size_t)tok * g.ld + g.R0 + ai * 128 + wr * 64 + c0;
              *(u32x2*)dp = o1;
              *(u32x2*)(dp + 32) = o2;
            }
          }
        }
      }
    return;
  }
  {
    const int fqp = g.perm ? (((fq & 1) << 1) | (fq >> 1)) : fq;
    unsigned char* wb = wreg + fr * 272 + fqp * 8;
    if (mode == M_BF16) {
#pragma unroll
      for (int bj = 0; bj < 2; ++bj)
#pragma unroll
        for (int n = 0; n < 2; ++n) {
          const int outer = g.C0 + bj * 128 + wc * 32 + n * 16 + fr;
          const float sc = g.scale * (g.rs ? g.rs[outer] : 1.f);
#pragma unroll
          for (int ai = 0; ai < 2; ++ai)
#pragma unroll
            for (int m = 0; m < 4; ++m) {
              const f32x4v v = acc[ai][bj][m][n] * sc;
              u32x2 pk; pk[0] = pack_bf16(v[0], v[1]); pk[1] = pack_bf16(v[2], v[3]);
              *(u32x2*)(wb + (bj * 32 + n * 16) * 272 + (ai * 64 + m * 16) * 2) = pk;
            }
        }
    } else if (mode == M_SILU) {
#pragma unroll
      for (int bj = 0; bj < 2; ++bj)
#pragma unroll
        for (int n = 0; n < 2; ++n)
#pragma unroll
          for (int ai = 0; ai < 2; ++ai)
#pragma unroll
            for (int m = 0; m < 4; ++m) {
              const f32x4v v = acc[ai][bj][m][n];
              u32x2 pk; pk[0] = pack_bf16(silu_f(v[0]), silu_f(v[1])); pk[1] = pack_bf16(silu_f(v[2]), silu_f(v[3]));
              *(u32x2*)(wb + (bj * 32 + n * 16) * 272 + (ai * 64 + m * 16) * 2) = pk;
            }
    } else {
      const float* rsp = g.rs ? g.rs + g.R0 + wr * 64 + fq * 4 : nullptr;
#pragma unroll
      for (int ai = 0; ai < 2; ++ai)
#pragma unroll
        for (int m = 0; m < 4; ++m) {
          float4 r4 = make_float4(1.f, 1.f, 1.f, 1.f);
          if (rsp) r4 = *(const float4*)(rsp + ai * 128 + m * 16);
#pragma unroll
          for (int bj = 0; bj < 2; ++bj)
#pragma unroll
            for (int n = 0; n < 2; ++n) {
              const f32x4v v = acc[ai][bj][m][n];
              u32x2 pk; pk[0] = pack_bf16(v[0] * r4.x, v[1] * r4.y); pk[1] = pack_bf16(v[2] * r4.z, v[3] * r4.w);
              *(u32x2*)(wb + (bj * 32 + n * 16) * 272 + (ai * 64 + m * 16) * 2) = pk;
            }
        }
    }
  }
  {
    const int ch = lane & 15, rsub = lane >> 4, ai = ch >> 3;
    const int outer0 = g.C0 + wc * 32 + rsub;
    const int inner0 = g.R0 + ai * 128 + wr * 64 + (ch & 7) * 8;
    size_t obase, ostride;
    if (mode == M_TRANS) { obase = ((size_t)(inner0 >> 13) * g.aux + outer0) * 8192 + (inner0 & 8191); ostride = 8192; }
    else { obase = (size_t)outer0 * g.ld + inner0; ostride = (size_t)g.ld; }
    const unsigned char* rb = wreg + rsub * 272 + ch * 16;
    u16* dp = g.d16 + obase;
#pragma unroll
    for (int it = 0; it < 16; ++it) {
      const u32x4 v = *(const u32x4*)(rb + it * 4 * 272);
      *(u32x4*)(dp + (size_t)((it >> 3) * 128 + (it & 7) * 4) * ostride) = v;
    }
  }
}

template <int DK, bool SB, int LDQN, int LDQR, int LDKN, int LDKR, int LDG>
DI void attn_item(const u16* __restrict__ Qn, const u16* __restrict__ Qr,
                  const u16* __restrict__ Kn, const u16* __restrict__ Kr,
                  const u16* __restrict__ Vt, const u16* __restrict__ Gt,
                  u16* __restrict__ Y, int q0, unsigned char* smem, int probe = 0) {
  constexpr int KS = DK / 16;
  constexpr int KROW_B = DK * 2;
  constexpr int KCH = DK / 8;
  constexpr int K_B = 64 * KROW_B;
  constexpr int STAGE_B = K_B + 128 * 128;
  constexpr int NKI = K_B / 8192;
  constexpr int G = NKI + 2;
  volatile __attribute__((address_space(3))) int* sflag = (volatile __attribute__((address_space(3))) int*)(smem + 3 * STAGE_B);
  const int tid = TIDX(), lane = tid & 63, wave = tid >> 6;
  const int r = lane & 31, h = lane >> 5;
  const int qrow = q0 + 32 * wave + r;
  const int qmin = q0 + 32 * wave, qmax = qmin + 31;

  bf16x8 bq[KS];
  {
    const u16* qp = Qn + (unsigned)(qrow * LDQN + 8 * h);
#pragma unroll
    for (int ks = 0; ks < 8; ++ks) bq[ks] = *(const bf16x8*)(qp + 16 * ks);
    if constexpr (!SB) {
      const u16* qp2 = Qr + (unsigned)(qrow * LDQR + 8 * h);
#pragma unroll
      for (int ks = 8; ks < KS; ++ks) bq[ks] = *(const bf16x8*)(qp2 + 16 * (ks - 8));
    }
  }
  f32x16 O[4];
#pragma unroll
  for (int d = 0; d < 4; ++d)
#pragma unroll
    for (int q = 0; q < 16; ++q) O[d][q] = 0.f;
  float m_run = -INFINITY, l_run = 0.f, R = 0.f;
  const int nt = (q0 >> 6) + 4;

  const u16* kbase[NKI]; unsigned isr = 0u; unsigned voff0;
#pragma unroll
  for (int j = 0; j < NKI; ++j) {
    const int L = 64 * (wave + 8 * j) + lane, row = L / KCH, p = L - row * KCH;
    const int c = SB ? (p ^ (row & 15)) : ((p & ~7) | ((p & 7) ^ ((row >> 1) & 7)));
    if (SB || c < 16) { kbase[j] = Kn + (unsigned)(row * LDKN + c * 8); }
    else { kbase[j] = Kr + (unsigned)(row * LDKR + (c - 16) * 8); isr |= 1u << j; }
  }
  {
    const int L = 64 * wave + lane, row = L >> 3, p = L & 7;
    voff0 = (unsigned)(row * 8192 + (p ^ ((row >> 1) & 7)) * 8);
  }
  auto issue_tile = [&](int kt, int st) {
    unsigned char* sKb = smem + st * STAGE_B;
#pragma unroll
    for (int j = 0; j < NKI; ++j) {
      const unsigned kstr = ((isr >> j) & 1u) ? 64u * LDKR : 64u * LDKN;
      __builtin_amdgcn_global_load_lds((const unsigned*)(kbase[j] + (size_t)kt * kstr),
                                       (unsigned*)(sKb + (wave + 8 * j) * 1024), 16, 0, 0);
    }
    const u16* vb_ = Vt + kt * 64;
#pragma unroll
    for (int j = 0; j < 2; ++j)
      __builtin_amdgcn_global_load_lds((const unsigned*)(vb_ + (size_t)j * 64 * 8192 + voff0),
                                       (unsigned*)(sKb + K_B + (wave + 8 * j) * 1024), 16, 0, 0);
  };
  const int s3 = (r >> 1) & 7, s4 = r & 15;

  lds_barrier();
  issue_tile(SB ? nt - 1 : 0, 0);
  issue_tile(SB ? nt - 2 : 1, 1);
  asm volatile("s_waitcnt vmcnt(%0)" :: "n"(G) : "memory");
  asm volatile("s_waitcnt lgkmcnt(0)" ::: "memory");
  __builtin_amdgcn_s_barrier();
  auto tile_body = [&](int it, auto st_c) -> bool {
    constexpr int ST = decltype(st_c)::value;
    const int kt = SB ? (nt - 1 - it) : it;
    if (it + 2 < nt && !(PROBE_MODE == 3 && probe)) issue_tile(SB ? (nt - 3 - it) : (it + 2), (ST + 2) % 3);
    __builtin_amdgcn_sched_barrier(0);
    const unsigned char* sK = smem + ST * STAGE_B;
    const unsigned char* sV = sK + K_B;
    auto kchunk = [&](int ks) -> int {
      const int c = 2 * ks + h;
      return (SB ? (c ^ s4) : ((c & ~7) | ((c & 7) ^ s3))) * 16;
    };
    const int kbA = SB ? 1 : 0, kbB = SB ? 0 : 1;
    const int keyA = kt * 64 + 32 * kbA, keyB = kt * 64 + 32 * kbB;
    const bool skipA = SB ? (keyA >= qmax) : (keyA > qmax);
    const bool skipB = SB ? (keyB >= qmax) : (keyB > qmax);
    f32x16 SA_, SB_;
    {
      bf16x8 kf[KS];
      if (!skipA) {
        const unsigned char* kp = sK + (32 * kbA + r) * KROW_B;
#pragma unroll
        for (int ks = 0; ks < KS; ++ks) kf[ks] = *(const bf16x8*)(kp + kchunk(ks));
#pragma unroll
        for (int q = 0; q < 16; ++q) SA_[q] = 0.f;
        __builtin_amdgcn_sched_barrier(0);
#pragma unroll
        for (int ks = 0; ks < KS; ++ks) SA_ = MFMA32(kf[ks], bq[ks], SA_);
        __builtin_amdgcn_sched_barrier(0);
      }
      if (!skipB) {
        const unsigned char* kp = sK + (32 * kbB + r) * KROW_B;
#pragma unroll
        for (int ks = 0; ks < KS; ++ks) kf[ks] = *(const bf16x8*)(kp + kchunk(ks));
#pragma unroll
        for (int q = 0; q < 16; ++q) SB_[q] = 0.f;
        __builtin_amdgcn_sched_barrier(0);
#pragma unroll
        for (int ks = 0; ks < KS; ++ks) SB_ = MFMA32(kf[ks], bq[ks], SB_);
        __builtin_amdgcn_sched_barrier(0);
      }
    }
    auto math_pv = [&](f32x16& Sx, const int kb, const int key0) {
      bf16x8 vf[8];
#pragma unroll
      for (int d = 0; d < 4; ++d) vf[d] = *(const bf16x8*)(sV + (32 * d + r) * 128 + (((4 * kb + h) ^ s3) * 16));
      __builtin_amdgcn_sched_barrier(0);
      if constexpr (!SB) {
       if (!(PROBE_MODE == 4 && probe)) {
        if (key0 + 31 > qmin) {
#pragma unroll
          for (int q = 0; q < 16; ++q)
            if (key0 + crow(q, h) > qrow) Sx[q] = -INFINITY;
        }
        float mloc = Sx[0];
#pragma unroll
        for (int q = 1; q < 16; ++q) mloc = fmaxf(mloc, Sx[q]);
        mloc = xh_max(mloc);
        float mnew = m_run, alpha = 1.f;
        const bool need = __builtin_amdgcn_ballot_w64(mloc > m_run + 8.f) != 0ull;
        if (need) {
          mnew = fmaxf(m_run, mloc);
          alpha = __builtin_amdgcn_exp2f(m_run - mnew);
          m_run = mnew;
        }
        typedef float f32x2v __attribute__((ext_vector_type(2)));
        const f32x2v mm = {mnew, mnew};
        f32x2v ls2 = {0.f, 0.f};
#pragma unroll
        for (int q = 0; q < 8; ++q) {
          f32x2v t = {Sx[2 * q], Sx[2 * q + 1]};
          t = t - mm;
          t[0] = __builtin_amdgcn_exp2f(t[0]);
          t[1] = __builtin_amdgcn_exp2f(t[1]);
          Sx[2 * q] = t[0]; Sx[2 * q + 1] = t[1];
          ls2 = ls2 + t;
        }
        const float lsum = ls2[0] + ls2[1];
        l_run = l_run * alpha + lsum;
        if (need) {
#pragma unroll
          for (int d = 0; d < 4; ++d)
#pragma unroll
            for (int q = 0; q < 16; ++q) O[d][q] *= alpha;
        }
       }
      } else {
        f32x16 Lx;
        float gs[4], ps[4];
        if (key0 + 31 < qmin) {
#pragma unroll
          for (int q = 0; q < 16; ++q) {
            const float z0 = Sx[q];
            Lx[q] = -(fmaxf(z0, 0.f) + __builtin_amdgcn_logf(1.f + __builtin_amdgcn_exp2f(-fabsf(z0))));
          }
#pragma unroll
          for (int gq = 0; gq < 4; ++gq) {
            gs[gq] = (Lx[4 * gq] + Lx[4 * gq + 1]) + (Lx[4 * gq + 2] + Lx[4 * gq + 3]);
            ps[gq] = xh_partner(gs[gq], h);
          }
          float run = 0.f;
#pragma unroll
          for (int gq = 3; gq >= 0; --gq) {
            const float own = R + run + (h == 0 ? ps[gq] : 0.f);
            run += gs[gq] + ps[gq];
            const float a3 = own, a2 = a3 + Lx[4 * gq + 3], a1 = a2 + Lx[4 * gq + 2], a0 = a1 + Lx[4 * gq + 1];
            Sx[4 * gq + 0] = __builtin_amdgcn_exp2f(Sx[4 * gq + 0] + Lx[4 * gq + 0] + a0);
            Sx[4 * gq + 1] = __builtin_amdgcn_exp2f(Sx[4 * gq + 1] + Lx[4 * gq + 1] + a1);
            Sx[4 * gq + 2] = __builtin_amdgcn_exp2f(Sx[4 * gq + 2] + Lx[4 * gq + 2] + a2);
            Sx[4 * gq + 3] = __builtin_amdgcn_exp2f(Sx[4 * gq + 3] + Lx[4 * gq + 3] + a3);
          }
          R += run;
        } else {
#pragma unroll
          for (int q = 0; q < 16; ++q) {
            const float z0 = Sx[q];
            const float sp0 = fmaxf(z0, 0.f) + __builtin_amdgcn_logf(1.f + __builtin_amdgcn_exp2f(-fabsf(z0)));
            Lx[q] = (key0 + crow(q, h) < qrow) ? -sp0 : 0.f;
          }
#pragma unroll
          for (int gq = 0; gq < 4; ++gq) {
            gs[gq] = (Lx[4 * gq] + Lx[4 * gq + 1]) + (Lx[4 * gq + 2] + Lx[4 * gq + 3]);
            ps[gq] = xh_partner(gs[gq], h);
          }
          float run = 0.f;
#pragma unroll
          for (int gq = 3; gq >= 0; --gq) {
            const float own = R + run + (h == 0 ? ps[gq] : 0.f);
            run += gs[gq] + ps[gq];
            const int key = key0 + 8 * gq + 4 * h;
            const float a3 = own, a2 = a3 + Lx[4 * gq + 3], a1 = a2 + Lx[4 * gq + 2], a0 = a1 + Lx[4 * gq + 1];
            const float e0 = __builtin_amdgcn_exp2f(Sx[4 * gq + 0] + Lx[4 * gq + 0] + a0);
            const float e1 = __builtin_amdgcn_exp2f(Sx[4 * gq + 1] + Lx[4 * gq + 1] + a1);
            const float e2 = __builtin_amdgcn_exp2f(Sx[4 * gq + 2] + Lx[4 * gq + 2] + a2);
            const float e3 = __builtin_amdgcn_exp2f(Sx[4 * gq + 3] + Lx[4 * gq + 3] + a3);
            Sx[4 * gq + 0] = (key + 0 < qrow) ? e0 : 0.f;
            Sx[4 * gq + 1] = (key + 1 < qrow) ? e1 : 0.f;
            Sx[4 * gq + 2] = (key + 2 < qrow) ? e2 : 0.f;
            Sx[4 * gq + 3] = (key + 3 < qrow) ? e3 : 0.f;
          }
          R += run;
        }
      }
      const bf16x8 pf0 = pack8(Sx, 0), pf1 = pack8(Sx, 1);
      __builtin_amdgcn_sched_barrier(0);
#pragma unroll
      for (int d = 0; d < 4; ++d) vf[4 + d] = *(const bf16x8*)(sV + (32 * d + r) * 128 + (((4 * kb + 2 + h) ^ s3) * 16));
#pragma unroll
      for (int d = 0; d < 4; ++d) O[d] = MFMA32(vf[d], pf0, O[d]);
      __builtin_amdgcn_sched_barrier(0);
#pragma unroll
      for (int d = 0; d < 4; ++d) O[d] = MFMA32(vf[4 + d], pf1, O[d]);
      __builtin_amdgcn_sched_barrier(0);
    };
    if (!skipA) math_pv(SA_, kbA, keyA);
    if (!skipB) math_pv(SB_, kbB, keyB);
    if constexpr (SB) {
      const bool done = (__builtin_amdgcn_ballot_w64(!(R < -150.1f)) == 0ull);
      if (lane == 0) sflag[(it & 1) * 8 + wave] = done ? 1 : 0;
    }
    if (it + 2 < nt) asm volatile("s_waitcnt vmcnt(%0)" :: "n"(G) : "memory");
    else asm volatile("s_waitcnt vmcnt(0)" ::: "memory");
    asm volatile("s_waitcnt lgkmcnt(0)" ::: "memory");
    __builtin_amdgcn_s_barrier();
    if constexpr (SB) {
      const volatile __attribute__((address_space(3))) int* f = sflag + (it & 1) * 8;
      if (f[0] & f[1] & f[2] & f[3] & f[4] & f[5] & f[6] & f[7]) return true;
    }
    return false;
  };
  for (int it = 0; it < nt; it += 3) {
    if (tile_body(it, std::integral_constant<int, 0>{})) break;
    if (it + 1 >= nt) break;
    if (tile_body(it + 1, std::integral_constant<int, 1>{})) break;
    if (it + 2 >= nt) break;
    if (tile_body(it + 2, std::integral_constant<int, 2>{})) break;
  }

  asm volatile("s_waitcnt vmcnt(0)" ::: "memory");
  if (PROBE_MODE >= 3 && probe) {
    float sacc = l_run;
#pragma unroll
    for (int d = 0; d < 4; ++d)
#pragma unroll
      for (int q = 0; q < 16; ++q) sacc += O[d][q];
    if (sacc == 1.2345e-30f) Y[0] = 0;
    return;
  }
  float inv = 1.f;
  if constexpr (!SB) {
    const float lt = xh_sum(l_run);
    inv = 1.f / lt;
  }
  const u16* gp = Gt + (unsigned)(qrow * LDG + 4 * h);
  u16* yp = Y + (unsigned)(qrow * 2048 + 4 * h);
#pragma unroll
  for (int d = 0; d < 4; ++d)
#pragma unroll
    for (int gq = 0; gq < 4; ++gq) {
      const int dv = 32 * d + 8 * gq;
      const u32x2 gt = *(const u32x2*)(gp + dv);
      u32x2 o;
      o[0] = pack_bf16(O[d][4 * gq + 0] * inv * bf_lo(gt[0]), O[d][4 * gq + 1] * inv * bf_hi(gt[0]));
      o[1] = pack_bf16(O[d][4 * gq + 2] * inv * bf_lo(gt[1]), O[d][4 * gq + 3] * inv * bf_hi(gt[1]));
      *(u32x2*)(yp + dv) = o;
    }
}

DI void gla_g1(const Params& p, int li, int unit, unsigned char* smem) {
  const int c = unit & 127, bh = unit >> 7, b = bh >> 2, hh = bh & 3;
  const size_t m0 = (size_t)b * S_ + c * 64;
  float* lf = (float*)smem;
  u16* klT = (u16*)(smem + 32768);
  const float* GA = (const float*)(p.ws + E_GA);
  u16* GQ = (u16*)(p.ws + E_GQ);
  u16* GK = (u16*)(p.ws + E_GK);
  const u16* GVT = (const u16*)(p.ws + E_GVT);
  float* EBL = (float*)(p.ws + E_EBL);
  float* SC = (float*)(p.ws + E_SC);
  const float* au_p = p.alpha_up + (size_t)li * 16 * 512;
  const float* bias_p = p.alpha_bias + (size_t)li * 512;
  const int tid = TIDX(), lane = tid & 63, wave = tid >> 6;
  const int r = lane & 31, h = lane >> 5;
  {
    const int d = tid & 127, th = tid >> 7;
    float au[16];
#pragma unroll
    for (int q = 0; q < 16; ++q) au[q] = au_p[q * 512 + hh * 128 + d];
    const float bs = bias_p[hh * 128 + d];
    for (int tt = 0; tt < 16; ++tt) {
      const int t = th * 16 + tt;
      const float4* ga = (const float4*)(GA + (m0 + t) * 16);
      float s = bs;
#pragma unroll
      for (int q = 0; q < 4; ++q) {
        const float4 g4 = ga[q];
        s += g4.x * au[4 * q] + g4.y * au[4 * q + 1] + g4.z * au[4 * q + 2] + g4.w * au[4 * q + 3];
      }
      const float sp = fmaxf(-s, 0.f) + __logf(1.f + __expf(-fabsf(s)));
      lf[t * 128 + d] = -sp * (1.f / 16.f);
    }
  }
  lds_barrier();
  {
    const int d = tid & 127, sg = tid >> 7;
    float run = 0.f;
#pragma unroll
    for (int t = 0; t < 16; ++t) { run += lf[(sg * 16 + t) * 128 + d]; lf[(sg * 16 + t) * 128 + d] = run; }
    lds_barrier();
    float off = 0.f;
    if (sg > 0) off += lf[15 * 128 + d];
    if (sg > 1) off += lf[31 * 128 + d];
    if (sg > 2) off += lf[47 * 128 + d];
    lds_barrier();
    if (sg > 0) {
#pragma unroll
      for (int t = 0; t < 16; ++t) lf[(sg * 16 + t) * 128 + d] += off;
    }
  }
  lds_barrier();
#pragma unroll 1
  for (int i = 0; i < 2; ++i) {
    const int idx = tid + 512 * i;
    const int t = idx >> 4, d0 = (idx & 15) * 8;
    u16* qp = GQ + (m0 + t) * 512 + hh * 128 + d0;
    u16* kp = GK + (m0 + t) * 512 + hh * 128 + d0;
    const u32x4 qv = *(const u32x4*)qp;
    const u32x4 kv = *(const u32x4*)kp;
    u32x4 qo, ko;
#pragma unroll
    for (int jj = 0; jj < 4; ++jj) {
      const float bb0 = lf[t * 128 + d0 + 2 * jj], bb1 = lf[t * 128 + d0 + 2 * jj + 1];
      const float bl0 = lf[63 * 128 + d0 + 2 * jj], bl1 = lf[63 * 128 + d0 + 2 * jj + 1];
      const float q0 = bf_lo(qv[jj]), q1 = bf_hi(qv[jj]);
      const float k0 = bf_lo(kv[jj]), k1 = bf_hi(kv[jj]);
      qo[jj] = pack_bf16(q0 * 0.08838834764831845f * __expf(bb0), q1 * 0.08838834764831845f * __expf(bb1));
      ko[jj] = pack_bf16(k0 * __expf(-bb0), k1 * __expf(-bb1));
      klT[(d0 + 2 * jj) * 72 + t] = to_bf16(k0 * __expf(bl0 - bb0));
      klT[(d0 + 2 * jj + 1) * 72 + t] = to_bf16(k1 * __expf(bl1 - bb1));
    }
    *(u32x4*)qp = qo;
    *(u32x4*)kp = ko;
  }
  if (tid < 128) EBL[(size_t)unit * 128 + tid] = __expf(lf[63 * 128 + tid]);
  lds_barrier();
  {
    f32x16 acc[4];
#pragma unroll
    for (int j = 0; j < 4; ++j)
#pragma unroll
      for (int q = 0; q < 16; ++q) acc[j][q] = 0.f;
    const u16* vp = GVT + ((size_t)(bh * 256 + 32 * wave + r)) * 8192 + c * 64 + 8 * h;
#pragma unroll
    for (int ks = 0; ks < 4; ++ks) {
      const bf16x8 bv = *(const bf16x8*)(vp + 16 * ks);
#pragma unroll
      for (int db = 0; db < 4; ++db) {
        const bf16x8 ak = *(const bf16x8*)(klT + (32 * db + r) * 72 + 16 * ks + 8 * h);
        acc[db] = MFMA32(ak, bv, acc[db]);
      }
    }
    u16* SC16 = (u16*)SC;
    u16* sp = SC16 + ((size_t)unit * 256 + 32 * wave + r) * 128 + 4 * h;
#pragma unroll
    for (int db = 0; db < 4; ++db)
#pragma unroll
      for (int g4 = 0; g4 < 4; ++g4) {
        u32x2 pk;
        pk[0] = pack_bf16(acc[db][4 * g4 + 0], acc[db][4 * g4 + 1]);
        pk[1] = pack_bf16(acc[db][4 * g4 + 2], acc[db][4 * g4 + 3]);
        *(u32x2*)(sp + 32 * db + 8 * g4) = pk;
      }
  }
  lds_barrier();
}

DI void gla_scan(const Params& p) {
  u16* SC16 = (u16*)(p.ws + E_SC);
  const float* EBL = (const float*)(p.ws + E_EBL);
  for (int cp = blockIdx.x * 512 + TIDX(); cp < 131072; cp += gridDim.x * 512) {
    const int bh = cp >> 14, rem = cp & 16383, e = rem >> 6, d2 = (rem & 63) * 2;
    u16* base = SC16 + ((size_t)(bh * 128) * 256 + e) * 128 + d2;
    const float* eb = EBL + (size_t)(bh * 128) * 128 + d2;
    float sx = 0.f, sy = 0.f;
#pragma unroll 8
    for (int c = 0; c < 128; ++c) {
      const unsigned sv = *(const unsigned*)(base + (size_t)c * 32768);
      const float2 f = *(const float2*)(eb + c * 128);
      *(unsigned*)(base + (size_t)c * 32768) = pack_bf16(sx, sy);
      sx = f.x * sx + bf_lo(sv);
      sy = f.y * sy + bf_hi(sv);
    }
  }
}

DI void gla_g3(const Params& p, int li, int unit, unsigned char* smem) {
  const int c = unit & 127, bh = unit >> 7, b = bh >> 2, hh = bh & 3;
  const size_t m0 = (size_t)b * S_ + c * 64;
  float* red = (float*)smem;
  const u16* GQ = (const u16*)(p.ws + E_GQ);
  const u16* GK = (const u16*)(p.ws + E_GK);
  const u16* GVT = (const u16*)(p.ws + E_GVT);
  const u16* GG = (const u16*)(p.ws + E_GG);
  const float* SC = (const float*)(p.ws + E_SC);
  u16* Y = (u16*)(p.ws + OFF_H);
  const float* gn = p.gla_norm + (size_t)li * 256;
  const int tid = TIDX(), lane = tid & 63, wave = tid >> 6;
  const int r = lane & 31, h = lane >> 5;

  bf16x8 bq[2][8];
#pragma unroll
  for (int ib = 0; ib < 2; ++ib)
#pragma unroll
    for (int ks = 0; ks < 8; ++ks)
      bq[ib][ks] = *(const bf16x8*)(GQ + (m0 + 32 * ib + r) * 512 + hh * 128 + 16 * ks + 8 * h);
  f32x16 X00, X01, X11;
#pragma unroll
  for (int q = 0; q < 16; ++q) { X00[q] = 0.f; X01[q] = 0.f; X11[q] = 0.f; }
#pragma unroll
  for (int ks = 0; ks < 8; ++ks) {
    const bf16x8 a0 = *(const bf16x8*)(GK + (m0 + r) * 512 + hh * 128 + 16 * ks + 8 * h);
    const bf16x8 a1 = *(const bf16x8*)(GK + (m0 + 32 + r) * 512 + hh * 128 + 16 * ks + 8 * h);
    X00 = MFMA32(a0, bq[0][ks], X00);
    X01 = MFMA32(a0, bq[1][ks], X01);
    X11 = MFMA32(a1, bq[1][ks], X11);
  }
#pragma unroll
  for (int q = 0; q < 16; ++q) {
    if (crow(q, h) > r) { X00[q] = 0.f; X11[q] = 0.f; }
  }
  f32x16 acc[2];
#pragma unroll
  for (int j = 0; j < 2; ++j)
#pragma unroll
    for (int q = 0; q < 16; ++q) acc[j][q] = 0.f;
  {
    const u16* st = (const u16*)SC + ((size_t)unit * 256 + 32 * wave + r) * 128 + 8 * h;
#pragma unroll
    for (int ks = 0; ks < 8; ++ks) {
      const bf16x8 a = *(const bf16x8*)(st + 16 * ks);
      acc[0] = MFMA32(a, bq[0][ks], acc[0]);
      acc[1] = MFMA32(a, bq[1][ks], acc[1]);
    }
  }
  {
    const u16* vr = GVT + ((size_t)(bh * 256 + 32 * wave + r)) * 8192 + c * 64;
#pragma unroll
    for (int s = 0; s < 2; ++s) {
      const bf16x8 pf00 = pack8(X00, s), pf01 = pack8(X01, s), pf11 = pack8(X11, s);
      {
        const s16x4 lo = *(const s16x4*)(vr + 16 * s + 4 * h);
        const s16x4 hi = *(const s16x4*)(vr + 16 * s + 8 + 4 * h);
        const bf16x8 a = __builtin_shufflevector(lo, hi, 0, 1, 2, 3, 4, 5, 6, 7);
        acc[0] = MFMA32(a, pf00, acc[0]);
        acc[1] = MFMA32(a, pf01, acc[1]);
      }
      {
        const s16x4 lo = *(const s16x4*)(vr + 32 + 16 * s + 4 * h);
        const s16x4 hi = *(const s16x4*)(vr + 32 + 16 * s + 8 + 4 * h);
        const bf16x8 a = __builtin_shufflevector(lo, hi, 0, 1, 2, 3, 4, 5, 6, 7);
        acc[1] = MFMA32(a, pf11, acc[1]);
      }
    }
  }
  float rstd[2];
#pragma unroll
  for (int ib = 0; ib < 2; ++ib) {
    float ss = 0.f;
#pragma unroll
    for (int q = 0; q < 16; ++q) ss += acc[ib][q] * acc[ib][q];
    ss = xh_sum(ss);
    if (h == 0) red[wave * 64 + 32 * ib + r] = ss;
  }
  lds_barrier();
#pragma unroll
  for (int ib = 0; ib < 2; ++ib) {
    float tot = 0.f;
#pragma unroll
    for (int w = 0; w < 8; ++w) tot += red[w * 64 + 32 * ib + r];
    rstd[ib] = rsqrtf(tot * (1.f / 256.f) + 1e-6f);
  }
#pragma unroll
  for (int ib = 0; ib < 2; ++ib)
#pragma unroll
    for (int gq = 0; gq < 4; ++gq) {
      const int e = 32 * wave + 8 * gq + 4 * h;
      const size_t m = m0 + 32 * ib + r;
      const u32x2 gt = *(const u32x2*)(GG + m * 1024 + hh * 256 + e);
      const float4 g4 = *(const float4*)(gn + e);
      const float rs = rstd[ib];
      u32x2 o;
      o[0] = pack_bf16(acc[ib][4 * gq + 0] * rs * g4.x * bf_lo(gt[0]), acc[ib][4 * gq + 1] * rs * g4.y * bf_hi(gt[0]));
      o[1] = pack_bf16(acc[ib][4 * gq + 2] * rs * g4.z * bf_lo(gt[1]), acc[ib][4 * gq + 3] * rs * g4.w * bf_hi(gt[1]));
      *(u32x2*)(Y + m * 2048 + 1024 + hh * 256 + e) = o;
    }
  lds_barrier();
}

__device__ const double kInvFreq[32] = {1.0, 0.7498942093324559, 0.5623413251903491, 0.4216965034285822, 0.31622776601683794, 0.23713737056616552, 0.1778279410038923, 0.1333521432163324, 0.1, 0.07498942093324558, 0.05623413251903491, 0.042169650342858224, 0.03162277660168379, 0.023713737056616554, 0.01778279410038923, 0.01333521432163324, 0.01, 0.007498942093324558, 0.005623413251903491, 0.004216965034285823, 0.0031622776601683794, 0.0023713737056616554, 0.0017782794100389228, 0.001333521432163324, 0.001, 0.0007498942093324559, 0.0005623413251903491, 0.00042169650342858224, 0.00031622776601683794, 0.00023713737056616554, 0.00017782794100389227, 0.0001333521432163324};

#define XB_TMO      128
#define XB_XCNT(j)  (256  + 64 * (j))
#define XB_XSUB(j)  (1280 + 64 * (j))
#define XB_XGEN(j)  (2304 + 64 * (j))
#define XB_TOP      3328
#define XB_TOPGEN   3392
#define XCD_BAR_WORDS 3456
#define XB_SPIN_CAP (1u << 20)
#define LAS __attribute__((address_space(3)))
DI unsigned xb_ld(unsigned* p)              { return __hip_atomic_load(p, __ATOMIC_RELAXED, __HIP_MEMORY_SCOPE_AGENT); }
DI unsigned xb_add(unsigned* p, unsigned v) { return __hip_atomic_fetch_add(p, v, __ATOMIC_RELAXED, __HIP_MEMORY_SCOPE_AGENT); }
DI unsigned xb_xcc_id() { return (unsigned)__builtin_amdgcn_s_getreg((3 << 11) | 20) & 0xFu; }
#define XB_SPIN(cond, bar) do { unsigned _sp = 0; while (cond) { __builtin_amdgcn_s_sleep(1); \
    if ((++_sp & 255u) == 0u) { if (xb_ld(&(bar)[XB_TMO])) break; if (_sp > XB_SPIN_CAP) { atomicAdd(&(bar)[XB_TMO], 1u); break; } } } } while (0)
struct XcdBarrier { unsigned* bar; unsigned x; volatile LAS unsigned* st; };
DI XcdBarrier xcd_barrier_post(unsigned* bar, volatile LAS unsigned* st) {
  XcdBarrier b; b.bar = bar; b.x = xb_xcc_id(); b.st = st;
  if (__builtin_amdgcn_workitem_id_x() == 0) (void)xb_add(&bar[XB_XCNT(b.x)], 1u);
  return b;
}
DI void xcd_barrier_complete(unsigned* bar, unsigned x, unsigned& nloc, unsigned& nx) {
  const unsigned G = gridDim.x * gridDim.y * gridDim.z;
  unsigned sum, cnt, mine, sp = 0u;
  for (;;) {
    sum = 0u; cnt = 0u; mine = 0u;
#pragma unroll
    for (unsigned j = 0; j < 16; ++j) { const unsigned c = xb_ld(&bar[XB_XCNT(j)]); sum += c; cnt += (c > 0u) ? 1u : 0u; mine = (j == x) ? c : mine; }
    if (sum == G) break;
    __builtin_amdgcn_s_sleep(1);
    if ((++sp & 255u) == 0u) { if (xb_ld(&bar[XB_TMO])) break; if (sp > XB_SPIN_CAP) { atomicAdd(&bar[XB_TMO], 1u); break; } }
  }
  nloc = mine > 0u ? mine : 1u; nx = cnt > 0u ? cnt : 1u;
}
DI void xcd_barrier(const XcdBarrier& b) {
  asm volatile("s_waitcnt vmcnt(0)" ::: "memory");
  __syncthreads();
  if (__builtin_amdgcn_workitem_id_x() == 0) {
    unsigned* bar = b.bar;
    __builtin_amdgcn_s_waitcnt(0);
    unsigned nloc = b.st[0], nx = b.st[1];
    if (nloc == 0u) { xcd_barrier_complete(bar, b.x, nloc, nx); b.st[0] = nloc; b.st[1] = nx; }
    const unsigned old = xb_add(&bar[XB_XSUB(b.x)], 1u);
    const unsigned gen = old / nloc;
    if (old + 1u == (gen + 1u) * nloc) {
      __builtin_amdgcn_fence(__ATOMIC_RELEASE, "agent");
      asm volatile("s_waitcnt vmcnt(0)" ::: "memory");
      const unsigned og = xb_add(&bar[XB_TOP], 1u);
      const unsigned tg = og / nx;
      if (og + 1u == (tg + 1u) * nx) xb_add(&bar[XB_TOPGEN], 1u);
      else XB_SPIN(xb_ld(&bar[XB_TOPGEN]) == tg, bar);
      __builtin_amdgcn_fence(__ATOMIC_ACQUIRE, "agent");
      xb_add(&bar[XB_XGEN(b.x)], 1u);
      asm volatile("s_waitcnt vmcnt(0)" ::: "memory");
    } else {
      XB_SPIN(xb_ld(&bar[XB_XGEN(b.x)]) == gen, bar);
      __builtin_amdgcn_fence(__ATOMIC_ACQUIRE, "agent");
      asm volatile("s_waitcnt vmcnt(0)" ::: "memory");
    }
  }
  __syncthreads();
}

constexpr int WG_LD = 2052;

DI GemmT gt_init(int K) {
  GemmT g;
  g.A = nullptr; g.B = nullptr; g.K = K; g.lda = K; g.ldb = K;
  g.mode = M_BF16; g.R0 = 0; g.C0 = 0; g.ld = 0; g.aux = 0; g.nact = 256; g.probe = 0; g.perm = 0;
  g.d16 = nullptr; g.d32 = nullptr; g.scale = 1.f; g.rs = nullptr; g.xin = nullptr; g.cs = nullptr; g.sn = nullptr;
  return g;
}

DI void tile_map(int t, int TN, int& tm, int& tn) {
  const int b = t & 255, k = t >> 8;
  const int x = b & 7, j = b >> 3;
  const int G = k * 8 + x;
  const int gpr = TN >> 2;
  const int gm = G / gpr, gn = G - gm * gpr;
  tm = gm * 8 + (j >> 2); tn = gn * 4 + (j & 3);
}

DI void phase_prep(const Params& p, int L, unsigned char* smem) {
  const bool even = (L & 1) == 0;
  const int li = L >> 1;
  u16* WL = (u16*)(p.ws + OFF_WL);
  float* lds = (float*)smem;
  if (L == 0) {
    float* cs = (float*)(p.ws + OFF_COS);
    float* sn = (float*)(p.ws + OFF_SIN);
    for (int i = blockIdx.x * 512 + TIDX(); i < T_ * 32; i += gridDim.x * 512) {
      const int m = i >> 5, f = i & 31;
      const double ang = (double)p.pos[m] * kInvFreq[f];
      const double t = ang * 0.63661977236758134308;
      const double kq = rint(t);
      const double rr = (t - kq) * 1.57079632679489661923;
      const int qd = (int)((long long)kq & 3);
      const double r2 = rr * rr;
      const double sr = rr * (1.0 - r2 / 6.0 * (1.0 - r2 / 20.0 * (1.0 - r2 / 42.0 * (1.0 - r2 / 72.0 * (1.0 - r2 / 110.0 * (1.0 - r2 / 156.0))))));
      const double cr = 1.0 - r2 / 2.0 * (1.0 - r2 / 12.0 * (1.0 - r2 / 30.0 * (1.0 - r2 / 56.0 * (1.0 - r2 / 90.0 * (1.0 - r2 / 132.0 * (1.0 - r2 / 182.0))))));
      const double cc = (qd == 0) ? cr : (qd == 1) ? -sr : (qd == 2) ? -cr : sr;
      const double sv = (qd == 0) ? sr : (qd == 1) ? cr : (qd == 2) ? -sr : -cr;
      cs[i] = (float)cc;
      sn[i] = (float)sv;
    }
  }
  if (even) {
    const float* win = p.w_in_even + (size_t)li * 2048 * 7184;
    const float* wout = p.w_out_even + (size_t)li * 2048 * 2048;
    const int n1 = 28 * 32, n2 = 8 * 32;
    for (int t = blockIdx.x; t < n1 + n2; t += gridDim.x) {
      if (t < n1) convert_tile256(win, 7184, nullptr, WL + WE_IN, 2048, (t & 31) * 64, (t >> 5) * 256, 0, lds);
      else { const int u = t - n1; convert_tile256(wout, 2048, nullptr, WL + WE_OUT, 2048, (u & 31) * 64, (u >> 5) * 256, 0, lds); }
    }
  } else {
    const float* win = p.w_in_odd + (size_t)li * 2048 * 3136;
    const float* wq = p.w_q_up + (size_t)li * 512 * 3072;
    const float* wkv = p.w_kv_up + (size_t)li * 512 * 4096;
    const float* wout = p.w_out_odd + (size_t)li * 2048 * 2048;
    const int n1 = 13 * 32, n2 = 12 * 8, n3 = 16 * 8, n4 = 8 * 32;
    for (int t = blockIdx.x; t < n1 + n2 + n3 + n4; t += gridDim.x) {
      if (t < n1) convert_tile256(win, 3136, nullptr, WL + WO_IN, 2048, (t & 31) * 64, (t >> 5) * 256, 1, lds);
      else if (t < n1 + n2) { const int u = t - n1; convert_tile256(wq, 3072, p.q_norm + (size_t)li * 512, WL + WO_Q, 512, (u & 7) * 64, (u >> 3) * 256, 2, lds); }
      else if (t < n1 + n2 + n3) { const int u = t - n1 - n2; convert_tile256(wkv, 4096, p.kv_norm + (size_t)li * 512, WL + WO_KV, 512, (u & 7) * 64, (u >> 3) * 256, 3, lds); }
      else { const int u = t - n1 - n2 - n3; convert_tile256(wout, 2048, nullptr, WL + WO_OUT, 2048, (u & 31) * 64, (u >> 5) * 256, 0, lds); }
    }
  }
  const float* xin = (L == 0) ? p.x : p.out;
  const float* g = even ? (p.ln_even + (size_t)li * 2048) : (p.ln_odd + (size_t)li * 2048);
  u16* H = (u16*)(p.ws + OFF_H);
  const int wave = TIDX() >> 6;
  if (even) {
    const float* wsrc = p.w_in_even + (size_t)li * 2048 * 7184 + 7168;
    const int tid = TIDX();
    for (int idx = tid; idx < 2048 * 16; idx += 512) {
      const int k = idx >> 4, c = idx & 15;
      lds[c * WG_LD + k] = wsrc[(size_t)k * 7184 + c];
    }
    __syncthreads();
    float* GA = (float*)(p.ws + E_GA);
    for (int row = blockIdx.x * 8 + wave; row < T_; row += gridDim.x * 8)
      norm_row<true>(xin + (size_t)row * 2048, g, H + (size_t)row * 2048, nullptr, lds, GA + (size_t)row * 16);
    __syncthreads();
  } else {
    for (int row = blockIdx.x * 8 + wave; row < T_; row += gridDim.x * 8)
      norm_row<false>(xin + (size_t)row * 2048, g, H + (size_t)row * 2048, nullptr, nullptr, nullptr);
  }
}

DI void phase_gemm_in_even(const Params& p, unsigned char* smem, int probe) {
  const u16* WL = (const u16*)(p.ws + OFF_WL);
  const u16* H = (const u16*)(p.ws + OFF_H);
  const int NT = 28;
  for (int t = blockIdx.x; t < 64 * NT; t += gridDim.x) {
    int tm, tn; tile_map(t, NT, tm, tn);
    GemmT g = gt_init(2048);
    const u16* Wt = WL + WE_IN + (size_t)tn * 256 * 2048;
    const u16* Ht = H + (size_t)tm * 256 * 2048;
    const bool trans = (tn >= 8 && tn < 12) || (tn >= 20 && tn < 24);
    if (trans) { g.A = Ht; g.B = Wt; g.R0 = tm * 256; } else { g.A = Wt; g.B = Ht; g.C0 = tm * 256; }
    if (tn < 4)       { g.mode = M_BF16; g.d16 = (u16*)(p.ws + E_SQ); g.ld = 1024; g.R0 = tn * 256; g.scale = 0.08838834764831845f * 1.4426950408889634f; }
    else if (tn < 8)  { g.mode = M_BF16; g.d16 = (u16*)(p.ws + E_SK); g.ld = 1024; g.R0 = (tn - 4) * 256; }
    else if (tn < 12) { g.mode = M_TRANS; g.d16 = (u16*)(p.ws + E_SVT); g.aux = 1024; g.C0 = (tn - 8) * 256; g.perm = 1; }
    else if (tn < 16) { g.mode = M_SILU; g.d16 = (u16*)(p.ws + E_SG); g.ld = 1024; g.R0 = (tn - 12) * 256; }
    else if (tn < 18) { g.mode = M_BF16; g.d16 = (u16*)(p.ws + E_GQ); g.ld = 512; g.R0 = (tn - 16) * 256; }
    else if (tn < 20) { g.mode = M_BF16; g.d16 = (u16*)(p.ws + E_GK); g.ld = 512; g.R0 = (tn - 18) * 256; }
    else if (tn < 24) { g.mode = M_TRANS; g.d16 = (u16*)(p.ws + E_GVT); g.aux = 1024; g.C0 = (tn - 20) * 256; }
    else              { g.mode = M_SILU; g.d16 = (u16*)(p.ws + E_GG); g.ld = 1024; g.R0 = (tn - 24) * 256; }
    g.probe = probe;
    gemm_tile8(g, smem);
  }
}

DI void phase_gemm_in_odd(const Params& p, unsigned char* smem) {
  const u16* WL = (const u16*)(p.ws + OFF_WL);
  const u16* H = (const u16*)(p.ws + OFF_H);
  const int NT = 12;
  for (int t = blockIdx.x; t < 64 * NT; t += gridDim.x) {
    int tm, tn; tile_map(t, NT, tm, tn);
    GemmT g = gt_init(2048);
    g.A = WL + WO_IN + (size_t)tn * 256 * 2048;
    g.B = H + (size_t)tm * 256 * 2048;
    g.C0 = tm * 256;
    if (tn < 2)      { g.mode = M_BF16; g.d16 = (u16*)(p.ws + O_QL); g.ld = 512; g.R0 = tn * 256; }
    else if (tn < 4) { g.mode = M_BF16; g.d16 = (u16*)(p.ws + O_KVL); g.ld = 512; g.R0 = (tn - 2) * 256; }
    else             { g.mode = M_SILU; g.d16 = (u16*)(p.ws + O_GATE); g.ld = 2048; g.R0 = (tn - 4) * 256; }
    gemm_tile8(g, smem);
  }
}

DI void phase_rstd_kr(const Params& p, unsigned char* smem) {
  for (int t = blockIdx.x; t < 64; t += gridDim.x) {
    GemmT g = gt_init(2048);
    g.A = (const u16*)(p.ws + OFF_WL) + WO_IN + (size_t)3072 * 2048;
    g.B = (const u16*)(p.ws + OFF_H) + (size_t)t * 256 * 2048;
    g.R0 = 0; g.C0 = t * 256; g.nact = 128; g.aux = 64;
    g.mode = M_ROPE; g.d16 = (u16*)(p.ws + O_KR); g.ld = 64;
    g.cs = (const float*)(p.ws + OFF_COS); g.sn = (const float*)(p.ws + OFF_SIN);
    gemm_tile8(g, smem);
  }
  const u16* QL = (const u16*)(p.ws + O_QL);
  const u16* KVL = (const u16*)(p.ws + O_KVL);
  float* RSQ = (float*)(p.ws + O_RSQ);
  float* RSKV = (float*)(p.ws + O_RSKV);
  const int wave = TIDX() >> 6, lane = TIDX() & 63;
  for (int row = blockIdx.x * 8 + wave; row < 2 * T_; row += gridDim.x * 8) {
    const int m = row >> 1;
    const u16* src = (row & 1) ? KVL : QL;
    const u32x4 v = *(const u32x4*)(src + (size_t)m * 512 + lane * 8);
    float ss = 0.f;
#pragma unroll
    for (int q = 0; q < 4; ++q) { const float a = bf_lo(v[q]), b = bf_hi(v[q]); ss += a * a + b * b; }
    ss = wave_sum(ss);
    if (lane == 0) ((row & 1) ? RSKV : RSQ)[m] = rsqrtf(ss * (1.f / 512.f) + 1e-6f);
  }
}

DI void phase_gemm_up(const Params& p, unsigned char* smem) {
  const u16* WL = (const u16*)(p.ws + OFF_WL);
  const u16* QL = (const u16*)(p.ws + O_QL);
  const u16* KVL = (const u16*)(p.ws + O_KVL);
  const float* RSQ = (const float*)(p.ws + O_RSQ);
  const float* RSKV = (const float*)(p.ws + O_RSKV);
  const float qscale = 0.07216878364870322f * 1.4426950408889634f;
  const int NT = 28;
  for (int t = blockIdx.x; t < 64 * NT; t += gridDim.x) {
    int tm, tn; tile_map(t, NT, tm, tn);
    GemmT g = gt_init(512);
    if (tn < 8) {
      g.A = WL + WO_Q + (size_t)tn * 256 * 512; g.B = QL + (size_t)tm * 256 * 512;
      g.mode = M_BF16; g.d16 = (u16*)(p.ws + O_QN); g.ld = 2048; g.R0 = tn * 256; g.C0 = tm * 256; g.rs = RSQ; g.scale = qscale;
    } else if (tn < 12) {
      g.A = WL + WO_Q + (size_t)(2048 + (tn - 8) * 256) * 512; g.B = QL + (size_t)tm * 256 * 512;
      g.mode = M_ROPE; g.d16 = (u16*)(p.ws + O_QR); g.ld = 1024; g.R0 = (tn - 8) * 256; g.C0 = tm * 256; g.aux = 256; g.rs = RSQ; g.scale = qscale;
      g.cs = (const float*)(p.ws + OFF_COS); g.sn = (const float*)(p.ws + OFF_SIN);
    } else if (tn < 20) {
      g.A = WL + WO_KV + (size_t)(tn - 12) * 256 * 512; g.B = KVL + (size_t)tm * 256 * 512;
      g.mode = M_BF16; g.d16 = (u16*)(p.ws + O_KN); g.ld = 2048; g.R0 = (tn - 12) * 256; g.C0 = tm * 256; g.rs = RSKV;
    } else {
      g.A = KVL + (size_t)tm * 256 * 512; g.B = WL + WO_KV + (size_t)(2048 + (tn - 20) * 256) * 512;
      g.mode = M_TRANS; g.d16 = (u16*)(p.ws + O_VT); g.aux = 2048; g.R0 = tm * 256; g.C0 = (tn - 20) * 256; g.rs = RSKV; g.perm = 1;
    }
    gemm_tile8(g, smem);
  }
}

DI void phase_gemm_out(const Params& p, int L, unsigned char* smem) {
  const bool even = (L & 1) == 0;
  const u16* WL = (const u16*)(p.ws + OFF_WL) + (even ? WE_OUT : WO_OUT);
  const u16* Y = (const u16*)(p.ws + OFF_H);
  const float* xin = (L == 0) ? p.x : p.out;
  for (int t = blockIdx.x; t < 64 * 8; t += gridDim.x) {
    int tm, tn; tile_map(t, 8, tm, tn);
    GemmT g = gt_init(2048);
    g.A = WL + (size_t)tn * 256 * 2048; g.B = Y + (size_t)tm * 256 * 2048;
    g.mode = M_RESID; g.R0 = tn * 256; g.C0 = tm * 256; g.d32 = p.out; g.xin = xin;
    gemm_tile8(g, smem);
  }
}

DI int next_item(int* ctr, int* sitem) {
  if (TIDX() == 0) *sitem = atomicAdd(ctr, 1);
  lds_barrier();
  const int it = *sitem;
  lds_barrier();
  return it;
}

DI void phase_even_mix(const Params& p, int L, int ph, unsigned char* smem, int* sitem, bool do_g1) {
  int* ctr = (int*)(p.ws + OFF_CTR) + ph;
  const int li = L >> 1;
  for (;;) {
    const int it = next_item(ctr, sitem);
    if (it >= 1536) break;
    if (it < 512) {
      const int qb = 31 - (it >> 4), bh = it & 15, b = bh >> 3, hh = bh & 7;
      const u16* SQ = (const u16*)(p.ws + E_SQ) + (size_t)b * S_ * 1024 + hh * 128;
      const u16* SK = (const u16*)(p.ws + E_SK) + (size_t)b * S_ * 1024 + hh * 128;
      const u16* SVT = (const u16*)(p.ws + E_SVT) + ((size_t)(b * 1024 + hh * 128)) * 8192;
      const u16* SG = (const u16*)(p.ws + E_SG) + (size_t)b * S_ * 1024 + hh * 128;
      u16* Y = (u16*)(p.ws + OFF_H) + (size_t)b * S_ * 2048 + hh * 128;
      attn_item<128, true, 1024, 0, 1024, 0, 1024>(SQ, nullptr, SK, nullptr, SVT, SG, Y, qb * 256, smem);
    } else {
      if (do_g1) gla_g1(p, li, it - 512, smem);
    }
  }
}

DI void phase_gla_out(const Params& p, int L, int ph, unsigned char* smem, int* sitem) {
  int* ctr = (int*)(p.ws + OFF_CTR) + ph;
  const int li = L >> 1;
  for (;;) {
    const int it = next_item(ctr, sitem);
    if (it >= 1024) break;
    gla_g3(p, li, it, smem);
  }
}

DI void mla_item(const Params& p, int bh, int qb, unsigned char* smem, int probe) {
  const int b = bh >> 4, hh = bh & 15;
  const u16* QN = (const u16*)(p.ws + O_QN) + (size_t)b * S_ * 2048 + hh * 128;
  const u16* QR = (const u16*)(p.ws + O_QR) + (size_t)b * S_ * 1024 + hh * 64;
  const u16* KN = (const u16*)(p.ws + O_KN) + (size_t)b * S_ * 2048 + hh * 128;
  const u16* KR = (const u16*)(p.ws + O_KR) + (size_t)b * S_ * 64;
  const u16* VT = (const u16*)(p.ws + O_VT) + ((size_t)(b * 2048 + hh * 128)) * 8192;
  const u16* GT = (const u16*)(p.ws + O_GATE) + (size_t)b * S_ * 2048 + hh * 128;
  u16* Y = (u16*)(p.ws + OFF_H) + (size_t)b * S_ * 2048 + hh * 128;
  attn_item<192, false, 2048, 1024, 2048, 64, 2048>(QN, QR, KN, KR, VT, GT, Y, qb * 256, smem, probe);
}

DI void phase_mla(const Params& p, int ph, unsigned char* smem, int* sitem, int probe) {
  if (gridDim.x == 256) {
    const int x = blockIdx.x & 7, j = blockIdx.x >> 3, half = j >> 4, jp = j & 15;
#pragma unroll 1
    for (int pass = 0; pass < 2; ++pass) {
      const int bh = 4 * x + 2 * pass + half;
      mla_item(p, bh, 31 - jp, smem, probe);
      mla_item(p, bh, jp, smem, probe);
    }
    return;
  }
  int* ctr = (int*)(p.ws + OFF_CTR) + 64 + (ph % 24) * 8;
  const int x = (int)(xb_xcc_id() & 7u);
  for (;;) {
    if (TIDX() == 0) {
      int it = -1;
      for (int k = 0; k < 8; ++k) {
        const int q = (x + k) & 7;
        const int v = atomicAdd(ctr + q, 1);
        if (v < 128) { it = q * 128 + v; break; }
      }
      *sitem = it;
    }
    __syncthreads();
    const int it = *sitem;
    __syncthreads();
    if (it < 0) break;
    const int q = it >> 7, v = it & 127;
    mla_item(p, 4 * q + (v >> 5), 31 - (v & 31), smem, probe);
  }
}

DI void phase_final(const Params& p) {
  const int wave = TIDX() >> 6;
  for (int row = blockIdx.x * 8 + wave; row < T_; row += gridDim.x * 8)
    norm_row<false>(p.out + (size_t)row * 2048, p.final_norm, nullptr, p.out + (size_t)row * 2048, nullptr, nullptr);
}

__global__ void __launch_bounds__(512, 2) fwd_kernel(Params p_arg, int ph0, int ph1) {
  __shared__ __attribute__((aligned(16))) unsigned char smem[SMEM_BYTES + 64];
  int& sitem = *(int*)(smem + SMEM_BYTES);
  uint4& xb_words = *(uint4*)(smem + SMEM_BYTES + 16);
  cg::grid_group grid = cg::this_grid();
  if (__builtin_amdgcn_workitem_id_x() == 0) xb_words = make_uint4(0u, 0u, 0u, 0u);
  __syncthreads();
  XcdBarrier xb = xcd_barrier_post((unsigned*)(p_arg.ws + OFF_BAR), (volatile LAS unsigned*)&xb_words);
  if (ph1 > 1000) grid.sync();
  typedef const __attribute__((address_space(4))) Params* KP;
  const KP kp0 = (KP)__builtin_amdgcn_kernarg_segment_ptr();
  for (int ph = ph0; ph < ph1; ++ph) {
   for (int rep = 0; rep < 2; ++rep) {
    if (rep == 1) { if (!((REPEAT_MASK >> ph) & 1)) break; xcd_barrier(xb); }
    const int cph = ph + 32 * rep;
    KP kq = kp0;
    asm volatile("" : "+s"(kq));
    const Params& p = *(const Params*)kq;
    if (ph == 24) {
      phase_final(p);
    } else {
      const int L = ph / 6, sub = ph % 6;
      const bool even = (L & 1) == 0;
      if (sub == 0) { if (PH_MASK & 1) phase_prep(p, L, smem); }
      else if (sub == 1) { if (even) { if (PH_MASK & 2) phase_gemm_in_even(p, smem, rep); } else { if (PH_MASK & 4) phase_gemm_in_odd(p, smem); } }
      else if (sub == 2) { if (even) { if (PH_MASK & 8) phase_even_mix(p, L, cph, smem, &sitem, rep == 0); } else { if (PH_MASK & 16) phase_rstd_kr(p, smem); } }
      else if (sub == 3) { if (even) { if (PH_MASK & 32) gla_scan(p); } else { if (PH_MASK & 64) phase_gemm_up(p, smem); } }
      else if (sub == 4) { if (even) { if (PH_MASK & 128) phase_gla_out(p, L, cph, smem, &sitem); } else { if (PH_MASK & 256) phase_mla(p, cph, smem, &sitem, rep); } }
      else { if (PH_MASK & 512) phase_gemm_out(p, L, smem); }
    }
   }
    if (ph + 1 < ph1) xcd_barrier(xb);
  }
}

extern "C" void kernel_launch(void* const* d_in, const int* in_sizes, int n_in, void* d_out, int out_size,
                              void* d_ws, size_t ws_size, hipStream_t stream) {
  static int grid_blocks = 0;
  if (!grid_blocks) {
    int dev = 0, cus = 0, per_cu = 0;
    (void)hipGetDevice(&dev);
    (void)hipDeviceGetAttribute(&cus, hipDeviceAttributeMultiprocessorCount, dev);
    (void)hipOccupancyMaxActiveBlocksPerMultiprocessor(&per_cu, fwd_kernel, 512, 0);
    if (per_cu < 1) per_cu = 1;
    if (per_cu > 1) per_cu = 1;
    grid_blocks = cus * per_cu;
  }
  if (ws_size < WS_NEED) { fprintf(stderr, "workspace too small: %zu\n", ws_size); return; }
  Params p{};
  p.x = (const float*)d_in[0]; p.pos = (const int*)d_in[1];
  p.ln_even = (const float*)d_in[2]; p.w_in_even = (const float*)d_in[3];
  p.alpha_up = (const float*)d_in[4]; p.alpha_bias = (const float*)d_in[5];
  p.gla_norm = (const float*)d_in[6]; p.w_out_even = (const float*)d_in[7];
  p.ln_odd = (const float*)d_in[8]; p.w_in_odd = (const float*)d_in[9];
  p.q_norm = (const float*)d_in[10]; p.w_q_up = (const float*)d_in[11];
  p.kv_norm = (const float*)d_in[12]; p.w_kv_up = (const float*)d_in[13];
  p.w_out_odd = (const float*)d_in[14]; p.final_norm = (const float*)d_in[15];
  p.out = (float*)d_out; p.ws = (unsigned char*)d_ws;
  (void)hipMemsetAsync((unsigned char*)d_ws + OFF_CTR, 0, 16384, stream);
  int a0 = 0, a1 = NPHASE;
  void* args[] = {&p, &a0, &a1};
  hipError_t e = hipLaunchCooperativeKernel((void*)fwd_kernel, dim3(grid_blocks), dim3(512), args, 0, stream);
  if (e != hipSuccess) fprintf(stderr, "cooperative launch failed: %s (grid %d)\n", hipGetErrorString(e), grid_blocks);
}
```

```cpp
#include <hip/hip_runtime.h>
#include <hip/hip_cooperative_groups.h>
#include <cstdio>
#include <cstdint>
#include <type_traits>
namespace cg = cooperative_groups;

#ifndef ONE_LAUNCH
#define ONE_LAUNCH 1
#endif

#ifndef REPEAT_MASK
#define REPEAT_MASK 0
#endif
#ifndef PROBE_MODE
#define PROBE_MODE 0
#endif
#ifndef PH_MASK
#define PH_MASK 0xFFFF
#endif
#define DI __device__ __forceinline__
typedef unsigned short u16;
using bf16x8 = __attribute__((ext_vector_type(8))) short;
using s16x4  = __attribute__((ext_vector_type(4))) short;
using f32x16 = __attribute__((ext_vector_type(16))) float;
using u32x4  = __attribute__((ext_vector_type(4))) unsigned;
using u32x2  = __attribute__((ext_vector_type(2))) unsigned;
#define MFMA32(a, b, c) __builtin_amdgcn_mfma_f32_32x32x16_bf16((a), (b), (c), 0, 0, 0)

constexpr int S_ = 8192;
constexpr int T_ = 16384;
constexpr size_t MiB = (size_t)1 << 20;

constexpr size_t OFF_WL = 0;
constexpr size_t OFF_H  = 40 * MiB;
constexpr size_t OFF_L  = 104 * MiB;
constexpr size_t E_SQ  = OFF_L + 0 * MiB;
constexpr size_t E_SK  = OFF_L + 32 * MiB;
constexpr size_t E_SVT = OFF_L + 64 * MiB;
constexpr size_t E_SG  = OFF_L + 96 * MiB;
constexpr size_t E_GQ  = OFF_L + 128 * MiB;
constexpr size_t E_GK  = OFF_L + 144 * MiB;
constexpr size_t E_GVT = OFF_L + 160 * MiB;
constexpr size_t E_GG  = OFF_L + 192 * MiB;
constexpr size_t E_GA  = OFF_L + 224 * MiB;
constexpr size_t E_EBL = OFF_L + 225 * MiB;
constexpr size_t E_SC  = OFF_L + 226 * MiB;
constexpr size_t O_QL   = OFF_L + 0 * MiB;
constexpr size_t O_KVL  = OFF_L + 16 * MiB;
constexpr size_t O_GATE = OFF_L + 32 * MiB;
constexpr size_t O_KR   = OFF_L + 96 * MiB;
constexpr size_t O_RSQ  = OFF_L + 98 * MiB;
constexpr size_t O_RSKV = OFF_L + 98 * MiB + 65536;
constexpr size_t O_QN   = OFF_L + 99 * MiB;
constexpr size_t O_QR   = OFF_L + 163 * MiB;
constexpr size_t O_KN   = OFF_L + 195 * MiB;
constexpr size_t O_VT   = OFF_L + 259 * MiB;
constexpr size_t OFF_COS = 460 * MiB;
constexpr size_t OFF_SIN = 462 * MiB;
constexpr size_t OFF_CTR = 464 * MiB;
constexpr size_t OFF_BAR = 464 * MiB + 1024;
constexpr size_t WS_NEED = 465 * MiB;

constexpr size_t WE_IN = 0;
constexpr size_t WE_OUT = (size_t)7168 * 2048;
constexpr size_t WO_IN = 0;
constexpr size_t WO_Q = (size_t)3328 * 2048;
constexpr size_t WO_KV = WO_Q + (size_t)3072 * 512;
constexpr size_t WO_OUT = WO_KV + (size_t)4096 * 512;

constexpr int NPHASE = 25;
constexpr int SMEM_BYTES = 147456;

struct Params {
  const float* x; const int* pos;
  const float* ln_even; const float* w_in_even; const float* alpha_up; const float* alpha_bias;
  const float* gla_norm; const float* w_out_even;
  const float* ln_odd; const float* w_in_odd; const float* q_norm; const float* w_q_up;
  const float* kv_norm; const float* w_kv_up; const float* w_out_odd;
  const float* final_norm;
  float* out; unsigned char* ws;
};

DI unsigned pack_bf16(float a, float b) {
  typedef __bf16 bf2 __attribute__((ext_vector_type(2)));
  typedef float f2 __attribute__((ext_vector_type(2)));
  f2 v = {a, b};
  bf2 r = __builtin_convertvector(v, bf2);
  return __builtin_bit_cast(unsigned, r);
}
DI u16 to_bf16(float a) { return (u16)(pack_bf16(a, 0.f) & 0xffffu); }
DI float bf_lo(unsigned w) { return __uint_as_float(w << 16); }
DI float bf_hi(unsigned w) { return __uint_as_float(w & 0xffff0000u); }
DI int TIDX() { int t = __builtin_amdgcn_workitem_id_x(); asm volatile("" : "+v"(t)); return t; }
DI int crow(int reg, int h) { return (reg & 3) + 8 * (reg >> 2) + 4 * h; }
DI float xh_max(float x) {
  const auto r = __builtin_amdgcn_permlane32_swap(__float_as_uint(x), __float_as_uint(x), false, false);
  return fmaxf(__uint_as_float(r[0]), __uint_as_float(r[1]));
}
DI float xh_sum(float x) {
  const auto r = __builtin_amdgcn_permlane32_swap(__float_as_uint(x), __float_as_uint(x), false, false);
  return __uint_as_float(r[0]) + __uint_as_float(r[1]);
}
DI float xh_partner(float x, int h) {
  const auto r = __builtin_amdgcn_permlane32_swap(__float_as_uint(x), __float_as_uint(x), false, false);
  return h ? __uint_as_float(r[0]) : __uint_as_float(r[1]);
}
DI float dpp_add(float v, const int ctrl_tag) {
  int r;
  if (ctrl_tag == 0) r = __builtin_amdgcn_update_dpp(0, __float_as_int(v), 0xB1, 0xf, 0xf, true);
  else if (ctrl_tag == 1) r = __builtin_amdgcn_update_dpp(0, __float_as_int(v), 0x4E, 0xf, 0xf, true);
  else if (ctrl_tag == 2) r = __builtin_amdgcn_update_dpp(0, __float_as_int(v), 0x141, 0xf, 0xf, true);
  else r = __builtin_amdgcn_update_dpp(0, __float_as_int(v), 0x140, 0xf, 0xf, true);
  return v + __int_as_float(r);
}
DI float wave_sum(float v) {
  v = dpp_add(v, 0); v = dpp_add(v, 1); v = dpp_add(v, 2); v = dpp_add(v, 3);
  { const auto r = __builtin_amdgcn_permlane16_swap(__float_as_uint(v), __float_as_uint(v), false, false);
    v = __uint_as_float(r[0]) + __uint_as_float(r[1]); }
  return xh_sum(v);
}
DI float silu_f(float v) { return v * __builtin_amdgcn_rcpf(1.f + __expf(-v)); }
DI bf16x8 pack8(const f32x16& x, int s) {
  u32x4 p;
  p[0] = pack_bf16(x[8 * s + 0], x[8 * s + 1]);
  p[1] = pack_bf16(x[8 * s + 2], x[8 * s + 3]);
  p[2] = pack_bf16(x[8 * s + 4], x[8 * s + 5]);
  p[3] = pack_bf16(x[8 * s + 6], x[8 * s + 7]);
  return __builtin_bit_cast(bf16x8, p);
}

DI void convert_tile(const float* __restrict__ src, int ldn, const float* __restrict__ gain,
                     u16* __restrict__ dst, int K, int k0, int nd0, int ns0, int nvalid, float* lds) {
  const int tid = TIDX();
  const int c = tid & 63, r0 = tid >> 6;
#pragma unroll
  for (int i = 0; i < 8; ++i) {
    const int r = r0 + 8 * i;
    float v = 0.f;
    if (c < nvalid) {
      v = src[(size_t)(k0 + r) * ldn + ns0 + c];
      if (gain) v *= gain[k0 + r];
    }
    lds[r * 65 + c] = v;
  }
  __syncthreads();
  const int kk = (tid & 31) * 2, n = tid >> 5;
#pragma unroll
  for (int i = 0; i < 4; ++i) {
    const int nn = n + 16 * i;
    const unsigned pk = pack_bf16(lds[kk * 65 + nn], lds[(kk + 1) * 65 + nn]);
    *(unsigned*)(dst + (size_t)(nd0 + nn) * K + k0 + kk) = pk;
  }
  __syncthreads();
}

DI int src_col(int mode, int nd) {
  if (mode == 0) return nd;
  if (mode == 1) return nd < 1024 ? nd : (nd < 3072 ? nd + 64 : (nd < 3136 ? nd - 2048 : -1));
  if (mode == 2) return nd < 2048 ? (nd >> 7) * 192 + (nd & 127) : ((nd - 2048) >> 6) * 192 + 128;
  return nd < 2048 ? (nd >> 7) * 256 + (nd & 127) : ((nd - 2048) >> 7) * 256 + 128 + ((nd - 2048) & 127);
}
DI void convert_tile256(const float* __restrict__ src, int ldn, const float* __restrict__ gain,
                        u16* __restrict__ dst, int K, int k0, int nd0, int mode, float* lds) {
  constexpr int LDW = 260;
  const int tid = TIDX();
  {
    const int col4 = tid & 63, row0 = tid >> 6;
    const int nd = nd0 + col4 * 4;
    const int sc = src_col(mode, nd & ~63);
    const float* sp = src + (size_t)(k0 + row0) * ldn + (sc + (nd & 63));
#pragma unroll
    for (int i = 0; i < 8; ++i) {
      float z = 0.f;
      asm volatile("" : "+v"(z));
      float4 v = make_float4(z, z, z, z);
      if (sc >= 0) {
        v = *(const float4*)(sp + (size_t)(8 * i) * ldn);
        if (gain) { const float gg = gain[k0 + row0 + 8 * i]; v.x *= gg; v.y *= gg; v.z *= gg; v.w *= gg; }
      }
      *(float4*)(lds + (row0 + 8 * i) * LDW + col4 * 4) = v;
    }
  }
  __syncthreads();
  {
    const int kc = tid & 7;
#pragma unroll
    for (int j = 0; j < 4; ++j) {
      const int n = (tid >> 3) + 64 * j;
      const float* lp = lds + (kc * 8) * LDW + n;
      u32x4 pk;
      pk[0] = pack_bf16(lp[0 * LDW], lp[1 * LDW]);
      pk[1] = pack_bf16(lp[2 * LDW], lp[3 * LDW]);
      pk[2] = pack_bf16(lp[4 * LDW], lp[5 * LDW]);
      pk[3] = pack_bf16(lp[6 * LDW], lp[7 * LDW]);
      *(u32x4*)(dst + (size_t)(nd0 + n) * K + k0 + kc * 8) = pk;
    }
  }
  __syncthreads();
}

template <bool GA>
DI void norm_row(const float* __restrict__ xrow, const float* __restrict__ g, u16* __restrict__ hrow,
                 float* __restrict__ orow, const float* wg, float* __restrict__ garow) {
  const int lane = TIDX() & 63;
  float4 v[8];
  float ss = 0.f;
#pragma unroll
  for (int i = 0; i < 8; ++i) {
    v[i] = ((const float4*)xrow)[lane + 64 * i];
    ss += v[i].x * v[i].x + v[i].y * v[i].y + v[i].z * v[i].z + v[i].w * v[i].w;
  }
  ss = wave_sum(ss);
  const float rstd = rsqrtf(ss * (1.f / 2048.f) + 1e-6f);
  float ga[16];
  if constexpr (GA) {
#pragma unroll
    for (int c = 0; c < 16; ++c) ga[c] = 0.f;
  }
#pragma unroll
  for (int i = 0; i < 8; ++i) {
    const float4 gg = ((const float4*)g)[lane + 64 * i];
    const float a = v[i].x * rstd * gg.x, b = v[i].y * rstd * gg.y, c = v[i].z * rstd * gg.z, d = v[i].w * rstd * gg.w;
    if (hrow) {
      u32x2 o; o[0] = pack_bf16(a, b); o[1] = pack_bf16(c, d);
      ((u32x2*)hrow)[lane + 64 * i] = o;
    } else {
      ((float4*)orow)[lane + 64 * i] = make_float4(a, b, c, d);
    }
    if constexpr (GA) {
#pragma unroll
      for (int cc = 0; cc < 16; ++cc) {
        const float4 w = ((const float4*)(wg + cc * 2052))[lane + 64 * i];
        ga[cc] += a * w.x + b * w.y + c * w.z + d * w.w;
      }
    }
  }
  if constexpr (GA) {
    float mine = 0.f;
#pragma unroll
    for (int cc = 0; cc < 16; ++cc) {
      const float t = wave_sum(ga[cc]);
      if (lane == cc) mine = t;
    }
    if (lane < 16) garow[lane] = mine;
  }
}

enum { M_BF16 = 0, M_SILU = 1, M_TRANS = 2, M_ROPE = 4, M_RESID = 5 };
struct GemmT {
  const u16* A; const u16* B; int lda, ldb, K;
  int mode, R0, C0, ld, aux, nact, probe, perm;
  u16* d16; float* d32; float scale; const float* rs; const float* xin; const float* cs; const float* sn;
};
constexpr int LDT = 72;

DI void gemm_tile(const GemmT& g, unsigned char* smem) {
  const int tid = TIDX(), lane = tid & 63, wave = tid >> 6;
  const int wm = (wave >> 2) * 128, wn = (wave & 3) * 64;
  const int r = lane & 31, h = lane >> 5;
  u16* sA = (u16*)smem;
  u16* sB = sA + 2 * 256 * LDT;
  const int lrow = tid >> 3, lch = (tid & 7) * 8;
  const u16* Ag = g.A + (size_t)lrow * g.lda + lch;
  const u16* Bg = g.B + (size_t)lrow * g.ldb + lch;
  const bool active = wm < g.nact;
  u32x4 ra[4], rb[4];
  f32x16 acc[4][2];
#pragma unroll
  for (int i = 0; i < 4; ++i)
#pragma unroll
    for (int j = 0; j < 2; ++j)
#pragma unroll
      for (int q = 0; q < 16; ++q) acc[i][j][q] = 0.f;

#pragma unroll
  for (int i = 0; i < 4; ++i) {
    ra[i] = *(const u32x4*)(Ag + (size_t)(64 * i) * g.lda);
    rb[i] = *(const u32x4*)(Bg + (size_t)(64 * i) * g.ldb);
  }
  __syncthreads();
#pragma unroll
  for (int i = 0; i < 4; ++i) {
    *(u32x4*)(sA + (lrow + 64 * i) * LDT + lch) = ra[i];
    *(u32x4*)(sB + (lrow + 64 * i) * LDT + lch) = rb[i];
  }
#pragma unroll
  for (int i = 0; i < 4; ++i) {
    ra[i] = *(const u32x4*)(Ag + (size_t)(64 * i) * g.lda + 64);
    rb[i] = *(const u32x4*)(Bg + (size_t)(64 * i) * g.ldb + 64);
  }
  __syncthreads();
  const int KT = g.K >> 6;
  for (int kt = 0; kt < KT; ++kt) {
    if (kt + 1 < KT) {
      u16* a_d = sA + ((kt + 1) & 1) * 256 * LDT;
      u16* b_d = sB + ((kt + 1) & 1) * 256 * LDT;
#pragma unroll
      for (int i = 0; i < 4; ++i) {
        *(u32x4*)(a_d + (lrow + 64 * i) * LDT + lch) = ra[i];
        *(u32x4*)(b_d + (lrow + 64 * i) * LDT + lch) = rb[i];
      }
    }
    if (kt + 2 < KT && !(PROBE_MODE == 1 && g.probe)) {
#pragma unroll
      for (int i = 0; i < 4; ++i) {
        ra[i] = *(const u32x4*)(Ag + (size_t)(64 * i) * g.lda + (kt + 2) * 64);
        rb[i] = *(const u32x4*)(Bg + (size_t)(64 * i) * g.ldb + (kt + 2) * 64);
      }
    }
    __builtin_amdgcn_sched_barrier(0);
    if (active) {
      const u16* a_s = sA + (kt & 1) * 256 * LDT + (wm + r) * LDT + 8 * h;
      const u16* b_s = sB + (kt & 1) * 256 * LDT + (wn + r) * LDT + 8 * h;
#pragma unroll
      for (int ks = 0; ks < 4; ++ks) {
        bf16x8 af[4], bf[2];
#pragma unroll
        for (int i = 0; i < 4; ++i) af[i] = *(const bf16x8*)(a_s + 32 * i * LDT + ks * 16);
#pragma unroll
        for (int j = 0; j < 2; ++j) bf[j] = *(const bf16x8*)(b_s + 32 * j * LDT + ks * 16);
#pragma unroll
        for (int i = 0; i < 4; ++i)
#pragma unroll
          for (int j = 0; j < 2; ++j) acc[i][j] = MFMA32(af[i], bf[j], acc[i][j]);
      }
    }
    __syncthreads();
  }
  if (!active) return;
  if (PROBE_MODE && g.probe) {
    float sacc = 0.f;
#pragma unroll
    for (int i = 0; i < 4; ++i)
#pragma unroll
      for (int j = 0; j < 2; ++j)
#pragma unroll
        for (int q = 0; q < 16; ++q) sacc += acc[i][j][q];
    if (sacc == 1.2345e-30f) g.d16[0] = 0;
    return;
  }

  const int mode = g.mode;
  if (mode == M_ROPE) {
#pragma unroll
    for (int j = 0; j < 2; ++j) {
      const int tok = g.C0 + wn + 32 * j + r;
      const float sc = g.scale * (g.rs ? g.rs[tok] : 1.f);
#pragma unroll
      for (int ip = 0; ip < 2; ++ip) {
        if (wm + 64 * ip < g.aux) {
#pragma unroll
          for (int g4 = 0; g4 < 4; ++g4) {
            const int c0 = 8 * g4 + 4 * h;
            const float4 cs = *(const float4*)(g.cs + (size_t)tok * 32 + c0);
            const float4 sn = *(const float4*)(g.sn + (size_t)tok * 32 + c0);
            const float a0 = acc[2 * ip][j][4 * g4 + 0] * sc, a1 = acc[2 * ip][j][4 * g4 + 1] * sc;
            const float a2 = acc[2 * ip][j][4 * g4 + 2] * sc, a3 = acc[2 * ip][j][4 * g4 + 3] * sc;
            const float b0 = acc[2 * ip + 1][j][4 * g4 + 0] * sc, b1 = acc[2 * ip + 1][j][4 * g4 + 1] * sc;
            const float b2 = acc[2 * ip + 1][j][4 * g4 + 2] * sc, b3 = acc[2 * ip + 1][j][4 * g4 + 3] * sc;
            u32x2 o1, o2;
            o1[0] = pack_bf16(a0 * cs.x - b0 * sn.x, a1 * cs.y - b1 * sn.y);
            o1[1] = pack_bf16(a2 * cs.z - b2 * sn.z, a3 * cs.w - b3 * sn.w);
            o2[0] = pack_bf16(b0 * cs.x + a0 * sn.x, b1 * cs.y + a1 * sn.y);
            o2[1] = pack_bf16(b2 * cs.z + a2 * sn.z, b3 * cs.w + a3 * sn.w);
            u16* dp = g.d16 + (size_t)tok * g.ld + g.R0 + wm + 64 * ip + c0;
            *(u32x2*)dp = o1;
            *(u32x2*)(dp + 32) = o2;
          }
        }
      }
    }
    return;
  }
  unsigned char* wreg = smem + wave * 17408;
  if (mode == M_RESID) {
#pragma unroll
    for (int j = 0; j < 2; ++j) {
#pragma unroll
      for (int i = 0; i < 4; ++i)
#pragma unroll
        for (int g4 = 0; g4 < 4; ++g4)
          *(float4*)(wreg + r * 528 + (32 * i + 8 * g4 + 4 * h) * 4) =
              make_float4(acc[i][j][4 * g4 + 0], acc[i][j][4 * g4 + 1], acc[i][j][4 * g4 + 2], acc[i][j][4 * g4 + 3]);
#pragma unroll
      for (int it = 0; it < 16; ++it) {
        const int row = 2 * it + h;
        const float4 v = *(const float4*)(wreg + row * 528 + r * 16);
        const size_t o = (size_t)(g.C0 + wn + 32 * j + row) * 2048 + g.R0 + wm + r * 4;
        const float4 x = *(const float4*)(g.xin + o);
        *(float4*)(g.d32 + o) = make_float4(x.x + v.x, x.y + v.y, x.z + v.z, x.w + v.w);
      }
    }
    return;
  }
#pragma unroll
  for (int j = 0; j < 2; ++j) {
    const int outer = g.C0 + wn + 32 * j + r;
    const float sc = (mode == M_BF16) ? g.scale * (g.rs ? g.rs[outer] : 1.f) : 1.f;
#pragma unroll
    for (int i = 0; i < 4; ++i)
#pragma unroll
      for (int g4 = 0; g4 < 4; ++g4) {
        float v0 = acc[i][j][4 * g4 + 0], v1 = acc[i][j][4 * g4 + 1], v2 = acc[i][j][4 * g4 + 2], v3 = acc[i][j][4 * g4 + 3];
        if (mode == M_BF16) { v0 *= sc; v1 *= sc; v2 *= sc; v3 *= sc; }
        else if (mode == M_SILU) { v0 = silu_f(v0); v1 = silu_f(v1); v2 = silu_f(v2); v3 = silu_f(v3); }
        else if (g.rs) {
          const float4 r4 = *(const float4*)(g.rs + g.R0 + wm + 32 * i + 8 * g4 + 4 * h);
          v0 *= r4.x; v1 *= r4.y; v2 *= r4.z; v3 *= r4.w;
        }
        u32x2 pk; pk[0] = pack_bf16(v0, v1); pk[1] = pack_bf16(v2, v3);
        *(u32x2*)(wreg + (32 * j + r) * 272 + (32 * i + 8 * g4 + 4 * h) * 2) = pk;
      }
  }
  {
    const int inner0 = g.R0 + wm;
#pragma unroll
    for (int it = 0; it < 16; ++it) {
      const int row = 4 * it + (lane >> 4), ch = lane & 15;
      const u32x4 v = *(const u32x4*)(wreg + row * 272 + ch * 16);
      const int outer = g.C0 + wn + row;
      size_t o;
      if (mode == M_TRANS) o = ((size_t)(inner0 >> 13) * g.aux + outer) * 8192 + (inner0 & 8191);
      else o = (size_t)outer * g.ld + inner0;
      *(u32x4*)(g.d16 + o + ch * 8) = v;
    }
  }
}

using f32x4v = __attribute__((ext_vector_type(4))) float;
DI int lds_byte8(int r, int c) {
  const int st = (r >> 4) * 2 + (c >> 5), rr = r & 15, cc = c & 31, ob = rr * 64 + cc * 2;
  return st * 1024 + (ob ^ (((ob >> 9) & 1) << 5));
}
DI void stage_rc8(int b, int& R, int& C) {
  const int st = b / 1024, sb = b % 1024, swz = sb ^ (((sb >> 9) & 1) << 5);
  R = (st >> 1) * 16 + swz / 64; C = (st & 1) * 32 + (swz % 64) / 2;
}
DI void gemm_tile8(const GemmT& g, unsigned char* smem) {
  constexpr int BK = 64, HALF = 128, HT = HALF * BK;
  u16* shm = (u16*)smem;
  const u16* A = g.A; const u16* Bt = g.B; const int K = g.K;
  const int tid = TIDX();
  #define SA8(b,h) (shm+((b)*2+(h))*HT)
  #define SB8(b,h) (shm+(4+(b)*2+(h))*HT)
  unsigned soff0, soff1;
  { int r_, c_; stage_rc8(tid * 16, r_, c_); soff0 = (unsigned)(r_ * K + c_); stage_rc8(tid * 16 + 8192, r_, c_); soff1 = (unsigned)(r_ * K + c_); }
  #define STAGE8(P,BASE,br,kt) do{ const u16* _gb = (BASE) + ((long)(br)*K+(long)(kt)*BK); \
      __builtin_amdgcn_global_load_lds((const unsigned*)(_gb + soff0), (unsigned*)((char*)(P)+tid*16),16,0,0); \
      __builtin_amdgcn_global_load_lds((const unsigned*)(_gb + soff1), (unsigned*)((char*)(P)+tid*16+8192),16,0,0); }while(0)
  #define LDA8(dst,b,h) _Pragma("unroll") for(int m=0;m<4;++m) _Pragma("unroll") for(int k=0;k<2;++k) \
    dst[m][k]=*reinterpret_cast<const bf16x8*>((const char*)SA8(b,h)+lds_byte8(wr*64+m*16+fr,k*32+fq*8))
  #define LDB8(dst,b,h) _Pragma("unroll") for(int n=0;n<2;++n) _Pragma("unroll") for(int k=0;k<2;++k) \
    dst[n][k]=*reinterpret_cast<const bf16x8*>((const char*)SB8(b,h)+lds_byte8(wc*32+n*16+fr,k*32+fq*8))
  #define MMA8(ai,bj,At_,Bt_) do{__builtin_amdgcn_s_setprio(1); \
    _Pragma("unroll") for(int m=0;m<4;++m) _Pragma("unroll") for(int n=0;n<2;++n) _Pragma("unroll") for(int k=0;k<2;++k) \
      acc[ai][bj][m][n]=__builtin_amdgcn_mfma_f32_16x16x32_bf16(At_[m][k],Bt_[n][k],acc[ai][bj][m][n],0,0,0); \
    __builtin_amdgcn_s_setprio(0);}while(0)
  #define WAIT_V8(n) asm volatile("s_waitcnt vmcnt(" #n ")":::"memory")
  #define WAIT_L8(n) asm volatile("s_waitcnt lgkmcnt(" #n ")":::"memory")
  #define BAR8 __builtin_amdgcn_s_barrier()
  #define SCHED8 __builtin_amdgcn_sched_barrier(0)
  f32x4v acc[2][2][4][2];
#pragma unroll
  for (int a = 0; a < 2; ++a)
#pragma unroll
    for (int b = 0; b < 2; ++b)
#pragma unroll
      for (int m = 0; m < 4; ++m)
#pragma unroll
        for (int n = 0; n < 2; ++n) acc[a][b][m][n] = f32x4v{0.f, 0.f, 0.f, 0.f};
  {
  const int wid = tid >> 6, lane = tid & 63, wr = wid >> 2, wc = wid & 3, fr = lane & 15, fq = lane >> 4;
  bf16x8 At[4][2], B0[2][2], B1[2][2];
  const int nt = K / BK;
  asm volatile("s_waitcnt lgkmcnt(0)" ::: "memory");
  __builtin_amdgcn_s_barrier();
  STAGE8(SB8(0,0),Bt,0,0); STAGE8(SA8(0,0),A,0,0);
  STAGE8(SB8(0,1),Bt,HALF,0); STAGE8(SA8(0,1),A,HALF,0);
  if (wr == 1) BAR8;
  WAIT_V8(4); BAR8;
  STAGE8(SB8(1,0),Bt,0,1); STAGE8(SA8(1,0),A,0,1); STAGE8(SB8(1,1),Bt,HALF,1);
  WAIT_V8(6); BAR8;
  for (int t = 0; t < nt - 2; t += 2) {
    LDB8(B0,0,0); SCHED8; LDA8(At,0,0); STAGE8(SA8(1,1),A,HALF,t+1);
    WAIT_L8(8); BAR8; WAIT_L8(0); MMA8(0,0,At,B0); BAR8; SCHED8;
    LDB8(B1,0,1); STAGE8(SB8(0,0),Bt,0,t+2);
    BAR8; WAIT_L8(0); MMA8(0,1,At,B1); BAR8;
    LDA8(At,0,1); STAGE8(SA8(0,0),A,0,t+2);
    BAR8; WAIT_L8(0); MMA8(1,0,At,B0); BAR8; SCHED8;
    STAGE8(SB8(0,1),Bt,HALF,t+2);
    WAIT_V8(6); BAR8; MMA8(1,1,At,B1); BAR8;
    LDB8(B0,1,0); SCHED8; LDA8(At,1,0); STAGE8(SA8(0,1),A,HALF,t+2);
    WAIT_L8(8); BAR8; WAIT_L8(0); MMA8(0,0,At,B0); BAR8; SCHED8;
    LDB8(B1,1,1); STAGE8(SB8(1,0),Bt,0,t+3);
    BAR8; WAIT_L8(0); MMA8(0,1,At,B1); BAR8;
    LDA8(At,1,1); STAGE8(SA8(1,0),A,0,t+3);
    BAR8; WAIT_L8(0); MMA8(1,0,At,B0); BAR8; SCHED8;
    STAGE8(SB8(1,1),Bt,HALF,t+3);
    WAIT_V8(6); BAR8; MMA8(1,1,At,B1); BAR8;
  }
  { LDB8(B0,0,0); LDA8(At,0,0); STAGE8(SA8(1,1),A,HALF,nt-1);
    BAR8; WAIT_L8(0); MMA8(0,0,At,B0); BAR8;
    LDB8(B1,0,1); BAR8; WAIT_L8(0); MMA8(0,1,At,B1); BAR8;
    LDA8(At,0,1); WAIT_V8(4); BAR8; WAIT_L8(0); MMA8(1,0,At,B0); MMA8(1,1,At,B1); BAR8; }
  { LDB8(B0,1,0); LDA8(At,1,0); WAIT_V8(2); BAR8; WAIT_L8(0); MMA8(0,0,At,B0); BAR8;
    LDB8(B1,1,1); WAIT_V8(0); BAR8; WAIT_L8(0); MMA8(0,1,At,B1); BAR8;
    LDA8(At,1,1); BAR8; WAIT_L8(0); MMA8(1,0,At,B0); MMA8(1,1,At,B1); BAR8; }
  if (wr == 0) BAR8;
  }

  const int mode = g.mode;
  unsigned char* wreg;
  int lane, wr, wc, fr, fq;
  { const int t2 = TIDX(); const int w2 = t2 >> 6; lane = t2 & 63; wr = w2 >> 2; wc = w2 & 3; fr = lane & 15; fq = lane >> 4; wreg = smem + w2 * 17408; }
  if (mode == M_RESID) {
#pragma unroll
    for (int bj = 0; bj < 2; ++bj) {
#pragma unroll
      for (int ai = 0; ai < 2; ++ai)
#pragma unroll
        for (int m = 0; m < 4; ++m)
#pragma unroll
          for (int n = 0; n < 2; ++n)
            *(f32x4v*)(wreg + (n * 16 + fr) * 528 + (ai * 64 + m * 16 + fq * 4) * 4) = acc[ai][bj][m][n];
#pragma unroll
      for (int it = 0; it < 16; ++it) {
        const int row = 2 * it + (lane >> 5), c4 = lane & 31;
        const float4 v = *(const float4*)(wreg + row * 528 + c4 * 16);
        const int ai = c4 >> 4, iin = (c4 & 15) * 4;
        const size_t o = (size_t)(g.C0 + bj * 128 + wc * 32 + row) * 2048 + g.R0 + ai * 128 + wr * 64 + iin;
        const float4 x = *(const float4*)(g.xin + o);
        *(float4*)(g.d32 + o) = make_float4(x.x + v.x, x.y + v.y, x.z + v.z, x.w + v.w);
      }
    }
    return;
  }
  if (mode == M_ROPE) {
#pragma unroll
    for (int bj = 0; bj < 2; ++bj)
#pragma unroll
      for (int n = 0; n < 2; ++n) {
        const int tok = g.C0 + bj * 128 + wc * 32 + n * 16 + fr;
        const float sc = g.scale * (g.rs ? g.rs[tok] : 1.f);
#pragma unroll
        for (int ai = 0; ai < 2; ++ai) {
          if (ai * 128 + wr * 64 < g.aux) {
#pragma unroll
            for (int m = 0; m < 2; ++m) {
              const int c0 = m * 16 + fq * 4;
              const float4 cs = *(const float4*)(g.cs + (size_t)tok * 32 + c0);
              const float4 sn = *(const float4*)(g.sn + (size_t)tok * 32 + c0);
              const f32x4v a = acc[ai][bj][m][n] * sc, b = acc[ai][bj][m + 2][n] * sc;
              u32x2 o1, o2;
              o1[0] = pack_bf16(a[0] * cs.x - b[0] * sn.x, a[1] * cs.y - b[1] * sn.y);
              o1[1] = pack_bf16(a[2] * cs.z - b[2] * sn.z, a[3] * cs.w - b[3] * sn.w);
              o2[0] = pack_bf16(b[0] * cs.x + a[0] * sn.x, b[1] * cs.y + a[1] * sn.y);
              o2[1] = pack_bf16(b[2] * cs.z + a[2] * sn.z, b[3] * cs.w + a[3] * sn.w);
              u16* dp = g.d16 + (size_t)tok * g.ld + g.R0 + ai * 128 + wr * 64 + c0;
              *(u32x2*)dp = o1;
              *(u32x2*)(dp + 32) = o2;
            }
          }
        }
      }
    return;
  }
  {
    const int fqp = g.perm ? (((fq & 1) << 1) | (fq >> 1)) : fq;
    unsigned char* wb = wreg + fr * 272 + fqp * 8;
    if (mode == M_BF16) {
#pragma unroll
      for (int bj = 0; bj < 2; ++bj)
#pragma unroll
        for (int n = 0; n < 2; ++n) {
          const int outer = g.C0 + bj * 128 + wc * 32 + n * 16 + fr;
          const float sc = g.scale * (g.rs ? g.rs[outer] : 1.f);
#pragma unroll
          for (int ai = 0; ai < 2; ++ai)
#pragma unroll
            for (int m = 0; m < 4; ++m) {
              const f32x4v v = acc[ai][bj][m][n] * sc;
              u32x2 pk; pk[0] = pack_bf16(v[0], v[1]); pk[1] = pack_bf16(v[2], v[3]);
              *(u32x2*)(wb + (bj * 32 + n * 16) * 272 + (ai * 64 + m * 16) * 2) = pk;
            }
        }
    } else if (mode == M_SILU) {
#pragma unroll
      for (int bj = 0; bj < 2; ++bj)
#pragma unroll
        for (int n = 0; n < 2; ++n)
#pragma unroll
          for (int ai = 0; ai < 2; ++ai)
#pragma unroll
            for (int m = 0; m < 4; ++m) {
              const f32x4v v = acc[ai][bj][m][n];
              u32x2 pk; pk[0] = pack_bf16(silu_f(v[0]), silu_f(v[1])); pk[1] = pack_bf16(silu_f(v[2]), silu_f(v[3]));
              *(u32x2*)(wb + (bj * 32 + n * 16) * 272 + (ai * 64 + m * 16) * 2) = pk;
            }
    } else {
      const float* rsp = g.rs ? g.rs + g.R0 + wr * 64 + fq * 4 : nullptr;
#pragma unroll
      for (int ai = 0; ai < 2; ++ai)
#pragma unroll
        for (int m = 0; m < 4; ++m) {
          float4 r4 = make_float4(1.f, 1.f, 1.f, 1.f);
          if (rsp) r4 = *(const float4*)(rsp + ai * 128 + m * 16);
#pragma unroll
          for (int bj = 0; bj < 2; ++bj)
#pragma unroll
            for (int n = 0; n < 2; ++n) {
              const f32x4v v = acc[ai][bj][m][n];
              u32x2 pk; pk[0] = pack_bf16(v[0] * r4.x, v[1] * r4.y); pk[1] = pack_bf16(v[2] * r4.z, v[3] * r4.w);
              *(u32x2*)(wb + (bj * 32 + n * 16) * 272 + (ai * 64 + m * 16) * 2) = pk;
            }
        }
    }
  }
  {
    const int ch = lane & 15, rsub = lane >> 4, ai = ch >> 3;
    const int outer0 = g.C0 + wc * 32 + rsub;
    const int inner0 = g.R0 + ai * 128 + wr * 64 + (ch & 7) * 8;
    size_t obase, ostride;
    if (mode == M_TRANS) { obase = ((size_t)(inner0 >> 13) * g.aux + outer0) * 8192 + (inner0 & 8191); ostride = 8192; }
    else { obase = (size_t)outer0 * g.ld + inner0; ostride = (size_t)g.ld; }
    const unsigned char* rb = wreg + rsub * 272 + ch * 16;
    u16* dp = g.d16 + obase;
#pragma unroll
    for (int it = 0; it < 16; ++it) {
      const u32x4 v = *(const u32x4*)(rb + it * 4 * 272);
      *(u32x4*)(dp + (size_t)((it >> 3) * 128 + (it & 7) * 4) * ostride) = v;
    }
  }
}

template <int DK, bool SB, int LDQN, int LDQR, int LDKN, int LDKR, int LDG>
DI void attn_item(const u16* __restrict__ Qn, const u16* __restrict__ Qr,
                  const u16* __restrict__ Kn, const u16* __restrict__ Kr,
                  const u16* __restrict__ Vt, const u16* __restrict__ Gt,
                  u16* __restrict__ Y, int q0, unsigned char* smem, int probe = 0) {
  constexpr int KS = DK / 16;
  constexpr int KROW_B = DK * 2;
  constexpr int KCH = DK / 8;
  constexpr int K_B = 64 * KROW_B;
  constexpr int STAGE_B = K_B + 128 * 128;
  constexpr int NKI = K_B / 8192;
  constexpr int G = NKI + 2;
  volatile __attribute__((address_space(3))) int* sflag = (volatile __attribute__((address_space(3))) int*)(smem + 3 * STAGE_B);
  const int tid = TIDX(), lane = tid & 63, wave = tid >> 6;
  const int r = lane & 31, h = lane >> 5;
  const int qrow = q0 + 32 * wave + r;
  const int qmin = q0 + 32 * wave, qmax = qmin + 31;

  bf16x8 bq[KS];
  {
    const u16* qp = Qn + (unsigned)(qrow * LDQN + 8 * h);
#pragma unroll
    for (int ks = 0; ks < 8; ++ks) bq[ks] = *(const bf16x8*)(qp + 16 * ks);
    if constexpr (!SB) {
      const u16* qp2 = Qr + (unsigned)(qrow * LDQR + 8 * h);
#pragma unroll
      for (int ks = 8; ks < KS; ++ks) bq[ks] = *(const bf16x8*)(qp2 + 16 * (ks - 8));
    }
  }
  f32x16 O[4];
#pragma unroll
  for (int d = 0; d < 4; ++d)
#pragma unroll
    for (int q = 0; q < 16; ++q) O[d][q] = 0.f;
  float m_run = -INFINITY, l_run = 0.f, R = 0.f;
  const int nt = (q0 >> 6) + 4;

  const u16* kbase[NKI]; unsigned isr = 0u; unsigned voff0;
#pragma unroll
  for (int j = 0; j < NKI; ++j) {
    const int L = 64 * (wave + 8 * j) + lane, row = L / KCH, p = L - row * KCH;
    const int c = SB ? (p ^ (row & 15)) : ((p & ~7) | ((p & 7) ^ ((row >> 1) & 7)));
    if (SB || c < 16) { kbase[j] = Kn + (unsigned)(row * LDKN + c * 8); }
    else { kbase[j] = Kr + (unsigned)(row * LDKR + (c - 16) * 8); isr |= 1u << j; }
  }
  {
    const int L = 64 * wave + lane, row = L >> 3, p = L & 7;
    voff0 = (unsigned)(row * 8192 + (p ^ ((row >> 1) & 7)) * 8);
  }
  auto issue_tile = [&](int kt, int st) {
    unsigned char* sKb = smem + st * STAGE_B;
#pragma unroll
    for (int j = 0; j < NKI; ++j) {
      const unsigned kstr = ((isr >> j) & 1u) ? 64u * LDKR : 64u * LDKN;
      __builtin_amdgcn_global_load_lds((const unsigned*)(kbase[j] + (size_t)kt * kstr),
                                       (unsigned*)(sKb + (wave + 8 * j) * 1024), 16, 0, 0);
    }
    const u16* vb_ = Vt + kt * 64;
#pragma unroll
    for (int j = 0; j < 2; ++j)
      __builtin_amdgcn_global_load_lds((const unsigned*)(vb_ + (size_t)j * 64 * 8192 + voff0),
                                       (unsigned*)(sKb + K_B + (wave + 8 * j) * 1024), 16, 0, 0);
  };
  const int s3 = (r >> 1) & 7, s4 = r & 15;

  asm volatile("s_waitcnt vmcnt(0)" ::: "memory");
  __syncthreads();
  issue_tile(SB ? nt - 1 : 0, 0);
  issue_tile(SB ? nt - 2 : 1, 1);
  asm volatile("s_waitcnt vmcnt(%0)" :: "n"(G) : "memory");
  asm volatile("s_waitcnt lgkmcnt(0)" ::: "memory");
  __builtin_amdgcn_s_barrier();
  auto tile_body = [&](int it, auto st_c) -> bool {
    constexpr int ST = decltype(st_c)::value;
    const int kt = SB ? (nt - 1 - it) : it;
    if (it + 2 < nt && !(PROBE_MODE == 3 && probe)) issue_tile(SB ? (nt - 3 - it) : (it + 2), (ST + 2) % 3);
    __builtin_amdgcn_sched_barrier(0);
    const unsigned char* sK = smem + ST * STAGE_B;
    const unsigned char* sV = sK + K_B;
    auto kchunk = [&](int ks) -> int {
      const int c = 2 * ks + h;
      return (SB ? (c ^ s4) : ((c & ~7) | ((c & 7) ^ s3))) * 16;
    };
    const int kbA = SB ? 1 : 0, kbB = SB ? 0 : 1;
    const int keyA = kt * 64 + 32 * kbA, keyB = kt * 64 + 32 * kbB;
    const bool skipA = SB ? (keyA >= qmax) : (keyA > qmax);
    const bool skipB = SB ? (keyB >= qmax) : (keyB > qmax);
    f32x16 SA_, SB_;
    {
      bf16x8 kf[KS];
      if (!skipA) {
        const unsigned char* kp = sK + (32 * kbA + r) * KROW_B;
#pragma unroll
        for (int ks = 0; ks < KS; ++ks) kf[ks] = *(const bf16x8*)(kp + kchunk(ks));
#pragma unroll
        for (int q = 0; q < 16; ++q) SA_[q] = 0.f;
        __builtin_amdgcn_sched_barrier(0);
#pragma unroll
        for (int ks = 0; ks < KS; ++ks) SA_ = MFMA32(kf[ks], bq[ks], SA_);
        __builtin_amdgcn_sched_barrier(0);
      }
      if (!skipB) {
        const unsigned char* kp = sK + (32 * kbB + r) * KROW_B;
#pragma unroll
        for (int ks = 0; ks < KS; ++ks) kf[ks] = *(const bf16x8*)(kp + kchunk(ks));
#pragma unroll
        for (int q = 0; q < 16; ++q) SB_[q] = 0.f;
        __builtin_amdgcn_sched_barrier(0);
#pragma unroll
        for (int ks = 0; ks < KS; ++ks) SB_ = MFMA32(kf[ks], bq[ks], SB_);
        __builtin_amdgcn_sched_barrier(0);
      }
    }
    auto math_pv = [&](f32x16& Sx, const int kb, const int key0) {
      bf16x8 vf[8];
#pragma unroll
      for (int d = 0; d < 4; ++d) vf[d] = *(const bf16x8*)(sV + (32 * d + r) * 128 + (((4 * kb + h) ^ s3) * 16));
      __builtin_amdgcn_sched_barrier(0);
      if constexpr (!SB) {
       if (!(PROBE_MODE == 4 && probe)) {
        if (key0 + 31 > qmin) {
#pragma unroll
          for (int q = 0; q < 16; ++q)
            if (key0 + crow(q, h) > qrow) Sx[q] = -INFINITY;
        }
        float mloc = Sx[0];
#pragma unroll
        for (int q = 1; q < 16; ++q) mloc = fmaxf(mloc, Sx[q]);
        mloc = xh_max(mloc);
        float mnew = m_run, alpha = 1.f;
        const bool need = __builtin_amdgcn_ballot_w64(mloc > m_run + 8.f) != 0ull;
        if (need) {
          mnew = fmaxf(m_run, mloc);
          alpha = __builtin_amdgcn_exp2f(m_run - mnew);
          m_run = mnew;
        }
        typedef float f32x2v __attribute__((ext_vector_type(2)));
        const f32x2v mm = {mnew, mnew};
        f32x2v ls2 = {0.f, 0.f};
#pragma unroll
        for (int q = 0; q < 8; ++q) {
          f32x2v t = {Sx[2 * q], Sx[2 * q + 1]};
          t = t - mm;
          t[0] = __builtin_amdgcn_exp2f(t[0]);
          t[1] = __builtin_amdgcn_exp2f(t[1]);
          Sx[2 * q] = t[0]; Sx[2 * q + 1] = t[1];
          ls2 = ls2 + t;
        }
        const float lsum = ls2[0] + ls2[1];
        l_run = l_run * alpha + lsum;
        if (need) {
#pragma unroll
          for (int d = 0; d < 4; ++d)
#pragma unroll
            for (int q = 0; q < 16; ++q) O[d][q] *= alpha;
        }
       }
      } else {
        f32x16 Lx;
        float gs[4], ps[4];
        if (key0 + 31 < qmin) {
#pragma unroll
          for (int q = 0; q < 16; ++q) {
            const float z0 = Sx[q];
            Lx[q] = -(fmaxf(z0, 0.f) + __builtin_amdgcn_logf(1.f + __builtin_amdgcn_exp2f(-fabsf(z0))));
          }
#pragma unroll
          for (int gq = 0; gq < 4; ++gq) {
            gs[gq] = (Lx[4 * gq] + Lx[4 * gq + 1]) + (Lx[4 * gq + 2] + Lx[4 * gq + 3]);
            ps[gq] = xh_partner(gs[gq], h);
          }
          float run = 0.f;
#pragma unroll
          for (int gq = 3; gq >= 0; --gq) {
            const float own = R + run + (h == 0 ? ps[gq] : 0.f);
            run += gs[gq] + ps[gq];
            const float a3 = own, a2 = a3 + Lx[4 * gq + 3], a1 = a2 + Lx[4 * gq + 2], a0 = a1 + Lx[4 * gq + 1];
            Sx[4 * gq + 0] = __builtin_amdgcn_exp2f(Sx[4 * gq + 0] + Lx[4 * gq + 0] + a0);
            Sx[4 * gq + 1] = __builtin_amdgcn_exp2f(Sx[4 * gq + 1] + Lx[4 * gq + 1] + a1);
            Sx[4 * gq + 2] = __builtin_amdgcn_exp2f(Sx[4 * gq + 2] + Lx[4 * gq + 2] + a2);
            Sx[4 * gq + 3] = __builtin_amdgcn_exp2f(Sx[4 * gq + 3] + Lx[4 * gq + 3] + a3);
          }
          R += run;
        } else {
#pragma unroll
          for (int q = 0; q < 16; ++q) {
            const float z0 = Sx[q];
            const float sp0 = fmaxf(z0, 0.f) + __builtin_amdgcn_logf(1.f + __builtin_amdgcn_exp2f(-fabsf(z0)));
            Lx[q] = (key0 + crow(q, h) < qrow) ? -sp0 : 0.f;
          }
#pragma unroll
          for (int gq = 0; gq < 4; ++gq) {
            gs[gq] = (Lx[4 * gq] + Lx[4 * gq + 1]) + (Lx[4 * gq + 2] + Lx[4 * gq + 3]);
            ps[gq] = xh_partner(gs[gq], h);
          }
          float run = 0.f;
#pragma unroll
          for (int gq = 3; gq >= 0; --gq) {
            const float own = R + run + (h == 0 ? ps[gq] : 0.f);
            run += gs[gq] + ps[gq];
            const int key = key0 + 8 * gq + 4 * h;
            const float a3 = own, a2 = a3 + Lx[4 * gq + 3], a1 = a2 + Lx[4 * gq + 2], a0 = a1 + Lx[4 * gq + 1];
            const float e0 = __builtin_amdgcn_exp2f(Sx[4 * gq + 0] + Lx[4 * gq + 0] + a0);
            const float e1 = __builtin_amdgcn_exp2f(Sx[4 * gq + 1] + Lx[4 * gq + 1] + a1);
            const float e2 = __builtin_amdgcn_exp2f(Sx[4 * gq + 2] + Lx[4 * gq + 2] + a2);
            const float e3 = __builtin_amdgcn_exp2f(Sx[4 * gq + 3] + Lx[4 * gq + 3] + a3);
            Sx[4 * gq + 0] = (key + 0 < qrow) ? e0 : 0.f;
            Sx[4 * gq + 1] = (key + 1 < qrow) ? e1 : 0.f;
            Sx[4 * gq + 2] = (key + 2 < qrow) ? e2 : 0.f;
            Sx[4 * gq + 3] = (key + 3 < qrow) ? e3 : 0.f;
          }
          R += run;
        }
      }
      const bf16x8 pf0 = pack8(Sx, 0), pf1 = pack8(Sx, 1);
      __builtin_amdgcn_sched_barrier(0);
#pragma unroll
      for (int d = 0; d < 4; ++d) vf[4 + d] = *(const bf16x8*)(sV + (32 * d + r) * 128 + (((4 * kb + 2 + h) ^ s3) * 16));
#pragma unroll
      for (int d = 0; d < 4; ++d) O[d] = MFMA32(vf[d], pf0, O[d]);
      __builtin_amdgcn_sched_barrier(0);
#pragma unroll
      for (int d = 0; d < 4; ++d) O[d] = MFMA32(vf[4 + d], pf1, O[d]);
      __builtin_amdgcn_sched_barrier(0);
    };
    if (!skipA) math_pv(SA_, kbA, keyA);
    if (!skipB) math_pv(SB_, kbB, keyB);
    if constexpr (SB) {
      const bool done = (__builtin_amdgcn_ballot_w64(!(R < -150.1f)) == 0ull);
      if (lane == 0) sflag[(it & 1) * 8 + wave] = done ? 1 : 0;
    }
    if (it + 2 < nt) asm volatile("s_waitcnt vmcnt(%0)" :: "n"(G) : "memory");
    else asm volatile("s_waitcnt vmcnt(0)" ::: "memory");
    asm volatile("s_waitcnt lgkmcnt(0)" ::: "memory");
    __builtin_amdgcn_s_barrier();
    if constexpr (SB) {
      const volatile __attribute__((address_space(3))) int* f = sflag + (it & 1) * 8;
      if (f[0] & f[1] & f[2] & f[3] & f[4] & f[5] & f[6] & f[7]) return true;
    }
    return false;
  };
  for (int it = 0; it < nt; it += 3) {
    if (tile_body(it, std::integral_constant<int, 0>{})) break;
    if (it + 1 >= nt) break;
    if (tile_body(it + 1, std::integral_constant<int, 1>{})) break;
    if (it + 2 >= nt) break;
    if (tile_body(it + 2, std::integral_constant<int, 2>{})) break;
  }

  if (PROBE_MODE >= 3 && probe) {
    float sacc = l_run;
#pragma unroll
    for (int d = 0; d < 4; ++d)
#pragma unroll
      for (int q = 0; q < 16; ++q) sacc += O[d][q];
    if (sacc == 1.2345e-30f) Y[0] = 0;
    return;
  }
  float inv = 1.f;
  if constexpr (!SB) {
    const float lt = xh_sum(l_run);
    inv = 1.f / lt;
  }
  const u16* gp = Gt + (unsigned)(qrow * LDG + 4 * h);
  u16* yp = Y + (unsigned)(qrow * 2048 + 4 * h);
#pragma unroll
  for (int d = 0; d < 4; ++d)
#pragma unroll
    for (int gq = 0; gq < 4; ++gq) {
      const int dv = 32 * d + 8 * gq;
      const u32x2 gt = *(const u32x2*)(gp + dv);
      u32x2 o;
      o[0] = pack_bf16(O[d][4 * gq + 0] * inv * bf_lo(gt[0]), O[d][4 * gq + 1] * inv * bf_hi(gt[0]));
      o[1] = pack_bf16(O[d][4 * gq + 2] * inv * bf_lo(gt[1]), O[d][4 * gq + 3] * inv * bf_hi(gt[1]));
      *(u32x2*)(yp + dv) = o;
    }
}

DI void gla_g1(const Params& p, int li, int unit, unsigned char* smem) {
  const int c = unit & 127, bh = unit >> 7, b = bh >> 2, hh = bh & 3;
  const size_t m0 = (size_t)b * S_ + c * 64;
  float* lf = (float*)smem;
  u16* klT = (u16*)(smem + 32768);
  const float* GA = (const float*)(p.ws + E_GA);
  u16* GQ = (u16*)(p.ws + E_GQ);
  u16* GK = (u16*)(p.ws + E_GK);
  const u16* GVT = (const u16*)(p.ws + E_GVT);
  float* EBL = (float*)(p.ws + E_EBL);
  float* SC = (float*)(p.ws + E_SC);
  const float* au_p = p.alpha_up + (size_t)li * 16 * 512;
  const float* bias_p = p.alpha_bias + (size_t)li * 512;
  const int tid = TIDX(), lane = tid & 63, wave = tid >> 6;
  const int r = lane & 31, h = lane >> 5;
  {
    const int d = tid & 127, th = tid >> 7;
    float au[16];
#pragma unroll
    for (int q = 0; q < 16; ++q) au[q] = au_p[q * 512 + hh * 128 + d];
    const float bs = bias_p[hh * 128 + d];
    for (int tt = 0; tt < 16; ++tt) {
      const int t = th * 16 + tt;
      const float4* ga = (const float4*)(GA + (m0 + t) * 16);
      float s = bs;
#pragma unroll
      for (int q = 0; q < 4; ++q) {
        const float4 g4 = ga[q];
        s += g4.x * au[4 * q] + g4.y * au[4 * q + 1] + g4.z * au[4 * q + 2] + g4.w * au[4 * q + 3];
      }
      const float sp = fmaxf(-s, 0.f) + __logf(1.f + __expf(-fabsf(s)));
      lf[t * 128 + d] = -sp * (1.f / 16.f);
    }
  }
  __syncthreads();
  {
    const int d = tid & 127, sg = tid >> 7;
    float run = 0.f;
#pragma unroll
    for (int t = 0; t < 16; ++t) { run += lf[(sg * 16 + t) * 128 + d]; lf[(sg * 16 + t) * 128 + d] = run; }
    __syncthreads();
    float off = 0.f;
    if (sg > 0) off += lf[15 * 128 + d];
    if (sg > 1) off += lf[31 * 128 + d];
    if (sg > 2) off += lf[47 * 128 + d];
    __syncthreads();
    if (sg > 0) {
#pragma unroll
      for (int t = 0; t < 16; ++t) lf[(sg * 16 + t) * 128 + d] += off;
    }
  }
  __syncthreads();
#pragma unroll 1
  for (int i = 0; i < 2; ++i) {
    const int idx = tid + 512 * i;
    const int t = idx >> 4, d0 = (idx & 15) * 8;
    u16* qp = GQ + (m0 + t) * 512 + hh * 128 + d0;
    u16* kp = GK + (m0 + t) * 512 + hh * 128 + d0;
    const u32x4 qv = *(const u32x4*)qp;
    const u32x4 kv = *(const u32x4*)kp;
    u32x4 qo, ko;
#pragma unroll
    for (int jj = 0; jj < 4; ++jj) {
      const float bb0 = lf[t * 128 + d0 + 2 * jj], bb1 = lf[t * 128 + d0 + 2 * jj + 1];
      const float bl0 = lf[63 * 128 + d0 + 2 * jj], bl1 = lf[63 * 128 + d0 + 2 * jj + 1];
      const float q0 = bf_lo(qv[jj]), q1 = bf_hi(qv[jj]);
      const float k0 = bf_lo(kv[jj]), k1 = bf_hi(kv[jj]);
      qo[jj] = pack_bf16(q0 * 0.08838834764831845f * __expf(bb0), q1 * 0.08838834764831845f * __expf(bb1));
      ko[jj] = pack_bf16(k0 * __expf(-bb0), k1 * __expf(-bb1));
      klT[(d0 + 2 * jj) * 72 + t] = to_bf16(k0 * __expf(bl0 - bb0));
      klT[(d0 + 2 * jj + 1) * 72 + t] = to_bf16(k1 * __expf(bl1 - bb1));
    }
    *(u32x4*)qp = qo;
    *(u32x4*)kp = ko;
  }
  if (tid < 128) EBL[(size_t)unit * 128 + tid] = __expf(lf[63 * 128 + tid]);
  __syncthreads();
  {
    f32x16 acc[4];
#pragma unroll
    for (int j = 0; j < 4; ++j)
#pragma unroll
      for (int q = 0; q < 16; ++q) acc[j][q] = 0.f;
    const u16* vp = GVT + ((size_t)(bh * 256 + 32 * wave + r)) * 8192 + c * 64 + 8 * h;
#pragma unroll
    for (int ks = 0; ks < 4; ++ks) {
      const bf16x8 bv = *(const bf16x8*)(vp + 16 * ks);
#pragma unroll
      for (int db = 0; db < 4; ++db) {
        const bf16x8 ak = *(const bf16x8*)(klT + (32 * db + r) * 72 + 16 * ks + 8 * h);
        acc[db] = MFMA32(ak, bv, acc[db]);
      }
    }
    u16* SC16 = (u16*)SC;
    u16* sp = SC16 + ((size_t)unit * 256 + 32 * wave + r) * 128 + 4 * h;
#pragma unroll
    for (int db = 0; db < 4; ++db)
#pragma unroll
      for (int g4 = 0; g4 < 4; ++g4) {
        u32x2 pk;
        pk[0] = pack_bf16(acc[db][4 * g4 + 0], acc[db][4 * g4 + 1]);
        pk[1] = pack_bf16(acc[db][4 * g4 + 2], acc[db][4 * g4 + 3]);
        *(u32x2*)(sp + 32 * db + 8 * g4) = pk;
      }
  }
  __syncthreads();
}

DI void gla_scan(const Params& p) {
  u16* SC16 = (u16*)(p.ws + E_SC);
  const float* EBL = (const float*)(p.ws + E_EBL);
  for (int cp = blockIdx.x * 512 + TIDX(); cp < 131072; cp += gridDim.x * 512) {
    const int bh = cp >> 14, rem = cp & 16383, e = rem >> 6, d2 = (rem & 63) * 2;
    u16* base = SC16 + ((size_t)(bh * 128) * 256 + e) * 128 + d2;
    const float* eb = EBL + (size_t)(bh * 128) * 128 + d2;
    float sx = 0.f, sy = 0.f;
#pragma unroll 8
    for (int c = 0; c < 128; ++c) {
      const unsigned sv = *(const unsigned*)(base + (size_t)c * 32768);
      const float2 f = *(const float2*)(eb + c * 128);
      *(unsigned*)(base + (size_t)c * 32768) = pack_bf16(sx, sy);
      sx = f.x * sx + bf_lo(sv);
      sy = f.y * sy + bf_hi(sv);
    }
  }
}

DI void gla_g3(const Params& p, int li, int unit, unsigned char* smem) {
  const int c = unit & 127, bh = unit >> 7, b = bh >> 2, hh = bh & 3;
  const size_t m0 = (size_t)b * S_ + c * 64;
  float* red = (float*)smem;
  const u16* GQ = (const u16*)(p.ws + E_GQ);
  const u16* GK = (const u16*)(p.ws + E_GK);
  const u16* GVT = (const u16*)(p.ws + E_GVT);
  const u16* GG = (const u16*)(p.ws + E_GG);
  const float* SC = (const float*)(p.ws + E_SC);
  u16* Y = (u16*)(p.ws + OFF_H);
  const float* gn = p.gla_norm + (size_t)li * 256;
  const int tid = TIDX(), lane = tid & 63, wave = tid >> 6;
  const int r = lane & 31, h = lane >> 5;

  bf16x8 bq[2][8];
#pragma unroll
  for (int ib = 0; ib < 2; ++ib)
#pragma unroll
    for (int ks = 0; ks < 8; ++ks)
      bq[ib][ks] = *(const bf16x8*)(GQ + (m0 + 32 * ib + r) * 512 + hh * 128 + 16 * ks + 8 * h);
  f32x16 X00, X01, X11;
#pragma unroll
  for (int q = 0; q < 16; ++q) { X00[q] = 0.f; X01[q] = 0.f; X11[q] = 0.f; }
#pragma unroll
  for (int ks = 0; ks < 8; ++ks) {
    const bf16x8 a0 = *(const bf16x8*)(GK + (m0 + r) * 512 + hh * 128 + 16 * ks + 8 * h);
    const bf16x8 a1 = *(const bf16x8*)(GK + (m0 + 32 + r) * 512 + hh * 128 + 16 * ks + 8 * h);
    X00 = MFMA32(a0, bq[0][ks], X00);
    X01 = MFMA32(a0, bq[1][ks], X01);
    X11 = MFMA32(a1, bq[1][ks], X11);
  }
#pragma unroll
  for (int q = 0; q < 16; ++q) {
    if (crow(q, h) > r) { X00[q] = 0.f; X11[q] = 0.f; }
  }
  f32x16 acc[2];
#pragma unroll
  for (int j = 0; j < 2; ++j)
#pragma unroll
    for (int q = 0; q < 16; ++q) acc[j][q] = 0.f;
  {
    const u16* st = (const u16*)SC + ((size_t)unit * 256 + 32 * wave + r) * 128 + 8 * h;
#pragma unroll
    for (int ks = 0; ks < 8; ++ks) {
      const bf16x8 a = *(const bf16x8*)(st + 16 * ks);
      acc[0] = MFMA32(a, bq[0][ks], acc[0]);
      acc[1] = MFMA32(a, bq[1][ks], acc[1]);
    }
  }
  {
    const u16* vr = GVT + ((size_t)(bh * 256 + 32 * wave + r)) * 8192 + c * 64;
#pragma unroll
    for (int s = 0; s < 2; ++s) {
      const bf16x8 pf00 = pack8(X00, s), pf01 = pack8(X01, s), pf11 = pack8(X11, s);
      {
        const s16x4 lo = *(const s16x4*)(vr + 16 * s + 4 * h);
        const s16x4 hi = *(const s16x4*)(vr + 16 * s + 8 + 4 * h);
        const bf16x8 a = __builtin_shufflevector(lo, hi, 0, 1, 2, 3, 4, 5, 6, 7);
        acc[0] = MFMA32(a, pf00, acc[0]);
        acc[1] = MFMA32(a, pf01, acc[1]);
      }
      {
        const s16x4 lo = *(const s16x4*)(vr + 32 + 16 * s + 4 * h);
        const s16x4 hi = *(const s16x4*)(vr + 32 + 16 * s + 8 + 4 * h);
        const bf16x8 a = __builtin_shufflevector(lo, hi, 0, 1, 2, 3, 4, 5, 6, 7);
        acc[1] = MFMA32(a, pf11, acc[1]);
      }
    }
  }
  float rstd[2];
#pragma unroll
  for (int ib = 0; ib < 2; ++ib) {
    float ss = 0.f;
#pragma unroll
    for (int q = 0; q < 16; ++q) ss += acc[ib][q] * acc[ib][q];
    ss = xh_sum(ss);
    if (h == 0) red[wave * 64 + 32 * ib + r] = ss;
  }
  __syncthreads();
#pragma unroll
  for (int ib = 0; ib < 2; ++ib) {
    float tot = 0.f;
#pragma unroll
    for (int w = 0; w < 8; ++w) tot += red[w * 64 + 32 * ib + r];
    rstd[ib] = rsqrtf(tot * (1.f / 256.f) + 1e-6f);
  }
#pragma unroll
  for (int ib = 0; ib < 2; ++ib)
#pragma unroll
    for (int gq = 0; gq < 4; ++gq) {
      const int e = 32 * wave + 8 * gq + 4 * h;
      const size_t m = m0 + 32 * ib + r;
      const u32x2 gt = *(const u32x2*)(GG + m * 1024 + hh * 256 + e);
      const float4 g4 = *(const float4*)(gn + e);
      const float rs = rstd[ib];
      u32x2 o;
      o[0] = pack_bf16(acc[ib][4 * gq + 0] * rs * g4.x * bf_lo(gt[0]), acc[ib][4 * gq + 1] * rs * g4.y * bf_hi(gt[0]));
      o[1] = pack_bf16(acc[ib][4 * gq + 2] * rs * g4.z * bf_lo(gt[1]), acc[ib][4 * gq + 3] * rs * g4.w * bf_hi(gt[1]));
      *(u32x2*)(Y + m * 2048 + 1024 + hh * 256 + e) = o;
    }
  __syncthreads();
}

__device__ const double kInvFreq[32] = {1.0, 0.7498942093324559, 0.5623413251903491, 0.4216965034285822, 0.31622776601683794, 0.23713737056616552, 0.1778279410038923, 0.1333521432163324, 0.1, 0.07498942093324558, 0.05623413251903491, 0.042169650342858224, 0.03162277660168379, 0.023713737056616554, 0.01778279410038923, 0.01333521432163324, 0.01, 0.007498942093324558, 0.005623413251903491, 0.004216965034285823, 0.0031622776601683794, 0.0023713737056616554, 0.0017782794100389228, 0.001333521432163324, 0.001, 0.0007498942093324559, 0.0005623413251903491, 0.00042169650342858224, 0.00031622776601683794, 0.00023713737056616554, 0.00017782794100389227, 0.0001333521432163324};

#define XB_TMO      128
#define XB_XCNT(j)  (256  + 64 * (j))
#define XB_XSUB(j)  (1280 + 64 * (j))
#define XB_XGEN(j)  (2304 + 64 * (j))
#define XB_TOP      3328
#define XB_TOPGEN   3392
#define XCD_BAR_WORDS 3456
#define XB_SPIN_CAP (1u << 20)
#define LAS __attribute__((address_space(3)))
DI unsigned xb_ld(unsigned* p)              { return __hip_atomic_load(p, __ATOMIC_RELAXED, __HIP_MEMORY_SCOPE_AGENT); }
DI unsigned xb_add(unsigned* p, unsigned v) { return __hip_atomic_fetch_add(p, v, __ATOMIC_RELAXED, __HIP_MEMORY_SCOPE_AGENT); }
DI unsigned xb_xcc_id() { return (unsigned)__builtin_amdgcn_s_getreg((3 << 11) | 20) & 0xFu; }
#define XB_SPIN(cond, bar) do { unsigned _sp = 0; while (cond) { __builtin_amdgcn_s_sleep(1); \
    if ((++_sp & 255u) == 0u) { if (xb_ld(&(bar)[XB_TMO])) break; if (_sp > XB_SPIN_CAP) { atomicAdd(&(bar)[XB_TMO], 1u); break; } } } } while (0)
struct XcdBarrier { unsigned* bar; unsigned x; volatile LAS unsigned* st; };
DI XcdBarrier xcd_barrier_post(unsigned* bar, volatile LAS unsigned* st) {
  XcdBarrier b; b.bar = bar; b.x = xb_xcc_id(); b.st = st;
  if (__builtin_amdgcn_workitem_id_x() == 0) (void)xb_add(&bar[XB_XCNT(b.x)], 1u);
  return b;
}
DI void xcd_barrier_complete(unsigned* bar, unsigned x, unsigned& nloc, unsigned& nx) {
  const unsigned G = gridDim.x * gridDim.y * gridDim.z;
  unsigned sum, cnt, mine, sp = 0u;
  for (;;) {
    sum = 0u; cnt = 0u; mine = 0u;
#pragma unroll
    for (unsigned j = 0; j < 16; ++j) { const unsigned c = xb_ld(&bar[XB_XCNT(j)]); sum += c; cnt += (c > 0u) ? 1u : 0u; mine = (j == x) ? c : mine; }
    if (sum == G) break;
    __builtin_amdgcn_s_sleep(1);
    if ((++sp & 255u) == 0u) { if (xb_ld(&bar[XB_TMO])) break; if (sp > XB_SPIN_CAP) { atomicAdd(&bar[XB_TMO], 1u); break; } }
  }
  nloc = mine > 0u ? mine : 1u; nx = cnt > 0u ? cnt : 1u;
}
DI void xcd_barrier(const XcdBarrier& b) {
  asm volatile("s_waitcnt vmcnt(0)" ::: "memory");
  __syncthreads();
  if (__builtin_amdgcn_workitem_id_x() == 0) {
    unsigned* bar = b.bar;
    __builtin_amdgcn_s_waitcnt(0);
    unsigned nloc = b.st[0], nx = b.st[1];
    if (nloc == 0u) { xcd_barrier_complete(bar, b.x, nloc, nx); b.st[0] = nloc; b.st[1] = nx; }
    const unsigned old = xb_add(&bar[XB_XSUB(b.x)], 1u);
    const unsigned gen = old / nloc;
    if (old + 1u == (gen + 1u) * nloc) {
      __builtin_amdgcn_fence(__ATOMIC_RELEASE, "agent");
      asm volatile("s_waitcnt vmcnt(0)" ::: "memory");
      const unsigned og = xb_add(&bar[XB_TOP], 1u);
      const unsigned tg = og / nx;
      if (og + 1u == (tg + 1u) * nx) xb_add(&bar[XB_TOPGEN], 1u);
      else XB_SPIN(xb_ld(&bar[XB_TOPGEN]) == tg, bar);
      __builtin_amdgcn_fence(__ATOMIC_ACQUIRE, "agent");
      xb_add(&bar[XB_XGEN(b.x)], 1u);
      asm volatile("s_waitcnt vmcnt(0)" ::: "memory");
    } else {
      XB_SPIN(xb_ld(&bar[XB_XGEN(b.x)]) == gen, bar);
      __builtin_amdgcn_fence(__ATOMIC_ACQUIRE, "agent");
      asm volatile("s_waitcnt vmcnt(0)" ::: "memory");
    }
  }
  __syncthreads();
}

constexpr int WG_LD = 2052;

DI GemmT gt_init(int K) {
  GemmT g;
  g.A = nullptr; g.B = nullptr; g.K = K; g.lda = K; g.ldb = K;
  g.mode = M_BF16; g.R0 = 0; g.C0 = 0; g.ld = 0; g.aux = 0; g.nact = 256; g.probe = 0; g.perm = 0;
  g.d16 = nullptr; g.d32 = nullptr; g.scale = 1.f; g.rs = nullptr; g.xin = nullptr; g.cs = nullptr; g.sn = nullptr;
  return g;
}

DI void tile_map(int t, int TN, int& tm, int& tn) {
  const int b = t & 255, k = t >> 8;
  const int x = b & 7, j = b >> 3;
  const int G = k * 8 + x;
  const int gpr = TN >> 2;
  const int gm = G / gpr, gn = G - gm * gpr;
  tm = gm * 8 + (j >> 2); tn = gn * 4 + (j & 3);
}

DI void phase_prep(const Params& p, int L, unsigned char* smem) {
  const bool even = (L & 1) == 0;
  const int li = L >> 1;
  u16* WL = (u16*)(p.ws + OFF_WL);
  float* lds = (float*)smem;
  if (L == 0) {
    float* cs = (float*)(p.ws + OFF_COS);
    float* sn = (float*)(p.ws + OFF_SIN);
    for (int i = blockIdx.x * 512 + TIDX(); i < T_ * 32; i += gridDim.x * 512) {
      const int m = i >> 5, f = i & 31;
      const double ang = (double)p.pos[m] * kInvFreq[f];
      const double t = ang * 0.63661977236758134308;
      const double kq = rint(t);
      const double rr = (t - kq) * 1.57079632679489661923;
      const int qd = (int)((long long)kq & 3);
      const double r2 = rr * rr;
      const double sr = rr * (1.0 - r2 / 6.0 * (1.0 - r2 / 20.0 * (1.0 - r2 / 42.0 * (1.0 - r2 / 72.0 * (1.0 - r2 / 110.0 * (1.0 - r2 / 156.0))))));
      const double cr = 1.0 - r2 / 2.0 * (1.0 - r2 / 12.0 * (1.0 - r2 / 30.0 * (1.0 - r2 / 56.0 * (1.0 - r2 / 90.0 * (1.0 - r2 / 132.0 * (1.0 - r2 / 182.0))))));
      const double cc = (qd == 0) ? cr : (qd == 1) ? -sr : (qd == 2) ? -cr : sr;
      const double sv = (qd == 0) ? sr : (qd == 1) ? cr : (qd == 2) ? -sr : -cr;
      cs[i] = (float)cc;
      sn[i] = (float)sv;
    }
  }
  if (even) {
    const float* win = p.w_in_even + (size_t)li * 2048 * 7184;
    const float* wout = p.w_out_even + (size_t)li * 2048 * 2048;
    const int n1 = 28 * 32, n2 = 8 * 32;
    for (int t = blockIdx.x; t < n1 + n2; t += gridDim.x) {
      if (t < n1) convert_tile256(win, 7184, nullptr, WL + WE_IN, 2048, (t & 31) * 64, (t >> 5) * 256, 0, lds);
      else { const int u = t - n1; convert_tile256(wout, 2048, nullptr, WL + WE_OUT, 2048, (u & 31) * 64, (u >> 5) * 256, 0, lds); }
    }
  } else {
    const float* win = p.w_in_odd + (size_t)li * 2048 * 3136;
    const float* wq = p.w_q_up + (size_t)li * 512 * 3072;
    const float* wkv = p.w_kv_up + (size_t)li * 512 * 4096;
    const float* wout = p.w_out_odd + (size_t)li * 2048 * 2048;
    const int n1 = 13 * 32, n2 = 12 * 8, n3 = 16 * 8, n4 = 8 * 32;
    for (int t = blockIdx.x; t < n1 + n2 + n3 + n4; t += gridDim.x) {
      if (t < n1) convert_tile256(win, 3136, nullptr, WL + WO_IN, 2048, (t & 31) * 64, (t >> 5) * 256, 1, lds);
      else if (t < n1 + n2) { const int u = t - n1; convert_tile256(wq, 3072, p.q_norm + (size_t)li * 512, WL + WO_Q, 512, (u & 7) * 64, (u >> 3) * 256, 2, lds); }
      else if (t < n1 + n2 + n3) { const int u = t - n1 - n2; convert_tile256(wkv, 4096, p.kv_norm + (size_t)li * 512, WL + WO_KV, 512, (u & 7) * 64, (u >> 3) * 256, 3, lds); }
      else { const int u = t - n1 - n2 - n3; convert_tile256(wout, 2048, nullptr, WL + WO_OUT, 2048, (u & 31) * 64, (u >> 5) * 256, 0, lds); }
    }
  }
  const float* xin = (L == 0) ? p.x : p.out;
  const float* g = even ? (p.ln_even + (size_t)li * 2048) : (p.ln_odd + (size_t)li * 2048);
  u16* H = (u16*)(p.ws + OFF_H);
  const int wave = TIDX() >> 6;
  if (even) {
    const float* wsrc = p.w_in_even + (size_t)li * 2048 * 7184 + 7168;
    const int tid = TIDX();
    for (int idx = tid; idx < 2048 * 16; idx += 512) {
      const int k = idx >> 4, c = idx & 15;
      lds[c * WG_LD + k] = wsrc[(size_t)k * 7184 + c];
    }
    __syncthreads();
    float* GA = (float*)(p.ws + E_GA);
    for (int row = blockIdx.x * 8 + wave; row < T_; row += gridDim.x * 8)
      norm_row<true>(xin + (size_t)row * 2048, g, H + (size_t)row * 2048, nullptr, lds, GA + (size_t)row * 16);
    __syncthreads();
  } else {
    for (int row = blockIdx.x * 8 + wave; row < T_; row += gridDim.x * 8)
      norm_row<false>(xin + (size_t)row * 2048, g, H + (size_t)row * 2048, nullptr, nullptr, nullptr);
  }
}

DI void phase_gemm_in_even(const Params& p, unsigned char* smem, int probe) {
  const u16* WL = (const u16*)(p.ws + OFF_WL);
  const u16* H = (const u16*)(p.ws + OFF_H);
  const int NT = 28;
  for (int t = blockIdx.x; t < 64 * NT; t += gridDim.x) {
    int tm, tn; tile_map(t, NT, tm, tn);
    GemmT g = gt_init(2048);
    const u16* Wt = WL + WE_IN + (size_t)tn * 256 * 2048;
    const u16* Ht = H + (size_t)tm * 256 * 2048;
    const bool trans = (tn >= 8 && tn < 12) || (tn >= 20 && tn < 24);
    if (trans) { g.A = Ht; g.B = Wt; g.R0 = tm * 256; } else { g.A = Wt; g.B = Ht; g.C0 = tm * 256; }
    if (tn < 4)       { g.mode = M_BF16; g.d16 = (u16*)(p.ws + E_SQ); g.ld = 1024; g.R0 = tn * 256; g.scale = 0.08838834764831845f * 1.4426950408889634f; }
    else if (tn < 8)  { g.mode = M_BF16; g.d16 = (u16*)(p.ws + E_SK); g.ld = 1024; g.R0 = (tn - 4) * 256; }
    else if (tn < 12) { g.mode = M_TRANS; g.d16 = (u16*)(p.ws + E_SVT); g.aux = 1024; g.C0 = (tn - 8) * 256; g.perm = 1; }
    else if (tn < 16) { g.mode = M_SILU; g.d16 = (u16*)(p.ws + E_SG); g.ld = 1024; g.R0 = (tn - 12) * 256; }
    else if (tn < 18) { g.mode = M_BF16; g.d16 = (u16*)(p.ws + E_GQ); g.ld = 512; g.R0 = (tn - 16) * 256; }
    else if (tn < 20) { g.mode = M_BF16; g.d16 = (u16*)(p.ws + E_GK); g.ld = 512; g.R0 = (tn - 18) * 256; }
    else if (tn < 24) { g.mode = M_TRANS; g.d16 = (u16*)(p.ws + E_GVT); g.aux = 1024; g.C0 = (tn - 20) * 256; }
    else              { g.mode = M_SILU; g.d16 = (u16*)(p.ws + E_GG); g.ld = 1024; g.R0 = (tn - 24) * 256; }
    g.probe = probe;
    gemm_tile8(g, smem);
  }
}

DI void phase_gemm_in_odd(const Params& p, unsigned char* smem) {
  const u16* WL = (const u16*)(p.ws + OFF_WL);
  const u16* H = (const u16*)(p.ws + OFF_H);
  const int NT = 12;
  for (int t = blockIdx.x; t < 64 * NT; t += gridDim.x) {
    int tm, tn; tile_map(t, NT, tm, tn);
    GemmT g = gt_init(2048);
    g.A = WL + WO_IN + (size_t)tn * 256 * 2048;
    g.B = H + (size_t)tm * 256 * 2048;
    g.C0 = tm * 256;
    if (tn < 2)      { g.mode = M_BF16; g.d16 = (u16*)(p.ws + O_QL); g.ld = 512; g.R0 = tn * 256; }
    else if (tn < 4) { g.mode = M_BF16; g.d16 = (u16*)(p.ws + O_KVL); g.ld = 512; g.R0 = (tn - 2) * 256; }
    else             { g.mode = M_SILU; g.d16 = (u16*)(p.ws + O_GATE); g.ld = 2048; g.R0 = (tn - 4) * 256; }
    gemm_tile8(g, smem);
  }
}

DI void phase_rstd_kr(const Params& p, unsigned char* smem) {
  for (int t = blockIdx.x; t < 64; t += gridDim.x) {
    GemmT g = gt_init(2048);
    g.A = (const u16*)(p.ws + OFF_WL) + WO_IN + (size_t)3072 * 2048;
    g.B = (const u16*)(p.ws + OFF_H) + (size_t)t * 256 * 2048;
    g.R0 = 0; g.C0 = t * 256; g.nact = 128; g.aux = 64;
    g.mode = M_ROPE; g.d16 = (u16*)(p.ws + O_KR); g.ld = 64;
    g.cs = (const float*)(p.ws + OFF_COS); g.sn = (const float*)(p.ws + OFF_SIN);
    gemm_tile8(g, smem);
  }
  const u16* QL = (const u16*)(p.ws + O_QL);
  const u16* KVL = (const u16*)(p.ws + O_KVL);
  float* RSQ = (float*)(p.ws + O_RSQ);
  float* RSKV = (float*)(p.ws + O_RSKV);
  const int wave = TIDX() >> 6, lane = TIDX() & 63;
  for (int row = blockIdx.x * 8 + wave; row < 2 * T_; row += gridDim.x * 8) {
    const int m = row >> 1;
    const u16* src = (row & 1) ? KVL : QL;
    const u32x4 v = *(const u32x4*)(src + (size_t)m * 512 + lane * 8);
    float ss = 0.f;
#pragma unroll
    for (int q = 0; q < 4; ++q) { const float a = bf_lo(v[q]), b = bf_hi(v[q]); ss += a * a + b * b; }
    ss = wave_sum(ss);
    if (lane == 0) ((row & 1) ? RSKV : RSQ)[m] = rsqrtf(ss * (1.f / 512.f) + 1e-6f);
  }
}

DI void phase_gemm_up(const Params& p, unsigned char* smem) {
  const u16* WL = (const u16*)(p.ws + OFF_WL);
  const u16* QL = (const u16*)(p.ws + O_QL);
  const u16* KVL = (const u16*)(p.ws + O_KVL);
  const float* RSQ = (const float*)(p.ws + O_RSQ);
  const float* RSKV = (const float*)(p.ws + O_RSKV);
  const float qscale = 0.07216878364870322f * 1.4426950408889634f;
  const int NT = 28;
  for (int t = blockIdx.x; t < 64 * NT; t += gridDim.x) {
    int tm, tn; tile_map(t, NT, tm, tn);
    GemmT g = gt_init(512);
    if (tn < 8) {
      g.A = WL + WO_Q + (size_t)tn * 256 * 512; g.B = QL + (size_t)tm * 256 * 512;
      g.mode = M_BF16; g.d16 = (u16*)(p.ws + O_QN); g.ld = 2048; g.R0 = tn * 256; g.C0 = tm * 256; g.rs = RSQ; g.scale = qscale;
    } else if (tn < 12) {
      g.A = WL + WO_Q + (size_t)(2048 + (tn - 8) * 256) * 512; g.B = QL + (size_t)tm * 256 * 512;
      g.mode = M_ROPE; g.d16 = (u16*)(p.ws + O_QR); g.ld = 1024; g.R0 = (tn - 8) * 256; g.C0 = tm * 256; g.aux = 256; g.rs = RSQ; g.scale = qscale;
      g.cs = (const float*)(p.ws + OFF_COS); g.sn = (const float*)(p.ws + OFF_SIN);
    } else if (tn < 20) {
      g.A = WL + WO_KV + (size_t)(tn - 12) * 256 * 512; g.B = KVL + (size_t)tm * 256 * 512;
      g.mode = M_BF16; g.d16 = (u16*)(p.ws + O_KN); g.ld = 2048; g.R0 = (tn - 12) * 256; g.C0 = tm * 256; g.rs = RSKV;
    } else {
      g.A = KVL + (size_t)tm * 256 * 512; g.B = WL + WO_KV + (size_t)(2048 + (tn - 20) * 256) * 512;
      g.mode = M_TRANS; g.d16 = (u16*)(p.ws + O_VT); g.aux = 2048; g.R0 = tm * 256; g.C0 = (tn - 20) * 256; g.rs = RSKV; g.perm = 1;
    }
    gemm_tile8(g, smem);
  }
}

DI void phase_gemm_out(const Params& p, int L, unsigned char* smem) {
  const bool even = (L & 1) == 0;
  const u16* WL = (const u16*)(p.ws + OFF_WL) + (even ? WE_OUT : WO_OUT);
  const u16* Y = (const u16*)(p.ws + OFF_H);
  const float* xin = (L == 0) ? p.x : p.out;
  for (int t = blockIdx.x; t < 64 * 8; t += gridDim.x) {
    int tm, tn; tile_map(t, 8, tm, tn);
    GemmT g = gt_init(2048);
    g.A = WL + (size_t)tn * 256 * 2048; g.B = Y + (size_t)tm * 256 * 2048;
    g.mode = M_RESID; g.R0 = tn * 256; g.C0 = tm * 256; g.d32 = p.out; g.xin = xin;
    gemm_tile8(g, smem);
  }
}

DI int next_item(int* ctr, int* sitem) {
  if (TIDX() == 0) *sitem = atomicAdd(ctr, 1);
  __syncthreads();
  const int it = *sitem;
  __syncthreads();
  return it;
}

DI void phase_even_mix(const Params& p, int L, int ph, unsigned char* smem, int* sitem, bool do_g1) {
  int* ctr = (int*)(p.ws + OFF_CTR) + ph;
  const int li = L >> 1;
  for (;;) {
    const int it = next_item(ctr, sitem);
    if (it >= 1536) break;
    if (it < 512) {
      const int qb = 31 - (it >> 4), bh = it & 15, b = bh >> 3, hh = bh & 7;
      const u16* SQ = (const u16*)(p.ws + E_SQ) + (size_t)b * S_ * 1024 + hh * 128;
      const u16* SK = (const u16*)(p.ws + E_SK) + (size_t)b * S_ * 1024 + hh * 128;
      const u16* SVT = (const u16*)(p.ws + E_SVT) + ((size_t)(b * 1024 + hh * 128)) * 8192;
      const u16* SG = (const u16*)(p.ws + E_SG) + (size_t)b * S_ * 1024 + hh * 128;
      u16* Y = (u16*)(p.ws + OFF_H) + (size_t)b * S_ * 2048 + hh * 128;
      attn_item<128, true, 1024, 0, 1024, 0, 1024>(SQ, nullptr, SK, nullptr, SVT, SG, Y, qb * 256, smem);
    } else {
      if (do_g1) gla_g1(p, li, it - 512, smem);
    }
  }
}

DI void phase_gla_out(const Params& p, int L, int ph, unsigned char* smem, int* sitem) {
  int* ctr = (int*)(p.ws + OFF_CTR) + ph;
  const int li = L >> 1;
  for (;;) {
    const int it = next_item(ctr, sitem);
    if (it >= 1024) break;
    gla_g3(p, li, it, smem);
  }
}

DI void mla_item(const Params& p, int bh, int qb, unsigned char* smem, int probe) {
  const int b = bh >> 4, hh = bh & 15;
  const u16* QN = (const u16*)(p.ws + O_QN) + (size_t)b * S_ * 2048 + hh * 128;
  const u16* QR = (const u16*)(p.ws + O_QR) + (size_t)b * S_ * 1024 + hh * 64;
  const u16* KN = (const u16*)(p.ws + O_KN) + (size_t)b * S_ * 2048 + hh * 128;
  const u16* KR = (const u16*)(p.ws + O_KR) + (size_t)b * S_ * 64;
  const u16* VT = (const u16*)(p.ws + O_VT) + ((size_t)(b * 2048 + hh * 128)) * 8192;
  const u16* GT = (const u16*)(p.ws + O_GATE) + (size_t)b * S_ * 2048 + hh * 128;
  u16* Y = (u16*)(p.ws + OFF_H) + (size_t)b * S_ * 2048 + hh * 128;
  attn_item<192, false, 2048, 1024, 2048, 64, 2048>(QN, QR, KN, KR, VT, GT, Y, qb * 256, smem, probe);
}

DI void phase_mla(const Params& p, int ph, unsigned char* smem, int* sitem, int probe) {
  if (gridDim.x == 256) {
    const int x = blockIdx.x & 7, j = blockIdx.x >> 3, half = j >> 4, jp = j & 15;
#pragma unroll 1
    for (int pass = 0; pass < 2; ++pass) {
      const int bh = 4 * x + 2 * pass + half;
      mla_item(p, bh, 31 - jp, smem, probe);
      mla_item(p, bh, jp, smem, probe);
    }
    return;
  }
  int* ctr = (int*)(p.ws + OFF_CTR) + 64 + (ph % 24) * 8;
  const int x = (int)(xb_xcc_id() & 7u);
  for (;;) {
    if (TIDX() == 0) {
      int it = -1;
      for (int k = 0; k < 8; ++k) {
        const int q = (x + k) & 7;
        const int v = atomicAdd(ctr + q, 1);
        if (v < 128) { it = q * 128 + v; break; }
      }
      *sitem = it;
    }
    __syncthreads();
    const int it = *sitem;
    __syncthreads();
    if (it < 0) break;
    const int q = it >> 7, v = it & 127;
    mla_item(p, 4 * q + (v >> 5), 31 - (v & 31), smem, probe);
  }
}

DI void phase_final(const Params& p) {
  const int wave = TIDX() >> 6;
  for (int row = blockIdx.x * 8 + wave; row < T_; row += gridDim.x * 8)
    norm_row<false>(p.out + (size_t)row * 2048, p.final_norm, nullptr, p.out + (size_t)row * 2048, nullptr, nullptr);
}

__global__ void __launch_bounds__(512, 2) fwd_kernel(Params p_arg, int ph0, int ph1) {
  __shared__ __attribute__((aligned(16))) unsigned char smem[SMEM_BYTES + 64];
  int& sitem = *(int*)(smem + SMEM_BYTES);
  uint4& xb_words = *(uint4*)(smem + SMEM_BYTES + 16);
  cg::grid_group grid = cg::this_grid();
  if (__builtin_amdgcn_workitem_id_x() == 0) xb_words = make_uint4(0u, 0u, 0u, 0u);
  __syncthreads();
  XcdBarrier xb = xcd_barrier_post((unsigned*)(p_arg.ws + OFF_BAR), (volatile LAS unsigned*)&xb_words);
  if (ph1 > 1000) grid.sync();
  typedef const __attribute__((address_space(4))) Params* KP;
  const KP kp0 = (KP)__builtin_amdgcn_kernarg_segment_ptr();
  for (int ph = ph0; ph < ph1; ++ph) {
   for (int rep = 0; rep < 2; ++rep) {
    if (rep == 1) { if (!((REPEAT_MASK >> ph) & 1)) break; xcd_barrier(xb); }
    const int cph = ph + 32 * rep;
    KP kq = kp0;
    asm volatile("" : "+s"(kq));
    const Params& p = *(const Params*)kq;
    if (ph == 24) {
      phase_final(p);
    } else {
      const int L = ph / 6, sub = ph % 6;
      const bool even = (L & 1) == 0;
      if (sub == 0) { if (PH_MASK & 1) phase_prep(p, L, smem); }
      else if (sub == 1) { if (even) { if (PH_MASK & 2) phase_gemm_in_even(p, smem, rep); } else { if (PH_MASK & 4) phase_gemm_in_odd(p, smem); } }
      else if (sub == 2) { if (even) { if (PH_MASK & 8) phase_even_mix(p, L, cph, smem, &sitem, rep == 0); } else { if (PH_MASK & 16) phase_rstd_kr(p, smem); } }
      else if (sub == 3) { if (even) { if (PH_MASK & 32) gla_scan(p); } else { if (PH_MASK & 64) phase_gemm_up(p, smem); } }
      else if (sub == 4) { if (even) { if (PH_MASK & 128) phase_gla_out(p, L, cph, smem, &sitem); } else { if (PH_MASK & 256) phase_mla(p, cph, smem, &sitem, rep); } }
      else { if (PH_MASK & 512) phase_gemm_out(p, L, smem); }
    }
   }
    if (ph + 1 < ph1) xcd_barrier(xb);
  }
}

extern "C" void kernel_launch(void* const* d_in, const int* in_sizes, int n_in, void* d_out, int out_size,
                              void* d_ws, size_t ws_size, hipStream_t stream) {
  static int grid_blocks = 0;
  if (!grid_blocks) {
    int dev = 0, cus = 0, per_cu = 0;
    (void)hipGetDevice(&dev);
    (void)hipDeviceGetAttribute(&cus, hipDeviceAttributeMultiprocessorCount, dev);
    (void)hipOccupancyMaxActiveBlocksPerMultiprocessor(&per_cu, fwd_kernel, 512, 0);
    if (per_cu < 1) per_cu = 1;
    if (per_cu > 1) per_cu = 1;
    grid_blocks = cus * per_cu;
  }
  if (ws_size < WS_NEED) { fprintf(stderr, "workspace too small: %zu\n", ws_size); return; }
  Params p{};
  p.x = (const float*)d_in[0]; p.pos = (const int*)d_in[1];
  p.ln_even = (const float*)d_in[2]; p.w_in_even = (const float*)d_in[3];
  p.alpha_up = (const float*)d_in[4]; p.alpha_bias = (const float*)d_in[5];
  p.gla_norm = (const float*)d_in[6]; p.w_out_even = (const float*)d_in[7];
  p.ln_odd = (const float*)d_in[8]; p.w_in_odd = (const float*)d_in[9];
  p.q_norm = (const float*)d_in[10]; p.w_q_up = (const float*)d_in[11];
  p.kv_norm = (const float*)d_in[12]; p.w_kv_up = (const float*)d_in[13];
  p.w_out_odd = (const float*)d_in[14]; p.final_norm = (const float*)d_in[15];
  p.out = (float*)d_out; p.ws = (unsigned char*)d_ws;
  (void)hipMemsetAsync((unsigned char*)d_ws + OFF_CTR, 0, 16384, stream);
  int a0 = 0, a1 = NPHASE;
  void* args[] = {&p, &a0, &a1};
  hipError_t e = hipLaunchCooperativeKernel((void*)fwd_kernel, dim3(grid_blocks), dim3(512), args, 0, stream);
  if (e != hipSuccess) fprintf(stderr, "cooperative launch failed: %s (grid %d)\n", hipGetErrorString(e), grid_blocks);
}
```

```cpp
#include <hip/hip_runtime.h>
#include <hip/hip_cooperative_groups.h>
#include <cstdio>
#include <cstdint>
#include <type_traits>
namespace cg = cooperative_groups;

#ifndef ONE_LAUNCH
#define ONE_LAUNCH 1
#endif

#ifndef REPEAT_MASK
#define REPEAT_MASK 0
#endif
#ifndef PROBE_MODE
#define PROBE_MODE 0
#endif
#ifndef PH_MASK
#define PH_MASK 0xFFFF
#endif
#define DI __device__ __forceinline__
typedef unsigned short u16;
using bf16x8 = __attribute__((ext_vector_type(8))) short;
using s16x4  = __attribute__((ext_vector_type(4))) short;
using f32x16 = __attribute__((ext_vector_type(16))) float;
using u32x4  = __attribute__((ext_vector_type(4))) unsigned;
using u32x2  = __attribute__((ext_vector_type(2))) unsigned;
#define MFMA32(a, b, c) __builtin_amdgcn_mfma_f32_32x32x16_bf16((a), (b), (c), 0, 0, 0)

constexpr int S_ = 8192;
constexpr int T_ = 16384;
constexpr size_t MiB = (size_t)1 << 20;

constexpr size_t OFF_WL = 0;
constexpr size_t OFF_H  = 40 * MiB;
constexpr size_t OFF_L  = 104 * MiB;
constexpr size_t E_SQ  = OFF_L + 0 * MiB;
constexpr size_t E_SK  = OFF_L + 32 * MiB;
constexpr size_t E_SVT = OFF_L + 64 * MiB;
constexpr size_t E_SG  = OFF_L + 96 * MiB;
constexpr size_t E_GQ  = OFF_L + 128 * MiB;
constexpr size_t E_GK  = OFF_L + 144 * MiB;
constexpr size_t E_GVT = OFF_L + 160 * MiB;
constexpr size_t E_GG  = OFF_L + 192 * MiB;
constexpr size_t E_GA  = OFF_L + 224 * MiB;
constexpr size_t E_EBL = OFF_L + 225 * MiB;
constexpr size_t E_SC  = OFF_L + 226 * MiB;
constexpr size_t O_QL   = OFF_L + 0 * MiB;
constexpr size_t O_KVL  = OFF_L + 16 * MiB;
constexpr size_t O_GATE = OFF_L + 32 * MiB;
constexpr size_t O_KR   = OFF_L + 96 * MiB;
constexpr size_t O_RSQ  = OFF_L + 98 * MiB;
constexpr size_t O_RSKV = OFF_L + 98 * MiB + 65536;
constexpr size_t O_QN   = OFF_L + 99 * MiB;
constexpr size_t O_QR   = OFF_L + 163 * MiB;
constexpr size_t O_KN   = OFF_L + 195 * MiB;
constexpr size_t O_VT   = OFF_L + 259 * MiB;
constexpr size_t OFF_COS = 460 * MiB;
constexpr size_t OFF_SIN = 462 * MiB;
constexpr size_t OFF_CTR = 464 * MiB;
constexpr size_t OFF_BAR = 464 * MiB + 1024;
constexpr size_t WS_NEED = 465 * MiB;

constexpr size_t WE_IN = 0;
constexpr size_t WE_OUT = (size_t)7168 * 2048;
constexpr size_t WO_IN = 0;
constexpr size_t WO_Q = (size_t)3328 * 2048;
constexpr size_t WO_KV = WO_Q + (size_t)3072 * 512;
constexpr size_t WO_OUT = WO_KV + (size_t)4096 * 512;

constexpr int NPHASE = 25;
constexpr int SMEM_BYTES = 147456;

struct Params {
  const float* x; const int* pos;
  const float* ln_even; const float* w_in_even; const float* alpha_up; const float* alpha_bias;
  const float* gla_norm; const float* w_out_even;
  const float* ln_odd; const float* w_in_odd; const float* q_norm; const float* w_q_up;
  const float* kv_norm; const float* w_kv_up; const float* w_out_odd;
  const float* final_norm;
  float* out; unsigned char* ws;
};

DI unsigned pack_bf16(float a, float b) {
  typedef __bf16 bf2 __attribute__((ext_vector_type(2)));
  typedef float f2 __attribute__((ext_vector_type(2)));
  f2 v = {a, b};
  bf2 r = __builtin_convertvector(v, bf2);
  return __builtin_bit_cast(unsigned, r);
}
DI u16 to_bf16(float a) { return (u16)(pack_bf16(a, 0.f) & 0xffffu); }
DI float bf_lo(unsigned w) { return __uint_as_float(w << 16); }
DI float bf_hi(unsigned w) { return __uint_as_float(w & 0xffff0000u); }
DI int TIDX() { int t = __builtin_amdgcn_workitem_id_x(); asm volatile("" : "+v"(t)); return t; }
DI int crow(int reg, int h) { return (reg & 3) + 8 * (reg >> 2) + 4 * h; }
DI float xh_max(float x) {
  const auto r = __builtin_amdgcn_permlane32_swap(__float_as_uint(x), __float_as_uint(x), false, false);
  return fmaxf(__uint_as_float(r[0]), __uint_as_float(r[1]));
}
DI float xh_sum(float x) {
  const auto r = __builtin_amdgcn_permlane32_swap(__float_as_uint(x), __float_as_uint(x), false, false);
  return __uint_as_float(r[0]) + __uint_as_float(r[1]);
}
DI float xh_partner(float x, int h) {
  const auto r = __builtin_amdgcn_permlane32_swap(__float_as_uint(x), __float_as_uint(x), false, false);
  return h ? __uint_as_float(r[0]) : __uint_as_float(r[1]);
}
DI float dpp_add(float v, const int ctrl_tag) {
  int r;
  if (ctrl_tag == 0) r = __builtin_amdgcn_update_dpp(0, __float_as_int(v), 0xB1, 0xf, 0xf, true);
  else if (ctrl_tag == 1) r = __builtin_amdgcn_update_dpp(0, __float_as_int(v), 0x4E, 0xf, 0xf, true);
  else if (ctrl_tag == 2) r = __builtin_amdgcn_update_dpp(0, __float_as_int(v), 0x141, 0xf, 0xf, true);
  else r = __builtin_amdgcn_update_dpp(0, __float_as_int(v), 0x140, 0xf, 0xf, true);
  return v + __int_as_float(r);
}
DI float wave_sum(float v) {
  v = dpp_add(v, 0); v = dpp_add(v, 1); v = dpp_add(v, 2); v = dpp_add(v, 3);
  { const auto r = __builtin_amdgcn_permlane16_swap(__float_as_uint(v), __float_as_uint(v), false, false);
    v = __uint_as_float(r[0]) + __uint_as_float(r[1]); }
  return xh_sum(v);
}
DI float silu_f(float v) { return v * __builtin_amdgcn_rcpf(1.f + __expf(-v)); }
DI bf16x8 pack8(const f32x16& x, int s) {
  u32x4 p;
  p[0] = pack_bf16(x[8 * s + 0], x[8 * s + 1]);
  p[1] = pack_bf16(x[8 * s + 2], x[8 * s + 3]);
  p[2] = pack_bf16(x[8 * s + 4], x[8 * s + 5]);
  p[3] = pack_bf16(x[8 * s + 6], x[8 * s + 7]);
  return __builtin_bit_cast(bf16x8, p);
}

DI void convert_tile(const float* __restrict__ src, int ldn, const float* __restrict__ gain,
                     u16* __restrict__ dst, int K, int k0, int nd0, int ns0, int nvalid, float* lds) {
  const int tid = TIDX();
  const int c = tid & 63, r0 = tid >> 6;
#pragma unroll
  for (int i = 0; i < 8; ++i) {
    const int r = r0 + 8 * i;
    float v = 0.f;
    if (c < nvalid) {
      v = src[(size_t)(k0 + r) * ldn + ns0 + c];
      if (gain) v *= gain[k0 + r];
    }
    lds[r * 65 + c] = v;
  }
  __syncthreads();
  const int kk = (tid & 31) * 2, n = tid >> 5;
#pragma unroll
  for (int i = 0; i < 4; ++i) {
    const int nn = n + 16 * i;
    const unsigned pk = pack_bf16(lds[kk * 65 + nn], lds[(kk + 1) * 65 + nn]);
    *(unsigned*)(dst + (size_t)(nd0 + nn) * K + k0 + kk) = pk;
  }
  __syncthreads();
}

DI int src_col(int mode, int nd) {
  if (mode == 0) return nd;
  if (mode == 1) return nd < 1024 ? nd : (nd < 3072 ? nd + 64 : (nd < 3136 ? nd - 2048 : -1));
  if (mode == 2) return nd < 2048 ? (nd >> 7) * 192 + (nd & 127) : ((nd - 2048) >> 6) * 192 + 128;
  return nd < 2048 ? (nd >> 7) * 256 + (nd & 127) : ((nd - 2048) >> 7) * 256 + 128 + ((nd - 2048) & 127);
}
DI void convert_tile256(const float* __restrict__ src, int ldn, const float* __restrict__ gain,
                        u16* __restrict__ dst, int K, int k0, int nd0, int mode, float* lds) {
  constexpr int LDW = 260;
  const int tid = TIDX();
  {
    const int col4 = tid & 63, row0 = tid >> 6;
    const int nd = nd0 + col4 * 4;
    const int sc = src_col(mode, nd & ~63);
    const float* sp = src + (size_t)(k0 + row0) * ldn + (sc + (nd & 63));
#pragma unroll
    for (int i = 0; i < 8; ++i) {
      float z = 0.f;
      asm volatile("" : "+v"(z));
      float4 v = make_float4(z, z, z, z);
      if (sc >= 0) {
        v = *(const float4*)(sp + (size_t)(8 * i) * ldn);
        if (gain) { const float gg = gain[k0 + row0 + 8 * i]; v.x *= gg; v.y *= gg; v.z *= gg; v.w *= gg; }
      }
      *(float4*)(lds + (row0 + 8 * i) * LDW + col4 * 4) = v;
    }
  }
  __syncthreads();
  {
    const int kc = tid & 7;
#pragma unroll
    for (int j = 0; j < 4; ++j) {
      const int n = (tid >> 3) + 64 * j;
      const float* lp = lds + (kc * 8) * LDW + n;
      u32x4 pk;
      pk[0] = pack_bf16(lp[0 * LDW], lp[1 * LDW]);
      pk[1] = pack_bf16(lp[2 * LDW], lp[3 * LDW]);
      pk[2] = pack_bf16(lp[4 * LDW], lp[5 * LDW]);
      pk[3] = pack_bf16(lp[6 * LDW], lp[7 * LDW]);
      *(u32x4*)(dst + (size_t)(nd0 + n) * K + k0 + kc * 8) = pk;
    }
  }
  __syncthreads();
}

template <bool GA>
DI void norm_row(const float* __restrict__ xrow, const float* __restrict__ g, u16* __restrict__ hrow,
                 float* __restrict__ orow, const float* wg, float* __restrict__ garow) {
  const int lane = TIDX() & 63;
  float4 v[8];
  float ss = 0.f;
#pragma unroll
  for (int i = 0; i < 8; ++i) {
    v[i] = ((const float4*)xrow)[lane + 64 * i];
    ss += v[i].x * v[i].x + v[i].y * v[i].y + v[i].z * v[i].z + v[i].w * v[i].w;
  }
  ss = wave_sum(ss);
  const float rstd = rsqrtf(ss * (1.f / 2048.f) + 1e-6f);
  float ga[16];
  if constexpr (GA) {
#pragma unroll
    for (int c = 0; c < 16; ++c) ga[c] = 0.f;
  }
#pragma unroll
  for (int i = 0; i < 8; ++i) {
    const float4 gg = ((const float4*)g)[lane + 64 * i];
    const float a = v[i].x * rstd * gg.x, b = v[i].y * rstd * gg.y, c = v[i].z * rstd * gg.z, d = v[i].w * rstd * gg.w;
    if (hrow) {
      u32x2 o; o[0] = pack_bf16(a, b); o[1] = pack_bf16(c, d);
      ((u32x2*)hrow)[lane + 64 * i] = o;
    } else {
      ((float4*)orow)[lane + 64 * i] = make_float4(a, b, c, d);
    }
    if constexpr (GA) {
#pragma unroll
      for (int cc = 0; cc < 16; ++cc) {
        const float4 w = ((const float4*)(wg + cc * 2052))[lane + 64 * i];
        ga[cc] += a * w.x + b * w.y + c * w.z + d * w.w;
      }
    }
  }
  if constexpr (GA) {
    float mine = 0.f;
#pragma unroll
    for (int cc = 0; cc < 16; ++cc) {
      const float t = wave_sum(ga[cc]);
      if (lane == cc) mine = t;
    }
    if (lane < 16) garow[lane] = mine;
  }
}

enum { M_BF16 = 0, M_SILU = 1, M_TRANS = 2, M_ROPE = 4, M_RESID = 5 };
struct GemmT {
  const u16* A; const u16* B; int lda, ldb, K;
  int mode, R0, C0, ld, aux, nact, probe, perm;
  u16* d16; float* d32; float scale; const float* rs; const float* xin; const float* cs; const float* sn;
};
constexpr int LDT = 72;

DI void gemm_tile(const GemmT& g, unsigned char* smem) {
  const int tid = TIDX(), lane = tid & 63, wave = tid >> 6;
  const int wm = (wave >> 2) * 128, wn = (wave & 3) * 64;
  const int r = lane & 31, h = lane >> 5;
  u16* sA = (u16*)smem;
  u16* sB = sA + 2 * 256 * LDT;
  const int lrow = tid >> 3, lch = (tid & 7) * 8;
  const u16* Ag = g.A + (size_t)lrow * g.lda + lch;
  const u16* Bg = g.B + (size_t)lrow * g.ldb + lch;
  const bool active = wm < g.nact;
  u32x4 ra[4], rb[4];
  f32x16 acc[4][2];
#pragma unroll
  for (int i = 0; i < 4; ++i)
#pragma unroll
    for (int j = 0; j < 2; ++j)
#pragma unroll
      for (int q = 0; q < 16; ++q) acc[i][j][q] = 0.f;

#pragma unroll
  for (int i = 0; i < 4; ++i) {
    ra[i] = *(const u32x4*)(Ag + (size_t)(64 * i) * g.lda);
    rb[i] = *(const u32x4*)(Bg + (size_t)(64 * i) * g.ldb);
  }
  __syncthreads();
#pragma unroll
  for (int i = 0; i < 4; ++i) {
    *(u32x4*)(sA + (lrow + 64 * i) * LDT + lch) = ra[i];
    *(u32x4*)(sB + (lrow + 64 * i) * LDT + lch) = rb[i];
  }
#pragma unroll
  for (int i = 0; i < 4; ++i) {
    ra[i] = *(const u32x4*)(Ag + (size_t)(64 * i) * g.lda + 64);
    rb[i] = *(const u32x4*)(Bg + (size_t)(64 * i) * g.ldb + 64);
  }
  __syncthreads();
  const int KT = g.K >> 6;
  for (int kt = 0; kt < KT; ++kt) {
    if (kt + 1 < KT) {
      u16* a_d = sA + ((kt + 1) & 1) * 256 * LDT;
      u16* b_d = sB + ((kt + 1) & 1) * 256 * LDT;
#pragma unroll
      for (int i = 0; i < 4; ++i) {
        *(u32x4*)(a_d + (lrow + 64 * i) * LDT + lch) = ra[i];
        *(u32x4*)(b_d + (lrow + 64 * i) * LDT + lch) = rb[i];
      }
    }
    if (kt + 2 < KT && !(PROBE_MODE == 1 && g.probe)) {
#pragma unroll
      for (int i = 0; i < 4; ++i) {
        ra[i] = *(const u32x4*)(Ag + (size_t)(64 * i) * g.lda + (kt + 2) * 64);
        rb[i] = *(const u32x4*)(Bg + (size_t)(64 * i) * g.ldb + (kt + 2) * 64);
      }
    }
    __builtin_amdgcn_sched_barrier(0);
    if (active) {
      const u16* a_s = sA + (kt & 1) * 256 * LDT + (wm + r) * LDT + 8 * h;
      const u16* b_s = sB + (kt & 1) * 256 * LDT + (wn + r) * LDT + 8 * h;
#pragma unroll
      for (int ks = 0; ks < 4; ++ks) {
        bf16x8 af[4], bf[2];
#pragma unroll
        for (int i = 0; i < 4; ++i) af[i] = *(const bf16x8*)(a_s + 32 * i * LDT + ks * 16);
#pragma unroll
        for (int j = 0; j < 2; ++j) bf[j] = *(const bf16x8*)(b_s + 32 * j * LDT + ks * 16);
#pragma unroll
        for (int i = 0; i < 4; ++i)
#pragma unroll
          for (int j = 0; j < 2; ++j) acc[i][j] = MFMA32(af[i], bf[j], acc[i][j]);
      }
    }
    __syncthreads();
  }
  if (!active) return;
  if (PROBE_MODE && g.probe) {
    float sacc = 0.f;
#pragma unroll
    for (int i = 0; i < 4; ++i)
#pragma unroll
      for (int j = 0; j < 2; ++j)
#pragma unroll
        for (int q = 0; q < 16; ++q) sacc += acc[i][j][q];
    if (sacc == 1.2345e-30f) g.d16[0] = 0;
    return;
  }

  const int mode = g.mode;
  if (mode == M_ROPE) {
#pragma unroll
    for (int j = 0; j < 2; ++j) {
      const int tok = g.C0 + wn + 32 * j + r;
      const float sc = g.scale * (g.rs ? g.rs[tok] : 1.f);
#pragma unroll
      for (int ip = 0; ip < 2; ++ip) {
        if (wm + 64 * ip < g.aux) {
#pragma unroll
          for (int g4 = 0; g4 < 4; ++g4) {
            const int c0 = 8 * g4 + 4 * h;
            const float4 cs = *(const float4*)(g.cs + (size_t)tok * 32 + c0);
            const float4 sn = *(const float4*)(g.sn + (size_t)tok * 32 + c0);
            const float a0 = acc[2 * ip][j][4 * g4 + 0] * sc, a1 = acc[2 * ip][j][4 * g4 + 1] * sc;
            const float a2 = acc[2 * ip][j][4 * g4 + 2] * sc, a3 = acc[2 * ip][j][4 * g4 + 3] * sc;
            const float b0 = acc[2 * ip + 1][j][4 * g4 + 0] * sc, b1 = acc[2 * ip + 1][j][4 * g4 + 1] * sc;
            const float b2 = acc[2 * ip + 1][j][4 * g4 + 2] * sc, b3 = acc[2 * ip + 1][j][4 * g4 + 3] * sc;
            u32x2 o1, o2;
            o1[0] = pack_bf16(a0 * cs.x - b0 * sn.x, a1 * cs.y - b1 * sn.y);
            o1[1] = pack_bf16(a2 * cs.z - b2 * sn.z, a3 * cs.w - b3 * sn.w);
            o2[0] = pack_bf16(b0 * cs.x + a0 * sn.x, b1 * cs.y + a1 * sn.y);
            o2[1] = pack_bf16(b2 * cs.z + a2 * sn.z, b3 * cs.w + a3 * sn.w);
            u16* dp = g.d16 + (size_t)tok * g.ld + g.R0 + wm + 64 * ip + c0;
            *(u32x2*)dp = o1;
            *(u32x2*)(dp + 32) = o2;
          }
        }
      }
    }
    return;
  }
  unsigned char* wreg = smem + wave * 17408;
  if (mode == M_RESID) {
#pragma unroll
    for (int j = 0; j < 2; ++j) {
#pragma unroll
      for (int i = 0; i < 4; ++i)
#pragma unroll
        for (int g4 = 0; g4 < 4; ++g4)
          *(float4*)(wreg + r * 528 + (32 * i + 8 * g4 + 4 * h) * 4) =
              make_float4(acc[i][j][4 * g4 + 0], acc[i][j][4 * g4 + 1], acc[i][j][4 * g4 + 2], acc[i][j][4 * g4 + 3]);
#pragma unroll
      for (int it = 0; it < 16; ++it) {
        const int row = 2 * it + h;
        const float4 v = *(const float4*)(wreg + row * 528 + r * 16);
        const size_t o = (size_t)(g.C0 + wn + 32 * j + row) * 2048 + g.R0 + wm + r * 4;
        const float4 x = *(const float4*)(g.xin + o);
        *(float4*)(g.d32 + o) = make_float4(x.x + v.x, x.y + v.y, x.z + v.z, x.w + v.w);
      }
    }
    return;
  }
#pragma unroll
  for (int j = 0; j < 2; ++j) {
    const int outer = g.C0 + wn + 32 * j + r;
    const float sc = (mode == M_BF16) ? g.scale * (g.rs ? g.rs[outer] : 1.f) : 1.f;
#pragma unroll
    for (int i = 0; i < 4; ++i)
#pragma unroll
      for (int g4 = 0; g4 < 4; ++g4) {
        float v0 = acc[i][j][4 * g4 + 0], v1 = acc[i][j][4 * g4 + 1], v2 = acc[i][j][4 * g4 + 2], v3 = acc[i][j][4 * g4 + 3];
        if (mode == M_BF16) { v0 *= sc; v1 *= sc; v2 *= sc; v3 *= sc; }
        else if (mode == M_SILU) { v0 = silu_f(v0); v1 = silu_f(v1); v2 = silu_f(v2); v3 = silu_f(v3); }
        else if (g.rs) {
          const float4 r4 = *(const float4*)(g.rs + g.R0 + wm + 32 * i + 8 * g4 + 4 * h);
          v0 *= r4.x; v1 *= r4.y; v2 *= r4.z; v3 *= r4.w;
        }
        u32x2 pk; pk[0] = pack_bf16(v0, v1); pk[1] = pack_bf16(v2, v3);
        *(u32x2*)(wreg + (32 * j + r) * 272 + (32 * i + 8 * g4 + 4 * h) * 2) = pk;
      }
  }
  {
    const int inner0 = g.R0 + wm;
#pragma unroll
    for (int it = 0; it < 16; ++it) {
      const int row = 4 * it + (lane >> 4), ch = lane & 15;
      const u32x4 v = *(const u32x4*)(wreg + row * 272 + ch * 16);
      const int outer = g.C0 + wn + row;
      size_t o;
      if (mode == M_TRANS) o = ((size_t)(inner0 >> 13) * g.aux + outer) * 8192 + (inner0 & 8191);
      else o = (size_t)outer * g.ld + inner0;
      *(u32x4*)(g.d16 + o + ch * 8) = v;
    }
  }
}

using f32x4v = __attribute__((ext_vector_type(4))) float;
DI int lds_byte8(int r, int c) {
  const int st = (r >> 4) * 2 + (c >> 5), rr = r & 15, cc = c & 31, ob = rr * 64 + cc * 2;
  return st * 1024 + (ob ^ (((ob >> 9) & 1) << 5));
}
DI void stage_rc8(int b, int& R, int& C) {
  const int st = b / 1024, sb = b % 1024, swz = sb ^ (((sb >> 9) & 1) << 5);
  R = (st >> 1) * 16 + swz / 64; C = (st & 1) * 32 + (swz % 64) / 2;
}
template <bool KR = false>
DI void gemm_tile8(const GemmT& g, unsigned char* smem) {
  constexpr int BK = 64, HALF = 128, HT = HALF * BK;
  u16* shm = (u16*)smem;
  const u16* A = g.A; const u16* Bt = g.B; const int K = g.K;
  const int tid = TIDX();
  const int nact = g.nact;
  #define SA8(b,h) (shm+((b)*2+(h))*HT)
  #define SB8(b,h) (shm+(4+(b)*2+(h))*HT)
  unsigned soff0, soff1;
  { int r_, c_; stage_rc8(tid * 16, r_, c_); soff0 = (unsigned)(r_ * K + c_); stage_rc8(tid * 16 + 8192, r_, c_); soff1 = (unsigned)(r_ * K + c_); }
  #define STAGE8(P,BASE,br,kt) do{ const u16* _gb = (BASE) + ((long)(br)*K+(long)(kt)*BK); \
      __builtin_amdgcn_global_load_lds((const unsigned*)(_gb + soff0), (unsigned*)((char*)(P)+tid*16),16,0,0); \
      __builtin_amdgcn_global_load_lds((const unsigned*)(_gb + soff1), (unsigned*)((char*)(P)+tid*16+8192),16,0,0); }while(0)
  #define LDA8(dst,b,h) _Pragma("unroll") for(int m=0;m<4;++m) _Pragma("unroll") for(int k=0;k<2;++k) \
    dst[m][k]=*reinterpret_cast<const bf16x8*>((const char*)SA8(b,h)+lds_byte8(wr*64+m*16+fr,k*32+fq*8))
  #define LDB8(dst,b,h) _Pragma("unroll") for(int n=0;n<2;++n) _Pragma("unroll") for(int k=0;k<2;++k) \
    dst[n][k]=*reinterpret_cast<const bf16x8*>((const char*)SB8(b,h)+lds_byte8(wc*32+n*16+fr,k*32+fq*8))
  #define MMA8(ai,bj,At_,Bt_) do{__builtin_amdgcn_s_setprio(1); \
    _Pragma("unroll") for(int m=0;m<4;++m) _Pragma("unroll") for(int n=0;n<2;++n) _Pragma("unroll") for(int k=0;k<2;++k) \
      acc[ai][bj][m][n]=__builtin_amdgcn_mfma_f32_16x16x32_bf16(At_[m][k],Bt_[n][k],acc[ai][bj][m][n],0,0,0); \
    __builtin_amdgcn_s_setprio(0);}while(0)
  #define MMA8C(ai,bj,At_,Bt_) do{ if (!KR || ((ai)*128 + wr*64 < nact)) MMA8(ai,bj,At_,Bt_); }while(0)
  #define WAIT_V8(n) asm volatile("s_waitcnt vmcnt(" #n ")":::"memory")
  #define WAIT_L8(n) asm volatile("s_waitcnt lgkmcnt(" #n ")":::"memory")
  #define BAR8 __builtin_amdgcn_s_barrier()
  #define SCHED8 __builtin_amdgcn_sched_barrier(0)
  f32x4v acc[2][2][4][2];
#pragma unroll
  for (int a = 0; a < 2; ++a)
#pragma unroll
    for (int b = 0; b < 2; ++b)
#pragma unroll
      for (int m = 0; m < 4; ++m)
#pragma unroll
        for (int n = 0; n < 2; ++n) acc[a][b][m][n] = f32x4v{0.f, 0.f, 0.f, 0.f};
  {
  const int wid = tid >> 6, lane = tid & 63, wr = wid >> 2, wc = wid & 3, fr = lane & 15, fq = lane >> 4;
  bf16x8 At[4][2], B0[2][2], B1[2][2];
  const int nt = K / BK;
  asm volatile("s_waitcnt lgkmcnt(0)" ::: "memory");
  __builtin_amdgcn_s_barrier();
  STAGE8(SB8(0,0),Bt,0,0); STAGE8(SA8(0,0),A,0,0);
  STAGE8(SB8(0,1),Bt,HALF,0); STAGE8(SA8(0,1),A,HALF,0);
  if (wr == 1) BAR8;
  WAIT_V8(4); BAR8;
  STAGE8(SB8(1,0),Bt,0,1); STAGE8(SA8(1,0),A,0,1); STAGE8(SB8(1,1),Bt,HALF,1);
  WAIT_V8(6); BAR8;
  for (int t = 0; t < nt - 2; t += 2) {
    LDB8(B0,0,0); SCHED8; LDA8(At,0,0); STAGE8(SA8(1,1),A,HALF,t+1);
    WAIT_L8(8); BAR8; WAIT_L8(0); MMA8C(0,0,At,B0); BAR8; SCHED8;
    LDB8(B1,0,1); STAGE8(SB8(0,0),Bt,0,t+2);
    BAR8; WAIT_L8(0); MMA8C(0,1,At,B1); BAR8;
    LDA8(At,0,1); STAGE8(SA8(0,0),A,0,t+2);
    BAR8; WAIT_L8(0); MMA8C(1,0,At,B0); BAR8; SCHED8;
    STAGE8(SB8(0,1),Bt,HALF,t+2);
    WAIT_V8(6); BAR8; MMA8C(1,1,At,B1); BAR8;
    LDB8(B0,1,0); SCHED8; LDA8(At,1,0); STAGE8(SA8(0,1),A,HALF,t+2);
    WAIT_L8(8); BAR8; WAIT_L8(0); MMA8C(0,0,At,B0); BAR8; SCHED8;
    LDB8(B1,1,1); STAGE8(SB8(1,0),Bt,0,t+3);
    BAR8; WAIT_L8(0); MMA8C(0,1,At,B1); BAR8;
    LDA8(At,1,1); STAGE8(SA8(1,0),A,0,t+3);
    BAR8; WAIT_L8(0); MMA8C(1,0,At,B0); BAR8; SCHED8;
    STAGE8(SB8(1,1),Bt,HALF,t+3);
    WAIT_V8(6); BAR8; MMA8C(1,1,At,B1); BAR8;
  }
  { LDB8(B0,0,0); LDA8(At,0,0); STAGE8(SA8(1,1),A,HALF,nt-1);
    BAR8; WAIT_L8(0); MMA8C(0,0,At,B0); BAR8;
    LDB8(B1,0,1); BAR8; WAIT_L8(0); MMA8C(0,1,At,B1); BAR8;
    LDA8(At,0,1); WAIT_V8(4); BAR8; WAIT_L8(0); MMA8C(1,0,At,B0); MMA8C(1,1,At,B1); BAR8; }
  { LDB8(B0,1,0); LDA8(At,1,0); WAIT_V8(2); BAR8; WAIT_L8(0); MMA8C(0,0,At,B0); BAR8;
    LDB8(B1,1,1); WAIT_V8(0); BAR8; WAIT_L8(0); MMA8C(0,1,At,B1); BAR8;
    LDA8(At,1,1); BAR8; WAIT_L8(0); MMA8C(1,0,At,B0); MMA8C(1,1,At,B1); BAR8; }
  if (wr == 0) BAR8;
  }

  const int mode = g.mode;
  unsigned char* wreg;
  int lane, wr, wc, fr, fq;
  { const int t2 = TIDX(); const int w2 = t2 >> 6; lane = t2 & 63; wr = w2 >> 2; wc = w2 & 3; fr = lane & 15; fq = lane >> 4; wreg = smem + w2 * 17408; }
  if (mode == M_RESID) {
#pragma unroll
    for (int bj = 0; bj < 2; ++bj) {
#pragma unroll
      for (int ai = 0; ai < 2; ++ai)
#pragma unroll
        for (int m = 0; m < 4; ++m)
#pragma unroll
          for (int n = 0; n < 2; ++n)
            *(f32x4v*)(wreg + (n * 16 + fr) * 528 + (ai * 64 + m * 16 + fq * 4) * 4) = acc[ai][bj][m][n];
#pragma unroll
      for (int it = 0; it < 16; ++it) {
        const int row = 2 * it + (lane >> 5), c4 = lane & 31;
        const float4 v = *(const float4*)(wreg + row * 528 + c4 * 16);
        const int ai = c4 >> 4, iin = (c4 & 15) * 4;
        const size_t o = (size_t)(g.C0 + bj * 128 + wc * 32 + row) * 2048 + g.R0 + ai * 128 + wr * 64 + iin;
        const float4 x = *(const float4*)(g.xin + o);
        *(float4*)(g.d32 + o) = make_float4(x.x + v.x, x.y + v.y, x.z + v.z, x.w + v.w);
      }
    }
    return;
  }
  if (mode == M_ROPE) {
#pragma unroll
    for (int bj = 0; bj < 2; ++bj)
#pragma unroll
      for (int n = 0; n < 2; ++n) {
        const int tok = g.C0 + bj * 128 + wc * 32 + n * 16 + fr;
        const float sc = g.scale * (g.rs ? g.rs[tok] : 1.f);
#pragma unroll
        for (int ai = 0; ai < 2; ++ai) {
          if (ai * 128 + wr * 64 < g.aux) {
#pragma unroll
            for (int m = 0; m < 2; ++m) {
              const int c0 = m * 16 + fq * 4;
              const float4 cs = *(const float4*)(g.cs + (size_t)tok * 32 + c0);
              const float4 sn = *(const float4*)(g.sn + (size_t)tok * 32 + c0);
              const f32x4v a = acc[ai][bj][m][n] * sc, b = acc[ai][bj][m + 2][n] * sc;
              u32x2 o1, o2;
              o1[0] = pack_bf16(a[0] * cs.x - b[0] * sn.x, a[1] * cs.y - b[1] * sn.y);
              o1[1] = pack_bf16(a[2] * cs.z - b[2] * sn.z, a[3] * cs.w - b[3] * sn.w);
              o2[0] = pack_bf16(b[0] * cs.x + a[0] * sn.x, b[1] * cs.y + a[1] * sn.y);
              o2[1] = pack_bf16(b[2] * cs.z + a[2] * sn.z, b[3] * cs.w + a[3] * sn.w);
              u16* dp = g.d16 + (size_t)tok * g.ld + g.R0 + ai * 128 + wr * 64 + c0;
              *(u32x2*)dp = o1;
              *(u32x2*)(dp + 32) = o2;
            }
          }
        }
      }
    return;
  }
  {
    const int fqp = g.perm ? (((fq & 1) << 1) | (fq >> 1)) : fq;
    unsigned char* wb = wreg + fr * 272 + fqp * 8;
    if (mode == M_BF16) {
#pragma unroll
      for (int bj = 0; bj < 2; ++bj)
#pragma unroll
        for (int n = 0; n < 2; ++n) {
          const int outer = g.C0 + bj * 128 + wc * 32 + n * 16 + fr;
          const float sc = g.scale * (g.rs ? g.rs[outer] : 1.f);
#pragma unroll
          for (int ai = 0; ai < 2; ++ai)
#pragma unroll
            for (int m = 0; m < 4; ++m) {
              const f32x4v v = acc[ai][bj][m][n] * sc;
              u32x2 pk; pk[0] = pack_bf16(v[0], v[1]); pk[1] = pack_bf16(v[2], v[3]);
              *(u32x2*)(wb + (bj * 32 + n * 16) * 272 + (ai * 64 + m * 16) * 2) = pk;
            }
        }
    } else if (mode == M_SILU) {
#pragma unroll
      for (int bj = 0; bj < 2; ++bj)
#pragma unroll
        for (int n = 0; n < 2; ++n)
#pragma unroll
          for (int ai = 0; ai < 2; ++ai)
#pragma unroll
            for (int m = 0; m < 4; ++m) {
              const f32x4v v = acc[ai][bj][m][n];
              u32x2 pk; pk[0] = pack_bf16(silu_f(v[0]), silu_f(v[1])); pk[1] = pack_bf16(silu_f(v[2]), silu_f(v[3]));
              *(u32x2*)(wb + (bj * 32 + n * 16) * 272 + (ai * 64 + m * 16) * 2) = pk;
            }
    } else {
      const float* rsp = g.rs ? g.rs + g.R0 + wr * 64 + fq * 4 : nullptr;
#pragma unroll
      for (int ai = 0; ai < 2; ++ai)
#pragma unroll
        for (int m = 0; m < 4; ++m) {
          float4 r4 = make_float4(1.f, 1.f, 1.f, 1.f);
          if (rsp) r4 = *(const float4*)(rsp + ai * 128 + m * 16);
#pragma unroll
          for (int bj = 0; bj < 2; ++bj)
#pragma unroll
            for (int n = 0; n < 2; ++n) {
              const f32x4v v = acc[ai][bj][m][n];
              u32x2 pk; pk[0] = pack_bf16(v[0] * r4.x, v[1] * r4.y); pk[1] = pack_bf16(v[2] * r4.z, v[3] * r4.w);
              *(u32x2*)(wb + (bj * 32 + n * 16) * 272 + (ai * 64 + m * 16) * 2) = pk;
            }
        }
    }
  }
  {
    const int ch = lane & 15, rsub = lane >> 4, ai = ch >> 3;
    const int outer0 = g.C0 + wc * 32 + rsub;
    const int inner0 = g.R0 + ai * 128 + wr * 64 + (ch & 7) * 8;
    size_t obase, ostride;
    if (mode == M_TRANS) { obase = ((size_t)(inner0 >> 13) * g.aux + outer0) * 8192 + (inner0 & 8191); ostride = 8192; }
    else { obase = (size_t)outer0 * g.ld + inner0; ostride = (size_t)g.ld; }
    const unsigned char* rb = wreg + rsub * 272 + ch * 16;
    u16* dp = g.d16 + obase;
#pragma unroll
    for (int it = 0; it < 16; ++it) {
      const u32x4 v = *(const u32x4*)(rb + it * 4 * 272);
      *(u32x4*)(dp + (size_t)((it >> 3) * 128 + (it & 7) * 4) * ostride) = v;
    }
  }
}

template <int DK, bool SB, int LDQN, int LDQR, int LDKN, int LDKR, int LDG>
DI void attn_item(const u16* __restrict__ Qn, const u16* __restrict__ Qr,
                  const u16* __restrict__ Kn, const u16* __restrict__ Kr,
                  const u16* __restrict__ Vt, const u16* __restrict__ Gt,
                  u16* __restrict__ Y, int q0, unsigned char* smem, int probe = 0) {
  constexpr int KS = DK / 16;
  constexpr int KROW_B = DK * 2;
  constexpr int KCH = DK / 8;
  constexpr int K_B = 64 * KROW_B;
  constexpr int STAGE_B = K_B + 128 * 128;
  constexpr int NKI = K_B / 8192;
  constexpr int G = NKI + 2;
  volatile __attribute__((address_space(3))) int* sflag = (volatile __attribute__((address_space(3))) int*)(smem + 3 * STAGE_B);
  const int tid = TIDX(), lane = tid & 63, wave = tid >> 6;
  const int r = lane & 31, h = lane >> 5;
  const int qrow = q0 + 32 * wave + r;
  const int qmin = q0 + 32 * wave, qmax = qmin + 31;

  bf16x8 bq[KS];
  {
    const u16* qp = Qn + (unsigned)(qrow * LDQN + 8 * h);
#pragma unroll
    for (int ks = 0; ks < 8; ++ks) bq[ks] = *(const bf16x8*)(qp + 16 * ks);
    if constexpr (!SB) {
      const u16* qp2 = Qr + (unsigned)(qrow * LDQR + 8 * h);
#pragma unroll
      for (int ks = 8; ks < KS; ++ks) bq[ks] = *(const bf16x8*)(qp2 + 16 * (ks - 8));
    }
  }
  f32x16 O[4];
#pragma unroll
  for (int d = 0; d < 4; ++d)
#pragma unroll
    for (int q = 0; q < 16; ++q) O[d][q] = 0.f;
  float m_run = -INFINITY, l_run = 0.f, R = 0.f;
  const int nt = (q0 >> 6) + 4;

  const u16* kbase[NKI]; unsigned isr = 0u; unsigned voff0;
#pragma unroll
  for (int j = 0; j < NKI; ++j) {
    const int L = 64 * (wave + 8 * j) + lane, row = L / KCH, p = L - row * KCH;
    const int c = SB ? (p ^ (row & 15)) : ((p & ~7) | ((p & 7) ^ ((row >> 1) & 7)));
    if (SB || c < 16) { kbase[j] = Kn + (unsigned)(row * LDKN + c * 8); }
    else { kbase[j] = Kr + (unsigned)(row * LDKR + (c - 16) * 8); isr |= 1u << j; }
  }
  {
    const int L = 64 * wave + lane, row = L >> 3, p = L & 7;
    voff0 = (unsigned)(row * 8192 + (p ^ ((row >> 1) & 7)) * 8);
  }
  auto issue_tile = [&](int kt, int st) {
    unsigned char* sKb = smem + st * STAGE_B;
#pragma unroll
    for (int j = 0; j < NKI; ++j) {
      const unsigned kstr = ((isr >> j) & 1u) ? 64u * LDKR : 64u * LDKN;
      __builtin_amdgcn_global_load_lds((const unsigned*)(kbase[j] + (size_t)kt * kstr),
                                       (unsigned*)(sKb + (wave + 8 * j) * 1024), 16, 0, 0);
    }
    const u16* vb_ = Vt + kt * 64;
#pragma unroll
    for (int j = 0; j < 2; ++j)
      __builtin_amdgcn_global_load_lds((const unsigned*)(vb_ + (size_t)j * 64 * 8192 + voff0),
                                       (unsigned*)(sKb + K_B + (wave + 8 * j) * 1024), 16, 0, 0);
  };
  const int s3 = (r >> 1) & 7, s4 = r & 15;

  asm volatile("s_waitcnt vmcnt(0)" ::: "memory");
  __syncthreads();
  issue_tile(SB ? nt - 1 : 0, 0);
  issue_tile(SB ? nt - 2 : 1, 1);
  asm volatile("s_waitcnt vmcnt(%0)" :: "n"(G) : "memory");
  asm volatile("s_waitcnt lgkmcnt(0)" ::: "memory");
  __builtin_amdgcn_s_barrier();
  auto tile_body = [&](int it, auto st_c) -> bool {
    constexpr int ST = decltype(st_c)::value;
    const int kt = SB ? (nt - 1 - it) : it;
    if (it + 2 < nt && !(PROBE_MODE == 3 && probe)) issue_tile(SB ? (nt - 3 - it) : (it + 2), (ST + 2) % 3);
    __builtin_amdgcn_sched_barrier(0);
    const unsigned char* sK = smem + ST * STAGE_B;
    const unsigned char* sV = sK + K_B;
    auto kchunk = [&](int ks) -> int {
      const int c = 2 * ks + h;
      return (SB ? (c ^ s4) : ((c & ~7) | ((c & 7) ^ s3))) * 16;
    };
    const int kbA = SB ? 1 : 0, kbB = SB ? 0 : 1;
    const int keyA = kt * 64 + 32 * kbA, keyB = kt * 64 + 32 * kbB;
    const bool skipA = SB ? (keyA >= qmax) : (keyA > qmax);
    const bool skipB = SB ? (keyB >= qmax) : (keyB > qmax);
    f32x16 SA_, SB_;
    {
      bf16x8 kf[KS];
      if (!skipA) {
        const unsigned char* kp = sK + (32 * kbA + r) * KROW_B;
#pragma unroll
        for (int ks = 0; ks < KS; ++ks) kf[ks] = *(const bf16x8*)(kp + kchunk(ks));
#pragma unroll
        for (int q = 0; q < 16; ++q) SA_[q] = 0.f;
        __builtin_amdgcn_sched_barrier(0);
#pragma unroll
        for (int ks = 0; ks < KS; ++ks) SA_ = MFMA32(kf[ks], bq[ks], SA_);
        __builtin_amdgcn_sched_barrier(0);
      }
      if (!skipB) {
        const unsigned char* kp = sK + (32 * kbB + r) * KROW_B;
#pragma unroll
        for (int ks = 0; ks < KS; ++ks) kf[ks] = *(const bf16x8*)(kp + kchunk(ks));
#pragma unroll
        for (int q = 0; q < 16; ++q) SB_[q] = 0.f;
        __builtin_amdgcn_sched_barrier(0);
#pragma unroll
        for (int ks = 0; ks < KS; ++ks) SB_ = MFMA32(kf[ks], bq[ks], SB_);
        __builtin_amdgcn_sched_barrier(0);
      }
    }
    auto math_pv = [&](f32x16& Sx, const int kb, const int key0) {
      bf16x8 vf[8];
#pragma unroll
      for (int d = 0; d < 4; ++d) vf[d] = *(const bf16x8*)(sV + (32 * d + r) * 128 + (((4 * kb + h) ^ s3) * 16));
      __builtin_amdgcn_sched_barrier(0);
      if constexpr (!SB) {
       if (!(PROBE_MODE == 4 && probe)) {
        if (key0 + 31 > qmin) {
#pragma unroll
          for (int q = 0; q < 16; ++q)
            if (key0 + crow(q, h) > qrow) Sx[q] = -INFINITY;
        }
        float mloc = Sx[0];
#pragma unroll
        for (int q = 1; q < 16; ++q) mloc = fmaxf(mloc, Sx[q]);
        mloc = xh_max(mloc);
        float mnew = m_run, alpha = 1.f;
        const bool need = __builtin_amdgcn_ballot_w64(mloc > m_run + 8.f) != 0ull;
        if (need) {
          mnew = fmaxf(m_run, mloc);
          alpha = __builtin_amdgcn_exp2f(m_run - mnew);
          m_run = mnew;
        }
        typedef float f32x2v __attribute__((ext_vector_type(2)));
        const f32x2v mm = {mnew, mnew};
        f32x2v ls2 = {0.f, 0.f};
#pragma unroll
        for (int q = 0; q < 8; ++q) {
          f32x2v t = {Sx[2 * q], Sx[2 * q + 1]};
          t = t - mm;
          t[0] = __builtin_amdgcn_exp2f(t[0]);
          t[1] = __builtin_amdgcn_exp2f(t[1]);
          Sx[2 * q] = t[0]; Sx[2 * q + 1] = t[1];
          ls2 = ls2 + t;
        }
        const float lsum = ls2[0] + ls2[1];
        l_run = l_run * alpha + lsum;
        if (need) {
#pragma unroll
          for (int d = 0; d < 4; ++d)
#pragma unroll
            for (int q = 0; q < 16; ++q) O[d][q] *= alpha;
        }
       }
      } else {
        f32x16 Lx;
        float gs[4], ps[4];
        if (key0 + 31 < qmin) {
#pragma unroll
          for (int q = 0; q < 16; ++q) {
            const float z0 = Sx[q];
            Lx[q] = -(fmaxf(z0, 0.f) + __builtin_amdgcn_logf(1.f + __builtin_amdgcn_exp2f(-fabsf(z0))));
          }
#pragma unroll
          for (int gq = 0; gq < 4; ++gq) {
            gs[gq] = (Lx[4 * gq] + Lx[4 * gq + 1]) + (Lx[4 * gq + 2] + Lx[4 * gq + 3]);
            ps[gq] = xh_partner(gs[gq], h);
          }
          float run = 0.f;
#pragma unroll
          for (int gq = 3; gq >= 0; --gq) {
            const float own = R + run + (h == 0 ? ps[gq] : 0.f);
            run += gs[gq] + ps[gq];
            const float a3 = own, a2 = a3 + Lx[4 * gq + 3], a1 = a2 + Lx[4 * gq + 2], a0 = a1 + Lx[4 * gq + 1];
            Sx[4 * gq + 0] = __builtin_amdgcn_exp2f(Sx[4 * gq + 0] + Lx[4 * gq + 0] + a0);
            Sx[4 * gq + 1] = __builtin_amdgcn_exp2f(Sx[4 * gq + 1] + Lx[4 * gq + 1] + a1);
            Sx[4 * gq + 2] = __builtin_amdgcn_exp2f(Sx[4 * gq + 2] + Lx[4 * gq + 2] + a2);
            Sx[4 * gq + 3] = __builtin_amdgcn_exp2f(Sx[4 * gq + 3] + Lx[4 * gq + 3] + a3);
          }
          R += run;
        } else {
#pragma unroll
          for (int q = 0; q < 16; ++q) {
            const float z0 = Sx[q];
            const float sp0 = fmaxf(z0, 0.f) + __builtin_amdgcn_logf(1.f + __builtin_amdgcn_exp2f(-fabsf(z0)));
            Lx[q] = (key0 + crow(q, h) < qrow) ? -sp0 : 0.f;
          }
#pragma unroll
          for (int gq = 0; gq < 4; ++gq) {
            gs[gq] = (Lx[4 * gq] + Lx[4 * gq + 1]) + (Lx[4 * gq + 2] + Lx[4 * gq + 3]);
            ps[gq] = xh_partner(gs[gq], h);
          }
          float run = 0.f;
#pragma unroll
          for (int gq = 3; gq >= 0; --gq) {
            const float own = R + run + (h == 0 ? ps[gq] : 0.f);
            run += gs[gq] + ps[gq];
            const int key = key0 + 8 * gq + 4 * h;
            const float a3 = own, a2 = a3 + Lx[4 * gq + 3], a1 = a2 + Lx[4 * gq + 2], a0 = a1 + Lx[4 * gq + 1];
            const float e0 = __builtin_amdgcn_exp2f(Sx[4 * gq + 0] + Lx[4 * gq + 0] + a0);
            const float e1 = __builtin_amdgcn_exp2f(Sx[4 * gq + 1] + Lx[4 * gq + 1] + a1);
            const float e2 = __builtin_amdgcn_exp2f(Sx[4 * gq + 2] + Lx[4 * gq + 2] + a2);
            const float e3 = __builtin_amdgcn_exp2f(Sx[4 * gq + 3] + Lx[4 * gq + 3] + a3);
            Sx[4 * gq + 0] = (key + 0 < qrow) ? e0 : 0.f;
            Sx[4 * gq + 1] = (key + 1 < qrow) ? e1 : 0.f;
            Sx[4 * gq + 2] = (key + 2 < qrow) ? e2 : 0.f;
            Sx[4 * gq + 3] = (key + 3 < qrow) ? e3 : 0.f;
          }
          R += run;
        }
      }
      const bf16x8 pf0 = pack8(Sx, 0), pf1 = pack8(Sx, 1);
      __builtin_amdgcn_sched_barrier(0);
#pragma unroll
      for (int d = 0; d < 4; ++d) vf[4 + d] = *(const bf16x8*)(sV + (32 * d + r) * 128 + (((4 * kb + 2 + h) ^ s3) * 16));
#pragma unroll
      for (int d = 0; d < 4; ++d) O[d] = MFMA32(vf[d], pf0, O[d]);
      __builtin_amdgcn_sched_barrier(0);
#pragma unroll
      for (int d = 0; d < 4; ++d) O[d] = MFMA32(vf[4 + d], pf1, O[d]);
      __builtin_amdgcn_sched_barrier(0);
    };
    if (!skipA) math_pv(SA_, kbA, keyA);
    if (!skipB) math_pv(SB_, kbB, keyB);
    if constexpr (SB) {
      const bool done = (__builtin_amdgcn_ballot_w64(!(R < -150.1f)) == 0ull);
      if (lane == 0) sflag[(it & 1) * 8 + wave] = done ? 1 : 0;
    }
    if (it + 2 < nt) asm volatile("s_waitcnt vmcnt(%0)" :: "n"(G) : "memory");
    else asm volatile("s_waitcnt vmcnt(0)" ::: "memory");
    asm volatile("s_waitcnt lgkmcnt(0)" ::: "memory");
    __builtin_amdgcn_s_barrier();
    if constexpr (SB) {
      const volatile __attribute__((address_space(3))) int* f = sflag + (it & 1) * 8;
      if (f[0] & f[1] & f[2] & f[3] & f[4] & f[5] & f[6] & f[7]) return true;
    }
    return false;
  };
  for (int it = 0; it < nt; it += 3) {
    if (tile_body(it, std::integral_constant<int, 0>{})) break;
    if (it + 1 >= nt) break;
    if (tile_body(it + 1, std::integral_constant<int, 1>{})) break;
    if (it + 2 >= nt) break;
    if (tile_body(it + 2, std::integral_constant<int, 2>{})) break;
  }

  if (PROBE_MODE >= 3 && probe) {
    float sacc = l_run;
#pragma unroll
    for (int d = 0; d < 4; ++d)
#pragma unroll
      for (int q = 0; q < 16; ++q) sacc += O[d][q];
    if (sacc == 1.2345e-30f) Y[0] = 0;
    return;
  }
  float inv = 1.f;
  if constexpr (!SB) {
    const float lt = xh_sum(l_run);
    inv = 1.f / lt;
  }
  const u16* gp = Gt + (unsigned)(qrow * LDG + 4 * h);
  u16* yp = Y + (unsigned)(qrow * 2048 + 4 * h);
#pragma unroll
  for (int d = 0; d < 4; ++d)
#pragma unroll
    for (int gq = 0; gq < 4; ++gq) {
      const int dv = 32 * d + 8 * gq;
      const u32x2 gt = *(const u32x2*)(gp + dv);
      u32x2 o;
      o[0] = pack_bf16(O[d][4 * gq + 0] * inv * bf_lo(gt[0]), O[d][4 * gq + 1] * inv * bf_hi(gt[0]));
      o[1] = pack_bf16(O[d][4 * gq + 2] * inv * bf_lo(gt[1]), O[d][4 * gq + 3] * inv * bf_hi(gt[1]));
      *(u32x2*)(yp + dv) = o;
    }
}

DI void gla_g1(const Params& p, int li, int unit, unsigned char* smem) {
  const int c = unit & 127, bh = unit >> 7, b = bh >> 2, hh = bh & 3;
  const size_t m0 = (size_t)b * S_ + c * 64;
  float* lf = (float*)smem;
  u16* klT = (u16*)(smem + 32768);
  const float* GA = (const float*)(p.ws + E_GA);
  u16* GQ = (u16*)(p.ws + E_GQ);
  u16* GK = (u16*)(p.ws + E_GK);
  const u16* GVT = (const u16*)(p.ws + E_GVT);
  float* EBL = (float*)(p.ws + E_EBL);
  float* SC = (float*)(p.ws + E_SC);
  const float* au_p = p.alpha_up + (size_t)li * 16 * 512;
  const float* bias_p = p.alpha_bias + (size_t)li * 512;
  const int tid = TIDX(), lane = tid & 63, wave = tid >> 6;
  const int r = lane & 31, h = lane >> 5;
  {
    const int d = tid & 127, th = tid >> 7;
    float au[16];
#pragma unroll
    for (int q = 0; q < 16; ++q) au[q] = au_p[q * 512 + hh * 128 + d];
    const float bs = bias_p[hh * 128 + d];
    for (int tt = 0; tt < 16; ++tt) {
      const int t = th * 16 + tt;
      const float4* ga = (const float4*)(GA + (m0 + t) * 16);
      float s = bs;
#pragma unroll
      for (int q = 0; q < 4; ++q) {
        const float4 g4 = ga[q];
        s += g4.x * au[4 * q] + g4.y * au[4 * q + 1] + g4.z * au[4 * q + 2] + g4.w * au[4 * q + 3];
      }
      const float sp = fmaxf(-s, 0.f) + __logf(1.f + __expf(-fabsf(s)));
      lf[t * 128 + d] = -sp * (1.f / 16.f);
    }
  }
  __syncthreads();
  {
    const int d = tid & 127, sg = tid >> 7;
    float run = 0.f;
#pragma unroll
    for (int t = 0; t < 16; ++t) { run += lf[(sg * 16 + t) * 128 + d]; lf[(sg * 16 + t) * 128 + d] = run; }
    __syncthreads();
    float off = 0.f;
    if (sg > 0) off += lf[15 * 128 + d];
    if (sg > 1) off += lf[31 * 128 + d];
    if (sg > 2) off += lf[47 * 128 + d];
    __syncthreads();
    if (sg > 0) {
#pragma unroll
      for (int t = 0; t < 16; ++t) lf[(sg * 16 + t) * 128 + d] += off;
    }
  }
  __syncthreads();
#pragma unroll 1
  for (int i = 0; i < 2; ++i) {
    const int idx = tid + 512 * i;
    const int t = idx >> 4, d0 = (idx & 15) * 8;
    u16* qp = GQ + (m0 + t) * 512 + hh * 128 + d0;
    u16* kp = GK + (m0 + t) * 512 + hh * 128 + d0;
    const u32x4 qv = *(const u32x4*)qp;
    const u32x4 kv = *(const u32x4*)kp;
    u32x4 qo, ko;
#pragma unroll
    for (int jj = 0; jj < 4; ++jj) {
      const float bb0 = lf[t * 128 + d0 + 2 * jj], bb1 = lf[t * 128 + d0 + 2 * jj + 1];
      const float bl0 = lf[63 * 128 + d0 + 2 * jj], bl1 = lf[63 * 128 + d0 + 2 * jj + 1];
      const float q0 = bf_lo(qv[jj]), q1 = bf_hi(qv[jj]);
      const float k0 = bf_lo(kv[jj]), k1 = bf_hi(kv[jj]);
      qo[jj] = pack_bf16(q0 * 0.08838834764831845f * __expf(bb0), q1 * 0.08838834764831845f * __expf(bb1));
      ko[jj] = pack_bf16(k0 * __expf(-bb0), k1 * __expf(-bb1));
      klT[(d0 + 2 * jj) * 72 + t] = to_bf16(k0 * __expf(bl0 - bb0));
      klT[(d0 + 2 * jj + 1) * 72 + t] = to_bf16(k1 * __expf(bl1 - bb1));
    }
    *(u32x4*)qp = qo;
    *(u32x4*)kp = ko;
  }
  if (tid < 128) EBL[(size_t)unit * 128 + tid] = __expf(lf[63 * 128 + tid]);
  __syncthreads();
  {
    f32x16 acc[4];
#pragma unroll
    for (int j = 0; j < 4; ++j)
#pragma unroll
      for (int q = 0; q < 16; ++q) acc[j][q] = 0.f;
    const u16* vp = GVT + ((size_t)(bh * 256 + 32 * wave + r)) * 8192 + c * 64 + 8 * h;
#pragma unroll
    for (int ks = 0; ks < 4; ++ks) {
      const bf16x8 bv = *(const bf16x8*)(vp + 16 * ks);
#pragma unroll
      for (int db = 0; db < 4; ++db) {
        const bf16x8 ak = *(const bf16x8*)(klT + (32 * db + r) * 72 + 16 * ks + 8 * h);
        acc[db] = MFMA32(ak, bv, acc[db]);
      }
    }
    u16* SC16 = (u16*)SC;
    u16* sp = SC16 + ((size_t)unit * 256 + 32 * wave + r) * 128 + 4 * h;
#pragma unroll
    for (int db = 0; db < 4; ++db)
#pragma unroll
      for (int g4 = 0; g4 < 4; ++g4) {
        u32x2 pk;
        pk[0] = pack_bf16(acc[db][4 * g4 + 0], acc[db][4 * g4 + 1]);
        pk[1] = pack_bf16(acc[db][4 * g4 + 2], acc[db][4 * g4 + 3]);
        *(u32x2*)(sp + 32 * db + 8 * g4) = pk;
      }
  }
  __syncthreads();
}

DI void gla_scan(const Params& p) {
  u16* SC16 = (u16*)(p.ws + E_SC);
  const float* EBL = (const float*)(p.ws + E_EBL);
  for (int cp = blockIdx.x * 512 + TIDX(); cp < 131072; cp += gridDim.x * 512) {
    const int bh = cp >> 14, rem = cp & 16383, e = rem >> 6, d2 = (rem & 63) * 2;
    u16* base = SC16 + ((size_t)(bh * 128) * 256 + e) * 128 + d2;
    const float* eb = EBL + (size_t)(bh * 128) * 128 + d2;
    float sx = 0.f, sy = 0.f;
#pragma unroll 8
    for (int c = 0; c < 128; ++c) {
      const unsigned sv = *(const unsigned*)(base + (size_t)c * 32768);
      const float2 f = *(const float2*)(eb + c * 128);
      *(unsigned*)(base + (size_t)c * 32768) = pack_bf16(sx, sy);
      sx = f.x * sx + bf_lo(sv);
      sy = f.y * sy + bf_hi(sv);
    }
  }
}

DI void gla_g3(const Params& p, int li, int unit, unsigned char* smem) {
  const int c = unit & 127, bh = unit >> 7, b = bh >> 2, hh = bh & 3;
  const size_t m0 = (size_t)b * S_ + c * 64;
  float* red = (float*)smem;
  const u16* GQ = (const u16*)(p.ws + E_GQ);
  const u16* GK = (const u16*)(p.ws + E_GK);
  const u16* GVT = (const u16*)(p.ws + E_GVT);
  const u16* GG = (const u16*)(p.ws + E_GG);
  const float* SC = (const float*)(p.ws + E_SC);
  u16* Y = (u16*)(p.ws + OFF_H);
  const float* gn = p.gla_norm + (size_t)li * 256;
  const int tid = TIDX(), lane = tid & 63, wave = tid >> 6;
  const int r = lane & 31, h = lane >> 5;

  bf16x8 bq[2][8];
#pragma unroll
  for (int ib = 0; ib < 2; ++ib)
#pragma unroll
    for (int ks = 0; ks < 8; ++ks)
      bq[ib][ks] = *(const bf16x8*)(GQ + (m0 + 32 * ib + r) * 512 + hh * 128 + 16 * ks + 8 * h);
  f32x16 X00, X01, X11;
#pragma unroll
  for (int q = 0; q < 16; ++q) { X00[q] = 0.f; X01[q] = 0.f; X11[q] = 0.f; }
#pragma unroll
  for (int ks = 0; ks < 8; ++ks) {
    const bf16x8 a0 = *(const bf16x8*)(GK + (m0 + r) * 512 + hh * 128 + 16 * ks + 8 * h);
    const bf16x8 a1 = *(const bf16x8*)(GK + (m0 + 32 + r) * 512 + hh * 128 + 16 * ks + 8 * h);
    X00 = MFMA32(a0, bq[0][ks], X00);
    X01 = MFMA32(a0, bq[1][ks], X01);
    X11 = MFMA32(a1, bq[1][ks], X11);
  }
#pragma unroll
  for (int q = 0; q < 16; ++q) {
    if (crow(q, h) > r) { X00[q] = 0.f; X11[q] = 0.f; }
  }
  f32x16 acc[2];
#pragma unroll
  for (int j = 0; j < 2; ++j)
#pragma unroll
    for (int q = 0; q < 16; ++q) acc[j][q] = 0.f;
  {
    const u16* st = (const u16*)SC + ((size_t)unit * 256 + 32 * wave + r) * 128 + 8 * h;
#pragma unroll
    for (int ks = 0; ks < 8; ++ks) {
      const bf16x8 a = *(const bf16x8*)(st + 16 * ks);
      acc[0] = MFMA32(a, bq[0][ks], acc[0]);
      acc[1] = MFMA32(a, bq[1][ks], acc[1]);
    }
  }
  {
    const u16* vr = GVT + ((size_t)(bh * 256 + 32 * wave + r)) * 8192 + c * 64;
#pragma unroll
    for (int s = 0; s < 2; ++s) {
      const bf16x8 pf00 = pack8(X00, s), pf01 = pack8(X01, s), pf11 = pack8(X11, s);
      {
        const s16x4 lo = *(const s16x4*)(vr + 16 * s + 4 * h);
        const s16x4 hi = *(const s16x4*)(vr + 16 * s + 8 + 4 * h);
        const bf16x8 a = __builtin_shufflevector(lo, hi, 0, 1, 2, 3, 4, 5, 6, 7);
        acc[0] = MFMA32(a, pf00, acc[0]);
        acc[1] = MFMA32(a, pf01, acc[1]);
      }
      {
        const s16x4 lo = *(const s16x4*)(vr + 32 + 16 * s + 4 * h);
        const s16x4 hi = *(const s16x4*)(vr + 32 + 16 * s + 8 + 4 * h);
        const bf16x8 a = __builtin_shufflevector(lo, hi, 0, 1, 2, 3, 4, 5, 6, 7);
        acc[1] = MFMA32(a, pf11, acc[1]);
      }
    }
  }
  float rstd[2];
#pragma unroll
  for (int ib = 0; ib < 2; ++ib) {
    float ss = 0.f;
#pragma unroll
    for (int q = 0; q < 16; ++q) ss += acc[ib][q] * acc[ib][q];
    ss = xh_sum(ss);
    if (h == 0) red[wave * 64 + 32 * ib + r] = ss;
  }
  __syncthreads();
#pragma unroll
  for (int ib = 0; ib < 2; ++ib) {
    float tot = 0.f;
#pragma unroll
    for (int w = 0; w < 8; ++w) tot += red[w * 64 + 32 * ib + r];
    rstd[ib] = rsqrtf(tot * (1.f / 256.f) + 1e-6f);
  }
#pragma unroll
  for (int ib = 0; ib < 2; ++ib)
#pragma unroll
    for (int gq = 0; gq < 4; ++gq) {
      const int e = 32 * wave + 8 * gq + 4 * h;
      const size_t m = m0 + 32 * ib + r;
      const u32x2 gt = *(const u32x2*)(GG + m * 1024 + hh * 256 + e);
      const float4 g4 = *(const float4*)(gn + e);
      const float rs = rstd[ib];
      u32x2 o;
      o[0] = pack_bf16(acc[ib][4 * gq + 0] * rs * g4.x * bf_lo(gt[0]), acc[ib][4 * gq + 1] * rs * g4.y * bf_hi(gt[0]));
      o[1] = pack_bf16(acc[ib][4 * gq + 2] * rs * g4.z * bf_lo(gt[1]), acc[ib][4 * gq + 3] * rs * g4.w * bf_hi(gt[1]));
      *(u32x2*)(Y + m * 2048 + 1024 + hh * 256 + e) = o;
    }
  __syncthreads();
}

__device__ const double kInvFreq[32] = {1.0, 0.7498942093324559, 0.5623413251903491, 0.4216965034285822, 0.31622776601683794, 0.23713737056616552, 0.1778279410038923, 0.1333521432163324, 0.1, 0.07498942093324558, 0.05623413251903491, 0.042169650342858224, 0.03162277660168379, 0.023713737056616554, 0.01778279410038923, 0.01333521432163324, 0.01, 0.007498942093324558, 0.005623413251903491, 0.004216965034285823, 0.0031622776601683794, 0.0023713737056616554, 0.0017782794100389228, 0.001333521432163324, 0.001, 0.0007498942093324559, 0.0005623413251903491, 0.00042169650342858224, 0.00031622776601683794, 0.00023713737056616554, 0.00017782794100389227, 0.0001333521432163324};

#define XB_TMO      128
#define XB_XCNT(j)  (256  + 64 * (j))
#define XB_XSUB(j)  (1280 + 64 * (j))
#define XB_XGEN(j)  (2304 + 64 * (j))
#define XB_TOP      3328
#define XB_TOPGEN   3392
#define XCD_BAR_WORDS 3456
#define XB_SPIN_CAP (1u << 20)
#define LAS __attribute__((address_space(3)))
DI unsigned xb_ld(unsigned* p)              { return __hip_atomic_load(p, __ATOMIC_RELAXED, __HIP_MEMORY_SCOPE_AGENT); }
DI unsigned xb_add(unsigned* p, unsigned v) { return __hip_atomic_fetch_add(p, v, __ATOMIC_RELAXED, __HIP_MEMORY_SCOPE_AGENT); }
DI unsigned xb_xcc_id() { return (unsigned)__builtin_amdgcn_s_getreg((3 << 11) | 20) & 0xFu; }
#define XB_SPIN(cond, bar) do { unsigned _sp = 0; while (cond) { __builtin_amdgcn_s_sleep(1); \
    if ((++_sp & 255u) == 0u) { if (xb_ld(&(bar)[XB_TMO])) break; if (_sp > XB_SPIN_CAP) { atomicAdd(&(bar)[XB_TMO], 1u); break; } } } } while (0)
struct XcdBarrier { unsigned* bar; unsigned x; volatile LAS unsigned* st; };
DI XcdBarrier xcd_barrier_post(unsigned* bar, volatile LAS unsigned* st) {
  XcdBarrier b; b.bar = bar; b.x = xb_xcc_id(); b.st = st;
  if (__builtin_amdgcn_workitem_id_x() == 0) (void)xb_add(&bar[XB_XCNT(b.x)], 1u);
  return b;
}
DI void xcd_barrier_complete(unsigned* bar, unsigned x, unsigned& nloc, unsigned& nx) {
  const unsigned G = gridDim.x * gridDim.y * gridDim.z;
  unsigned sum, cnt, mine, sp = 0u;
  for (;;) {
    sum = 0u; cnt = 0u; mine = 0u;
#pragma unroll
    for (unsigned j = 0; j < 16; ++j) { const unsigned c = xb_ld(&bar[XB_XCNT(j)]); sum += c; cnt += (c > 0u) ? 1u : 0u; mine = (j == x) ? c : mine; }
    if (sum == G) break;
    __builtin_amdgcn_s_sleep(1);
    if ((++sp & 255u) == 0u) { if (xb_ld(&bar[XB_TMO])) break; if (sp > XB_SPIN_CAP) { atomicAdd(&bar[XB_TMO], 1u); break; } }
  }
  nloc = mine > 0u ? mine : 1u; nx = cnt > 0u ? cnt : 1u;
}
DI void xcd_barrier(const XcdBarrier& b) {
  asm volatile("s_waitcnt vmcnt(0)" ::: "memory");
  __syncthreads();
  if (__builtin_amdgcn_workitem_id_x() == 0) {
    unsigned* bar = b.bar;
    __builtin_amdgcn_s_waitcnt(0);
    unsigned nloc = b.st[0], nx = b.st[1];
    if (nloc == 0u) { xcd_barrier_complete(bar, b.x, nloc, nx); b.st[0] = nloc; b.st[1] = nx; }
    const unsigned old = xb_add(&bar[XB_XSUB(b.x)], 1u);
    const unsigned gen = old / nloc;
    if (old + 1u == (gen + 1u) * nloc) {
      __builtin_amdgcn_fence(__ATOMIC_RELEASE, "agent");
      asm volatile("s_waitcnt vmcnt(0)" ::: "memory");
      const unsigned og = xb_add(&bar[XB_TOP], 1u);
      const unsigned tg = og / nx;
      if (og + 1u == (tg + 1u) * nx) xb_add(&bar[XB_TOPGEN], 1u);
      else XB_SPIN(xb_ld(&bar[XB_TOPGEN]) == tg, bar);
      __builtin_amdgcn_fence(__ATOMIC_ACQUIRE, "agent");
      xb_add(&bar[XB_XGEN(b.x)], 1u);
      asm volatile("s_waitcnt vmcnt(0)" ::: "memory");
    } else {
      XB_SPIN(xb_ld(&bar[XB_XGEN(b.x)]) == gen, bar);
      __builtin_amdgcn_fence(__ATOMIC_ACQUIRE, "agent");
      asm volatile("s_waitcnt vmcnt(0)" ::: "memory");
    }
  }
  __syncthreads();
}

constexpr int WG_LD = 2052;

DI GemmT gt_init(int K) {
  GemmT g;
  g.A = nullptr; g.B = nullptr; g.K = K; g.lda = K; g.ldb = K;
  g.mode = M_BF16; g.R0 = 0; g.C0 = 0; g.ld = 0; g.aux = 0; g.nact = 256; g.probe = 0; g.perm = 0;
  g.d16 = nullptr; g.d32 = nullptr; g.scale = 1.f; g.rs = nullptr; g.xin = nullptr; g.cs = nullptr; g.sn = nullptr;
  return g;
}

DI void tile_map(int t, int TN, int& tm, int& tn) {
  const int b = t & 255, k = t >> 8;
  const int x = b & 7, j = b >> 3;
  const int G = k * 8 + x;
  const int gpr = TN >> 2;
  const int gm = G / gpr, gn = G - gm * gpr;
  tm = gm * 8 + (j >> 2); tn = gn * 4 + (j & 3);
}

DI void phase_prep(const Params& p, int L, unsigned char* smem) {
  const bool even = (L & 1) == 0;
  const int li = L >> 1;
  u16* WL = (u16*)(p.ws + OFF_WL);
  float* lds = (float*)smem;
  if (L == 0) {
    float* cs = (float*)(p.ws + OFF_COS);
    float* sn = (float*)(p.ws + OFF_SIN);
    for (int i = blockIdx.x * 512 + TIDX(); i < T_ * 32; i += gridDim.x * 512) {
      const int m = i >> 5, f = i & 31;
      const double ang = (double)p.pos[m] * kInvFreq[f];
      const double t = ang * 0.63661977236758134308;
      const double kq = rint(t);
      const double rr = (t - kq) * 1.57079632679489661923;
      const int qd = (int)((long long)kq & 3);
      const double r2 = rr * rr;
      const double sr = rr * (1.0 - r2 / 6.0 * (1.0 - r2 / 20.0 * (1.0 - r2 / 42.0 * (1.0 - r2 / 72.0 * (1.0 - r2 / 110.0 * (1.0 - r2 / 156.0))))));
      const double cr = 1.0 - r2 / 2.0 * (1.0 - r2 / 12.0 * (1.0 - r2 / 30.0 * (1.0 - r2 / 56.0 * (1.0 - r2 / 90.0 * (1.0 - r2 / 132.0 * (1.0 - r2 / 182.0))))));
      const double cc = (qd == 0) ? cr : (qd == 1) ? -sr : (qd == 2) ? -cr : sr;
      const double sv = (qd == 0) ? sr : (qd == 1) ? cr : (qd == 2) ? -sr : -cr;
      cs[i] = (float)cc;
      sn[i] = (float)sv;
    }
  }
  if (even) {
    const float* win = p.w_in_even + (size_t)li * 2048 * 7184;
    const float* wout = p.w_out_even + (size_t)li * 2048 * 2048;
    const int n1 = 28 * 32, n2 = 8 * 32;
    for (int t = blockIdx.x; t < n1 + n2; t += gridDim.x) {
      if (t < n1) convert_tile256(win, 7184, nullptr, WL + WE_IN, 2048, (t & 31) * 64, (t >> 5) * 256, 0, lds);
      else { const int u = t - n1; convert_tile256(wout, 2048, nullptr, WL + WE_OUT, 2048, (u & 31) * 64, (u >> 5) * 256, 0, lds); }
    }
  } else {
    const float* win = p.w_in_odd + (size_t)li * 2048 * 3136;
    const float* wq = p.w_q_up + (size_t)li * 512 * 3072;
    const float* wkv = p.w_kv_up + (size_t)li * 512 * 4096;
    const float* wout = p.w_out_odd + (size_t)li * 2048 * 2048;
    const int n1 = 13 * 32, n2 = 12 * 8, n3 = 16 * 8, n4 = 8 * 32;
    for (int t = blockIdx.x; t < n1 + n2 + n3 + n4; t += gridDim.x) {
      if (t < n1) convert_tile256(win, 3136, nullptr, WL + WO_IN, 2048, (t & 31) * 64, (t >> 5) * 256, 1, lds);
      else if (t < n1 + n2) { const int u = t - n1; convert_tile256(wq, 3072, p.q_norm + (size_t)li * 512, WL + WO_Q, 512, (u & 7) * 64, (u >> 3) * 256, 2, lds); }
      else if (t < n1 + n2 + n3) { const int u = t - n1 - n2; convert_tile256(wkv, 4096, p.kv_norm + (size_t)li * 512, WL + WO_KV, 512, (u & 7) * 64, (u >> 3) * 256, 3, lds); }
      else { const int u = t - n1 - n2 - n3; convert_tile256(wout, 2048, nullptr, WL + WO_OUT, 2048, (u & 31) * 64, (u >> 5) * 256, 0, lds); }
    }
  }
  const float* xin = (L == 0) ? p.x : p.out;
  const float* g = even ? (p.ln_even + (size_t)li * 2048) : (p.ln_odd + (size_t)li * 2048);
  u16* H = (u16*)(p.ws + OFF_H);
  const int wave = TIDX() >> 6;
  if (even) {
    const float* wsrc = p.w_in_even + (size_t)li * 2048 * 7184 + 7168;
    const int tid = TIDX();
    for (int idx = tid; idx < 2048 * 16; idx += 512) {
      const int k = idx >> 4, c = idx & 15;
      lds[c * WG_LD + k] = wsrc[(size_t)k * 7184 + c];
    }
    __syncthreads();
    float* GA = (float*)(p.ws + E_GA);
    for (int row = blockIdx.x * 8 + wave; row < T_; row += gridDim.x * 8)
      norm_row<true>(xin + (size_t)row * 2048, g, H + (size_t)row * 2048, nullptr, lds, GA + (size_t)row * 16);
    __syncthreads();
  } else {
    for (int row = blockIdx.x * 8 + wave; row < T_; row += gridDim.x * 8)
      norm_row<false>(xin + (size_t)row * 2048, g, H + (size_t)row * 2048, nullptr, nullptr, nullptr);
  }
}

DI void phase_gemm_in_even(const Params& p, unsigned char* smem, int probe) {
  const u16* WL = (const u16*)(p.ws + OFF_WL);
  const u16* H = (const u16*)(p.ws + OFF_H);
  const int NT = 28;
  for (int t = blockIdx.x; t < 64 * NT; t += gridDim.x) {
    int tm, tn; tile_map(t, NT, tm, tn);
    GemmT g = gt_init(2048);
    const u16* Wt = WL + WE_IN + (size_t)tn * 256 * 2048;
    const u16* Ht = H + (size_t)tm * 256 * 2048;
    const bool trans = (tn >= 8 && tn < 12) || (tn >= 20 && tn < 24);
    if (trans) { g.A = Ht; g.B = Wt; g.R0 = tm * 256; } else { g.A = Wt; g.B = Ht; g.C0 = tm * 256; }
    if (tn < 4)       { g.mode = M_BF16; g.d16 = (u16*)(p.ws + E_SQ); g.ld = 1024; g.R0 = tn * 256; g.scale = 0.08838834764831845f * 1.4426950408889634f; }
    else if (tn < 8)  { g.mode = M_BF16; g.d16 = (u16*)(p.ws + E_SK); g.ld = 1024; g.R0 = (tn - 4) * 256; }
    else if (tn < 12) { g.mode = M_TRANS; g.d16 = (u16*)(p.ws + E_SVT); g.aux = 1024; g.C0 = (tn - 8) * 256; g.perm = 1; }
    else if (tn < 16) { g.mode = M_SILU; g.d16 = (u16*)(p.ws + E_SG); g.ld = 1024; g.R0 = (tn - 12) * 256; }
    else if (tn < 18) { g.mode = M_BF16; g.d16 = (u16*)(p.ws + E_GQ); g.ld = 512; g.R0 = (tn - 16) * 256; }
    else if (tn < 20) { g.mode = M_BF16; g.d16 = (u16*)(p.ws + E_GK); g.ld = 512; g.R0 = (tn - 18) * 256; }
    else if (tn < 24) { g.mode = M_TRANS; g.d16 = (u16*)(p.ws + E_GVT); g.aux = 1024; g.C0 = (tn - 20) * 256; }
    else              { g.mode = M_SILU; g.d16 = (u16*)(p.ws + E_GG); g.ld = 1024; g.R0 = (tn - 24) * 256; }
    g.probe = probe;
    gemm_tile8(g, smem);
  }
}

DI void phase_gemm_in_odd(const Params& p, unsigned char* smem) {
  const u16* WL = (const u16*)(p.ws + OFF_WL);
  const u16* H = (const u16*)(p.ws + OFF_H);
  const int NT = 12;
  for (int t = blockIdx.x; t < 64 * NT; t += gridDim.x) {
    int tm, tn; tile_map(t, NT, tm, tn);
    GemmT g = gt_init(2048);
    g.A = WL + WO_IN + (size_t)tn * 256 * 2048;
    g.B = H + (size_t)tm * 256 * 2048;
    g.C0 = tm * 256;
    if (tn < 2)      { g.mode = M_BF16; g.d16 = (u16*)(p.ws + O_QL); g.ld = 512; g.R0 = tn * 256; }
    else if (tn < 4) { g.mode = M_BF16; g.d16 = (u16*)(p.ws + O_KVL); g.ld = 512; g.R0 = (tn - 2) * 256; }
    else             { g.mode = M_SILU; g.d16 = (u16*)(p.ws + O_GATE); g.ld = 2048; g.R0 = (tn - 4) * 256; }
    gemm_tile8(g, smem);
  }
}

DI void phase_rstd_kr(const Params& p, unsigned char* smem) {
  for (int t = blockIdx.x; t < 64; t += gridDim.x) {
    GemmT g = gt_init(2048);
    g.A = (const u16*)(p.ws + OFF_WL) + WO_IN + (size_t)3072 * 2048;
    g.B = (const u16*)(p.ws + OFF_H) + (size_t)t * 256 * 2048;
    g.R0 = 0; g.C0 = t * 256; g.nact = 64; g.aux = 64;
    g.mode = M_ROPE; g.d16 = (u16*)(p.ws + O_KR); g.ld = 64;
    g.cs = (const float*)(p.ws + OFF_COS); g.sn = (const float*)(p.ws + OFF_SIN);
    gemm_tile8<true>(g, smem);
  }
  const u16* QL = (const u16*)(p.ws + O_QL);
  const u16* KVL = (const u16*)(p.ws + O_KVL);
  float* RSQ = (float*)(p.ws + O_RSQ);
  float* RSKV = (float*)(p.ws + O_RSKV);
  const int wave = TIDX() >> 6, lane = TIDX() & 63;
  for (int row = blockIdx.x * 8 + wave; row < 2 * T_; row += gridDim.x * 8) {
    const int m = row >> 1;
    const u16* src = (row & 1) ? KVL : QL;
    const u32x4 v = *(const u32x4*)(src + (size_t)m * 512 + lane * 8);
    float ss = 0.f;
#pragma unroll
    for (int q = 0; q < 4; ++q) { const float a = bf_lo(v[q]), b = bf_hi(v[q]); ss += a * a + b * b; }
    ss = wave_sum(ss);
    if (lane == 0) ((row & 1) ? RSKV : RSQ)[m] = rsqrtf(ss * (1.f / 512.f) + 1e-6f);
  }
}

DI void phase_gemm_up(const Params& p, unsigned char* smem) {
  const u16* WL = (const u16*)(p.ws + OFF_WL);
  const u16* QL = (const u16*)(p.ws + O_QL);
  const u16* KVL = (const u16*)(p.ws + O_KVL);
  const float* RSQ = (const float*)(p.ws + O_RSQ);
  const float* RSKV = (const float*)(p.ws + O_RSKV);
  const float qscale = 0.07216878364870322f * 1.4426950408889634f;
  const int NT = 28;
  for (int t = blockIdx.x; t < 64 * NT; t += gridDim.x) {
    int tm, tn; tile_map(t, NT, tm, tn);
    GemmT g = gt_init(512);
    if (tn < 8) {
      g.A = WL + WO_Q + (size_t)tn * 256 * 512; g.B = QL + (size_t)tm * 256 * 512;
      g.mode = M_BF16; g.d16 = (u16*)(p.ws + O_QN); g.ld = 2048; g.R0 = tn * 256; g.C0 = tm * 256; g.rs = RSQ; g.scale = qscale;
    } else if (tn < 12) {
      g.A = WL + WO_Q + (size_t)(2048 + (tn - 8) * 256) * 512; g.B = QL + (size_t)tm * 256 * 512;
      g.mode = M_ROPE; g.d16 = (u16*)(p.ws + O_QR); g.ld = 1024; g.R0 = (tn - 8) * 256; g.C0 = tm * 256; g.aux = 256; g.rs = RSQ; g.scale = qscale;
      g.cs = (const float*)(p.ws + OFF_COS); g.sn = (const float*)(p.ws + OFF_SIN);
    } else if (tn < 20) {
      g.A = WL + WO_KV + (size_t)(tn - 12) * 256 * 512; g.B = KVL + (size_t)tm * 256 * 512;
      g.mode = M_BF16; g.d16 = (u16*)(p.ws + O_KN); g.ld = 2048; g.R0 = (tn - 12) * 256; g.C0 = tm * 256; g.rs = RSKV;
    } else {
      g.A = KVL + (size_t)tm * 256 * 512; g.B = WL + WO_KV + (size_t)(2048 + (tn - 20) * 256) * 512;
      g.mode = M_TRANS; g.d16 = (u16*)(p.ws + O_VT); g.aux = 2048; g.R0 = tm * 256; g.C0 = (tn - 20) * 256; g.rs = RSKV; g.perm = 1;
    }
    gemm_tile8(g, smem);
  }
}

DI void phase_gemm_out(const Params& p, int L, unsigned char* smem) {
  const bool even = (L & 1) == 0;
  const u16* WL = (const u16*)(p.ws + OFF_WL) + (even ? WE_OUT : WO_OUT);
  const u16* Y = (const u16*)(p.ws + OFF_H);
  const float* xin = (L == 0) ? p.x : p.out;
  for (int t = blockIdx.x; t < 64 * 8; t += gridDim.x) {
    int tm, tn; tile_map(t, 8, tm, tn);
    GemmT g = gt_init(2048);
    g.A = WL + (size_t)tn * 256 * 2048; g.B = Y + (size_t)tm * 256 * 2048;
    g.mode = M_RESID; g.R0 = tn * 256; g.C0 = tm * 256; g.d32 = p.out; g.xin = xin;
    gemm_tile8(g, smem);
  }
}

DI int next_item(int* ctr, int* sitem) {
  if (TIDX() == 0) *sitem = atomicAdd(ctr, 1);
  __syncthreads();
  const int it = *sitem;
  __syncthreads();
  return it;
}

DI void phase_even_mix(const Params& p, int L, int ph, unsigned char* smem, int* sitem, bool do_g1) {
  int* ctr = (int*)(p.ws + OFF_CTR) + ph;
  const int li = L >> 1;
  for (;;) {
    const int it = next_item(ctr, sitem);
    if (it >= 1536) break;
    if (it < 512) {
      const int qb = 31 - (it >> 4), bh = it & 15, b = bh >> 3, hh = bh & 7;
      const u16* SQ = (const u16*)(p.ws + E_SQ) + (size_t)b * S_ * 1024 + hh * 128;
      const u16* SK = (const u16*)(p.ws + E_SK) + (size_t)b * S_ * 1024 + hh * 128;
      const u16* SVT = (const u16*)(p.ws + E_SVT) + ((size_t)(b * 1024 + hh * 128)) * 8192;
      const u16* SG = (const u16*)(p.ws + E_SG) + (size_t)b * S_ * 1024 + hh * 128;
      u16* Y = (u16*)(p.ws + OFF_H) + (size_t)b * S_ * 2048 + hh * 128;
      attn_item<128, true, 1024, 0, 1024, 0, 1024>(SQ, nullptr, SK, nullptr, SVT, SG, Y, qb * 256, smem);
    } else {
      if (do_g1) gla_g1(p, li, it - 512, smem);
    }
  }
}

DI void phase_gla_out(const Params& p, int L, int ph, unsigned char* smem, int* sitem) {
  int* ctr = (int*)(p.ws + OFF_CTR) + ph;
  const int li = L >> 1;
  for (;;) {
    const int it = next_item(ctr, sitem);
    if (it >= 1024) break;
    gla_g3(p, li, it, smem);
  }
}

DI void mla_item(const Params& p, int bh, int qb, unsigned char* smem, int probe) {
  const int b = bh >> 4, hh = bh & 15;
  const u16* QN = (const u16*)(p.ws + O_QN) + (size_t)b * S_ * 2048 + hh * 128;
  const u16* QR = (const u16*)(p.ws + O_QR) + (size_t)b * S_ * 1024 + hh * 64;
  const u16* KN = (const u16*)(p.ws + O_KN) + (size_t)b * S_ * 2048 + hh * 128;
  const u16* KR = (const u16*)(p.ws + O_KR) + (size_t)b * S_ * 64;
  const u16* VT = (const u16*)(p.ws + O_VT) + ((size_t)(b * 2048 + hh * 128)) * 8192;
  const u16* GT = (const u16*)(p.ws + O_GATE) + (size_t)b * S_ * 2048 + hh * 128;
  u16* Y = (u16*)(p.ws + OFF_H) + (size_t)b * S_ * 2048 + hh * 128;
  attn_item<192, false, 2048, 1024, 2048, 64, 2048>(QN, QR, KN, KR, VT, GT, Y, qb * 256, smem, probe);
}

DI void phase_mla(const Params& p, int ph, unsigned char* smem, int* sitem, int probe) {
  if (gridDim.x == 256) {
    const int x = blockIdx.x & 7, j = blockIdx.x >> 3, half = j >> 4, jp = j & 15;
#pragma unroll 1
    for (int pass = 0; pass < 2; ++pass) {
      const int bh = 4 * x + 2 * pass + half;
      mla_item(p, bh, 31 - jp, smem, probe);
      mla_item(p, bh, jp, smem, probe);
    }
    return;
  }
  int* ctr = (int*)(p.ws + OFF_CTR) + 64 + (ph % 24) * 8;
  const int x = (int)(xb_xcc_id() & 7u);
  for (;;) {
    if (TIDX() == 0) {
      int it = -1;
      for (int k = 0; k < 8; ++k) {
        const int q = (x + k) & 7;
        const int v = atomicAdd(ctr + q, 1);
        if (v < 128) { it = q * 128 + v; break; }
      }
      *sitem = it;
    }
    __syncthreads();
    const int it = *sitem;
    __syncthreads();
    if (it < 0) break;
    const int q = it >> 7, v = it & 127;
    mla_item(p, 4 * q + (v >> 5), 31 - (v & 31), smem, probe);
  }
}

DI void phase_final(const Params& p) {
  const int wave = TIDX() >> 6;
  for (int row = blockIdx.x * 8 + wave; row < T_; row += gridDim.x * 8)
    norm_row<false>(p.out + (size_t)row * 2048, p.final_norm, nullptr, p.out + (size_t)row * 2048, nullptr, nullptr);
}

__global__ void __launch_bounds__(512, 2) fwd_kernel(Params p_arg, int ph0, int ph1) {
  __shared__ __attribute__((aligned(16))) unsigned char smem[SMEM_BYTES + 64];
  int& sitem = *(int*)(smem + SMEM_BYTES);
  uint4& xb_words = *(uint4*)(smem + SMEM_BYTES + 16);
  cg::grid_group grid = cg::this_grid();
  if (__builtin_amdgcn_workitem_id_x() == 0) xb_words = make_uint4(0u, 0u, 0u, 0u);
  __syncthreads();
  XcdBarrier xb = xcd_barrier_post((unsigned*)(p_arg.ws + OFF_BAR), (volatile LAS unsigned*)&xb_words);
  if (ph1 > 1000) grid.sync();
  typedef const __attribute__((address_space(4))) Params* KP;
  const KP kp0 = (KP)__builtin_amdgcn_kernarg_segment_ptr();
  for (int ph = ph0; ph < ph1; ++ph) {
   for (int rep = 0; rep < 2; ++rep) {
    if (rep == 1) { if (!((REPEAT_MASK >> ph) & 1)) break; xcd_barrier(xb); }
    const int cph = ph + 32 * rep;
    KP kq = kp0;
    asm volatile("" : "+s"(kq));
    const Params& p = *(const Params*)kq;
    if (ph == 24) {
      phase_final(p);
    } else {
      const int L = ph / 6, sub = ph % 6;
      const bool even = (L & 1) == 0;
      if (sub == 0) { if (PH_MASK & 1) phase_prep(p, L, smem); }
      else if (sub == 1) { if (even) { if (PH_MASK & 2) phase_gemm_in_even(p, smem, rep); } else { if (PH_MASK & 4) phase_gemm_in_odd(p, smem); } }
      else if (sub == 2) { if (even) { if (PH_MASK & 8) phase_even_mix(p, L, cph, smem, &sitem, rep == 0); } else { if (PH_MASK & 16) phase_rstd_kr(p, smem); } }
      else if (sub == 3) { if (even) { if (PH_MASK & 32) gla_scan(p); } else { if (PH_MASK & 64) phase_gemm_up(p, smem); } }
      else if (sub == 4) { if (even) { if (PH_MASK & 128) phase_gla_out(p, L, cph, smem, &sitem); } else { if (PH_MASK & 256) phase_mla(p, cph, smem, &sitem, rep); } }
      else { if (PH_MASK & 512) phase_gemm_out(p, L, smem); }
    }
   }
    if (ph + 1 < ph1) xcd_barrier(xb);
  }
}

extern "C" void kernel_launch(void* const* d_in, const int* in_sizes, int n_in, void* d_out, int out_size,
                              void* d_ws, size_t ws_size, hipStream_t stream) {
  static int grid_blocks = 0;
  if (!grid_blocks) {
    int dev = 0, cus = 0, per_cu = 0;
    (void)hipGetDevice(&dev);
    (void)hipDeviceGetAttribute(&cus, hipDeviceAttributeMultiprocessorCount, dev);
    (void)hipOccupancyMaxActiveBlocksPerMultiprocessor(&per_cu, fwd_kernel, 512, 0);
    if (per_cu < 1) per_cu = 1;
    if (per_cu > 1) per_cu = 1;
    grid_blocks = cus * per_cu;
  }
  if (ws_size < WS_NEED) { fprintf(stderr, "workspace too small: %zu\n", ws_size); return; }
  Params p{};
  p.x = (const float*)d_in[0]; p.pos = (const int*)d_in[1];
  p.ln_even = (const float*)d_in[2]; p.w_in_even = (const float*)d_in[3];
  p.alpha_up = (const float*)d_in[4]; p.alpha_bias = (const float*)d_in[5];
  p.gla_norm = (const float*)d_in[6]; p.w_out_even = (const float*)d_in[7];
  p.ln_odd = (const float*)d_in[8]; p.w_in_odd = (const float*)d_in[9];
  p.q_norm = (const float*)d_in[10]; p.w_q_up = (const float*)d_in[11];
  p.kv_norm = (const float*)d_in[12]; p.w_kv_up = (const float*)d_in[13];
  p.w_out_odd = (const float*)d_in[14]; p.final_norm = (const float*)d_in[15];
  p.out = (float*)d_out; p.ws = (unsigned char*)d_ws;
  (void)hipMemsetAsync((unsigned char*)d_ws + OFF_CTR, 0, 16384, stream);
  int a0 = 0, a1 = NPHASE;
  void* args[] = {&p, &a0, &a1};
  hipError_t e = hipLaunchCooperativeKernel((void*)fwd_kernel, dim3(grid_blocks), dim3(512), args, 0, stream);
  if (e != hipSuccess) fprintf(stderr, "cooperative launch failed: %s (grid %d)\n", hipGetErrorString(e), grid_blocks);
}
```

```cpp
#include <hip/hip_runtime.h>
#include <hip/hip_cooperative_groups.h>
#include <cstdio>
#include <cstdint>
#include <type_traits>
namespace cg = cooperative_groups;

#ifndef ONE_LAUNCH
#define ONE_LAUNCH 1
#endif

#ifndef REPEAT_MASK
#define REPEAT_MASK 0
#endif
#ifndef PROBE_MODE
#define PROBE_MODE 0
#endif
#ifndef PH_MASK
#define PH_MASK 0xFFFF
#endif
#define DI __device__ __forceinline__
typedef unsigned short u16;
using bf16x8 = __attribute__((ext_vector_type(8))) short;
using s16x4  = __attribute__((ext_vector_type(4))) short;
using f32x16 = __attribute__((ext_vector_type(16))) float;
using u32x4  = __attribute__((ext_vector_type(4))) unsigned;
using u32x2  = __attribute__((ext_vector_type(2))) unsigned;
#define MFMA32(a, b, c) __builtin_amdgcn_mfma_f32_32x32x16_bf16((a), (b), (c), 0, 0, 0)

constexpr int S_ = 8192;
constexpr int T_ = 16384;
constexpr size_t MiB = (size_t)1 << 20;

constexpr size_t OFF_WL = 0;
constexpr size_t OFF_H  = 40 * MiB;
constexpr size_t OFF_L  = 104 * MiB;
constexpr size_t E_SQ  = OFF_L + 0 * MiB;
constexpr size_t E_SK  = OFF_L + 32 * MiB;
constexpr size_t E_SVT = OFF_L + 64 * MiB;
constexpr size_t E_SG  = OFF_L + 96 * MiB;
constexpr size_t E_GQ  = OFF_L + 128 * MiB;
constexpr size_t E_GK  = OFF_L + 144 * MiB;
constexpr size_t E_GVT = OFF_L + 160 * MiB;
constexpr size_t E_GG  = OFF_L + 192 * MiB;
constexpr size_t E_GA  = OFF_L + 224 * MiB;
constexpr size_t E_EBL = OFF_L + 225 * MiB;
constexpr size_t E_SC  = OFF_L + 226 * MiB;
constexpr size_t O_QL   = OFF_L + 0 * MiB;
constexpr size_t O_KVL  = OFF_L + 16 * MiB;
constexpr size_t O_GATE = OFF_L + 32 * MiB;
constexpr size_t O_KR   = OFF_L + 96 * MiB;
constexpr size_t O_RSQ  = OFF_L + 98 * MiB;
constexpr size_t O_RSKV = OFF_L + 98 * MiB + 65536;
constexpr size_t O_QN   = OFF_L + 99 * MiB;
constexpr size_t O_QR   = OFF_L + 163 * MiB;
constexpr size_t O_KN   = OFF_L + 195 * MiB;
constexpr size_t O_VT   = OFF_L + 259 * MiB;
constexpr size_t OFF_COS = 460 * MiB;
constexpr size_t OFF_SIN = 462 * MiB;
constexpr size_t OFF_CTR = 464 * MiB;
constexpr size_t OFF_BAR = 464 * MiB + 1024;
constexpr size_t WS_NEED = 465 * MiB;

constexpr size_t WE_IN = 0;
constexpr size_t WE_OUT = (size_t)7168 * 2048;
constexpr size_t WO_IN = 0;
constexpr size_t WO_Q = (size_t)3328 * 2048;
constexpr size_t WO_KV = WO_Q + (size_t)3072 * 512;
constexpr size_t WO_OUT = WO_KV + (size_t)4096 * 512;

constexpr int NPHASE = 25;
constexpr int SMEM_BYTES = 147456;

struct Params {
  const float* x; const int* pos;
  const float* ln_even; const float* w_in_even; const float* alpha_up; const float* alpha_bias;
  const float* gla_norm; const float* w_out_even;
  const float* ln_odd; const float* w_in_odd; const float* q_norm; const float* w_q_up;
  const float* kv_norm; const float* w_kv_up; const float* w_out_odd;
  const float* final_norm;
  float* out; unsigned char* ws;
};

DI unsigned pack_bf16(float a, float b) {
  typedef __bf16 bf2 __attribute__((ext_vector_type(2)));
  typedef float f2 __attribute__((ext_vector_type(2)));
  f2 v = {a, b};
  bf2 r = __builtin_convertvector(v, bf2);
  return __builtin_bit_cast(unsigned, r);
}
DI u16 to_bf16(float a) { return (u16)(pack_bf16(a, 0.f) & 0xffffu); }
DI float bf_lo(unsigned w) { return __uint_as_float(w << 16); }
DI float bf_hi(unsigned w) { return __uint_as_float(w & 0xffff0000u); }
DI int TIDX() { int t = __builtin_amdgcn_workitem_id_x(); asm volatile("" : "+v"(t)); return t; }
DI int crow(int reg, int h) { return (reg & 3) + 8 * (reg >> 2) + 4 * h; }
DI float xh_max(float x) {
  const auto r = __builtin_amdgcn_permlane32_swap(__float_as_uint(x), __float_as_uint(x), false, false);
  return fmaxf(__uint_as_float(r[0]), __uint_as_float(r[1]));
}
DI float xh_sum(float x) {
  const auto r = __builtin_amdgcn_permlane32_swap(__float_as_uint(x), __float_as_uint(x), false, false);
  return __uint_as_float(r[0]) + __uint_as_float(r[1]);
}
DI float xh_partner(float x, int h) {
  const auto r = __builtin_amdgcn_permlane32_swap(__float_as_uint(x), __float_as_uint(x), false, false);
  return h ? __uint_as_float(r[0]) : __uint_as_float(r[1]);
}
DI float dpp_add(float v, const int ctrl_tag) {
  int r;
  if (ctrl_tag == 0) r = __builtin_amdgcn_update_dpp(0, __float_as_int(v), 0xB1, 0xf, 0xf, true);
  else if (ctrl_tag == 1) r = __builtin_amdgcn_update_dpp(0, __float_as_int(v), 0x4E, 0xf, 0xf, true);
  else if (ctrl_tag == 2) r = __builtin_amdgcn_update_dpp(0, __float_as_int(v), 0x141, 0xf, 0xf, true);
  else r = __builtin_amdgcn_update_dpp(0, __float_as_int(v), 0x140, 0xf, 0xf, true);
  return v + __int_as_float(r);
}
DI float wave_sum(float v) {
  v = dpp_add(v, 0); v = dpp_add(v, 1); v = dpp_add(v, 2); v = dpp_add(v, 3);
  { const auto r = __builtin_amdgcn_permlane16_swap(__float_as_uint(v), __float_as_uint(v), false, false);
    v = __uint_as_float(r[0]) + __uint_as_float(r[1]); }
  return xh_sum(v);
}
DI float silu_f(float v) { return v * __builtin_amdgcn_rcpf(1.f + __expf(-v)); }
DI bf16x8 pack8(const f32x16& x, int s) {
  u32x4 p;
  p[0] = pack_bf16(x[8 * s + 0], x[8 * s + 1]);
  p[1] = pack_bf16(x[8 * s + 2], x[8 * s + 3]);
  p[2] = pack_bf16(x[8 * s + 4], x[8 * s + 5]);
  p[3] = pack_bf16(x[8 * s + 6], x[8 * s + 7]);
  return __builtin_bit_cast(bf16x8, p);
}

DI void convert_tile(const float* __restrict__ src, int ldn, const float* __restrict__ gain,
                     u16* __restrict__ dst, int K, int k0, int nd0, int ns0, int nvalid, float* lds) {
  const int tid = TIDX();
  const int c = tid & 63, r0 = tid >> 6;
#pragma unroll
  for (int i = 0; i < 8; ++i) {
    const int r = r0 + 8 * i;
    float v = 0.f;
    if (c < nvalid) {
      v = src[(size_t)(k0 + r) * ldn + ns0 + c];
      if (gain) v *= gain[k0 + r];
    }
    lds[r * 65 + c] = v;
  }
  __syncthreads();
  const int kk = (tid & 31) * 2, n = tid >> 5;
#pragma unroll
  for (int i = 0; i < 4; ++i) {
    const int nn = n + 16 * i;
    const unsigned pk = pack_bf16(lds[kk * 65 + nn], lds[(kk + 1) * 65 + nn]);
    *(unsigned*)(dst + (size_t)(nd0 + nn) * K + k0 + kk) = pk;
  }
  __syncthreads();
}

DI int src_col(int mode, int nd) {
  if (mode == 0) return nd;
  if (mode == 1) return nd < 1024 ? nd : (nd < 3072 ? nd + 64 : (nd < 3136 ? nd - 2048 : -1));
  if (mode == 2) return nd < 2048 ? (nd >> 7) * 192 + (nd & 127) : ((nd - 2048) >> 6) * 192 + 128;
  return nd < 2048 ? (nd >> 7) * 256 + (nd & 127) : ((nd - 2048) >> 7) * 256 + 128 + ((nd - 2048) & 127);
}
DI void convert_tile256(const float* __restrict__ src, int ldn, const float* __restrict__ gain,
                        u16* __restrict__ dst, int K, int k0, int nd0, int mode, float* lds) {
  constexpr int LDW = 260;
  const int tid = TIDX();
  {
    const int col4 = tid & 63, row0 = tid >> 6;
    const int nd = nd0 + col4 * 4;
    const int sc = src_col(mode, nd & ~63);
    const float* sp = src + (size_t)(k0 + row0) * ldn + (sc + (nd & 63));
#pragma unroll
    for (int i = 0; i < 8; ++i) {
      float z = 0.f;
      asm volatile("" : "+v"(z));
      float4 v = make_float4(z, z, z, z);
      if (sc >= 0) {
        v = *(const float4*)(sp + (size_t)(8 * i) * ldn);
        if (gain) { const float gg = gain[k0 + row0 + 8 * i]; v.x *= gg; v.y *= gg; v.z *= gg; v.w *= gg; }
      }
      *(float4*)(lds + (row0 + 8 * i) * LDW + col4 * 4) = v;
    }
  }
  __syncthreads();
  {
    const int kc = tid & 7;
#pragma unroll
    for (int j = 0; j < 4; ++j) {
      const int n = (tid >> 3) + 64 * j;
      const float* lp = lds + (kc * 8) * LDW + n;
      u32x4 pk;
      pk[0] = pack_bf16(lp[0 * LDW], lp[1 * LDW]);
      pk[1] = pack_bf16(lp[2 * LDW], lp[3 * LDW]);
      pk[2] = pack_bf16(lp[4 * LDW], lp[5 * LDW]);
      pk[3] = pack_bf16(lp[6 * LDW], lp[7 * LDW]);
      *(u32x4*)(dst + (size_t)(nd0 + n) * K + k0 + kc * 8) = pk;
    }
  }
  __syncthreads();
}

template <bool GA>
DI void norm_row(const float* __restrict__ xrow, const float* __restrict__ g, u16* __restrict__ hrow,
                 float* __restrict__ orow, const float* wg, float* __restrict__ garow) {
  const int lane = TIDX() & 63;
  float4 v[8];
  float ss = 0.f;
#pragma unroll
  for (int i = 0; i < 8; ++i) {
    v[i] = ((const float4*)xrow)[lane + 64 * i];
    ss += v[i].x * v[i].x + v[i].y * v[i].y + v[i].z * v[i].z + v[i].w * v[i].w;
  }
  ss = wave_sum(ss);
  const float rstd = rsqrtf(ss * (1.f / 2048.f) + 1e-6f);
  float ga[16];
  if constexpr (GA) {
#pragma unroll
    for (int c = 0; c < 16; ++c) ga[c] = 0.f;
  }
#pragma unroll
  for (int i = 0; i < 8; ++i) {
    const float4 gg = ((const float4*)g)[lane + 64 * i];
    const float a = v[i].x * rstd * gg.x, b = v[i].y * rstd * gg.y, c = v[i].z * rstd * gg.z, d = v[i].w * rstd * gg.w;
    if (hrow) {
      u32x2 o; o[0] = pack_bf16(a, b); o[1] = pack_bf16(c, d);
      ((u32x2*)hrow)[lane + 64 * i] = o;
    } else {
      ((float4*)orow)[lane + 64 * i] = make_float4(a, b, c, d);
    }
    if constexpr (GA) {
#pragma unroll
      for (int cc = 0; cc < 16; ++cc) {
        const float4 w = ((const float4*)(wg + cc * 2052))[lane + 64 * i];
        ga[cc] += a * w.x + b * w.y + c * w.z + d * w.w;
      }
    }
  }
  if constexpr (GA) {
    float mine = 0.f;
#pragma unroll
    for (int cc = 0; cc < 16; ++cc) {
      const float t = wave_sum(ga[cc]);
      if (lane == cc) mine = t;
    }
    if (lane < 16) garow[lane] = mine;
  }
}

enum { M_BF16 = 0, M_SILU = 1, M_TRANS = 2, M_ROPE = 4, M_RESID = 5 };
struct GemmT {
  const u16* A; const u16* B; int lda, ldb, K;
  int mode, R0, C0, ld, aux, nact, probe, perm;
  u16* d16; float* d32; float scale; const float* rs; const float* xin; const float* cs; const float* sn;
};
constexpr int LDT = 72;

DI void gemm_tile(const GemmT& g, unsigned char* smem) {
  const int tid = TIDX(), lane = tid & 63, wave = tid >> 6;
  const int wm = (wave >> 2) * 128, wn = (wave & 3) * 64;
  const int r = lane & 31, h = lane >> 5;
  u16* sA = (u16*)smem;
  u16* sB = sA + 2 * 256 * LDT;
  const int lrow = tid >> 3, lch = (tid & 7) * 8;
  const u16* Ag = g.A + (size_t)lrow * g.lda + lch;
  const u16* Bg = g.B + (size_t)lrow * g.ldb + lch;
  const bool active = wm < g.nact;
  u32x4 ra[4], rb[4];
  f32x16 acc[4][2];
#pragma unroll
  for (int i = 0; i < 4; ++i)
#pragma unroll
    for (int j = 0; j < 2; ++j)
#pragma unroll
      for (int q = 0; q < 16; ++q) acc[i][j][q] = 0.f;

#pragma unroll
  for (int i = 0; i < 4; ++i) {
    ra[i] = *(const u32x4*)(Ag + (size_t)(64 * i) * g.lda);
    rb[i] = *(const u32x4*)(Bg + (size_t)(64 * i) * g.ldb);
  }
  __syncthreads();
#pragma unroll
  for (int i = 0; i < 4; ++i) {
    *(u32x4*)(sA + (lrow + 64 * i) * LDT + lch) = ra[i];
    *(u32x4*)(sB + (lrow + 64 * i) * LDT + lch) = rb[i];
  }
#pragma unroll
  for (int i = 0; i < 4; ++i) {
    ra[i] = *(const u32x4*)(Ag + (size_t)(64 * i) * g.lda + 64);
    rb[i] = *(const u32x4*)(Bg + (size_t)(64 * i) * g.ldb + 64);
  }
  __syncthreads();
  const int KT = g.K >> 6;
  for (int kt = 0; kt < KT; ++kt) {
    if (kt + 1 < KT) {
      u16* a_d = sA + ((kt + 1) & 1) * 256 * LDT;
      u16* b_d = sB + ((kt + 1) & 1) * 256 * LDT;
#pragma unroll
      for (int i = 0; i < 4; ++i) {
        *(u32x4*)(a_d + (lrow + 64 * i) * LDT + lch) = ra[i];
        *(u32x4*)(b_d + (lrow + 64 * i) * LDT + lch) = rb[i];
      }
    }
    if (kt + 2 < KT && !(PROBE_MODE == 1 && g.probe)) {
#pragma unroll
      for (int i = 0; i < 4; ++i) {
        ra[i] = *(const u32x4*)(Ag + (size_t)(64 * i) * g.lda + (kt + 2) * 64);
        rb[i] = *(const u32x4*)(Bg + (size_t)(64 * i) * g.ldb + (kt + 2) * 64);
      }
    }
    __builtin_amdgcn_sched_barrier(0);
    if (active) {
      const u16* a_s = sA + (kt & 1) * 256 * LDT + (wm + r) * LDT + 8 * h;
      const u16* b_s = sB + (kt & 1) * 256 * LDT + (wn + r) * LDT + 8 * h;
#pragma unroll
      for (int ks = 0; ks < 4; ++ks) {
        bf16x8 af[4], bf[2];
#pragma unroll
        for (int i = 0; i < 4; ++i) af[i] = *(const bf16x8*)(a_s + 32 * i * LDT + ks * 16);
#pragma unroll
        for (int j = 0; j < 2; ++j) bf[j] = *(const bf16x8*)(b_s + 32 * j * LDT + ks * 16);
#pragma unroll
        for (int i = 0; i < 4; ++i)
#pragma unroll
          for (int j = 0; j < 2; ++j) acc[i][j] = MFMA32(af[i], bf[j], acc[i][j]);
      }
    }
    __syncthreads();
  }
  if (!active) return;
  if (PROBE_MODE && g.probe) {
    float sacc = 0.f;
#pragma unroll
    for (int i = 0; i < 4; ++i)
#pragma unroll
      for (int j = 0; j < 2; ++j)
#pragma unroll
        for (int q = 0; q < 16; ++q) sacc += acc[i][j][q];
    if (sacc == 1.2345e-30f) g.d16[0] = 0;
    return;
  }

  const int mode = g.mode;
  if (mode == M_ROPE) {
#pragma unroll
    for (int j = 0; j < 2; ++j) {
      const int tok = g.C0 + wn + 32 * j + r;
      const float sc = g.scale * (g.rs ? g.rs[tok] : 1.f);
#pragma unroll
      for (int ip = 0; ip < 2; ++ip) {
        if (wm + 64 * ip < g.aux) {
#pragma unroll
          for (int g4 = 0; g4 < 4; ++g4) {
            const int c0 = 8 * g4 + 4 * h;
            const float4 cs = *(const float4*)(g.cs + (size_t)tok * 32 + c0);
            const float4 sn = *(const float4*)(g.sn + (size_t)tok * 32 + c0);
            const float a0 = acc[2 * ip][j][4 * g4 + 0] * sc, a1 = acc[2 * ip][j][4 * g4 + 1] * sc;
            const float a2 = acc[2 * ip][j][4 * g4 + 2] * sc, a3 = acc[2 * ip][j][4 * g4 + 3] * sc;
            const float b0 = acc[2 * ip + 1][j][4 * g4 + 0] * sc, b1 = acc[2 * ip + 1][j][4 * g4 + 1] * sc;
            const float b2 = acc[2 * ip + 1][j][4 * g4 + 2] * sc, b3 = acc[2 * ip + 1][j][4 * g4 + 3] * sc;
            u32x2 o1, o2;
            o1[0] = pack_bf16(a0 * cs.x - b0 * sn.x, a1 * cs.y - b1 * sn.y);
            o1[1] = pack_bf16(a2 * cs.z - b2 * sn.z, a3 * cs.w - b3 * sn.w);
            o2[0] = pack_bf16(b0 * cs.x + a0 * sn.x, b1 * cs.y + a1 * sn.y);
            o2[1] = pack_bf16(b2 * cs.z + a2 * sn.z, b3 * cs.w + a3 * sn.w);
            u16* dp = g.d16 + (size_t)tok * g.ld + g.R0 + wm + 64 * ip + c0;
            *(u32x2*)dp = o1;
            *(u32x2*)(dp + 32) = o2;
          }
        }
      }
    }
    return;
  }
  unsigned char* wreg = smem + wave * 17408;
  if (mode == M_RESID) {
#pragma unroll
    for (int j = 0; j < 2; ++j) {
#pragma unroll
      for (int i = 0; i < 4; ++i)
#pragma unroll
        for (int g4 = 0; g4 < 4; ++g4)
          *(float4*)(wreg + r * 528 + (32 * i + 8 * g4 + 4 * h) * 4) =
              make_float4(acc[i][j][4 * g4 + 0], acc[i][j][4 * g4 + 1], acc[i][j][4 * g4 + 2], acc[i][j][4 * g4 + 3]);
#pragma unroll
      for (int it = 0; it < 16; ++it) {
        const int row = 2 * it + h;
        const float4 v = *(const float4*)(wreg + row * 528 + r * 16);
        const size_t o = (size_t)(g.C0 + wn + 32 * j + row) * 2048 + g.R0 + wm + r * 4;
        const float4 x = *(const float4*)(g.xin + o);
        *(float4*)(g.d32 + o) = make_float4(x.x + v.x, x.y + v.y, x.z + v.z, x.w + v.w);
      }
    }
    return;
  }
#pragma unroll
  for (int j = 0; j < 2; ++j) {
    const int outer = g.C0 + wn + 32 * j + r;
    const float sc = (mode == M_BF16) ? g.scale * (g.rs ? g.rs[outer] : 1.f) : 1.f;
#pragma unroll
    for (int i = 0; i < 4; ++i)
#pragma unroll
      for (int g4 = 0; g4 < 4; ++g4) {
        float v0 = acc[i][j][4 * g4 + 0], v1 = acc[i][j][4 * g4 + 1], v2 = acc[i][j][4 * g4 + 2], v3 = acc[i][j][4 * g4 + 3];
        if (mode == M_BF16) { v0 *= sc; v1 *= sc; v2 *= sc; v3 *= sc; }
        else if (mode == M_SILU) { v0 = silu_f(v0); v1 = silu_f(v1); v2 = silu_f(v2); v3 = silu_f(v3); }
        else if (g.rs) {
          const float4 r4 = *(const float4*)(g.rs + g.R0 + wm + 32 * i + 8 * g4 + 4 * h);
          v0 *= r4.x; v1 *= r4.y; v2 *= r4.z; v3 *= r4.w;
        }
        u32x2 pk; pk[0] = pack_bf16(v0, v1); pk[1] = pack_bf16(v2, v3);
        *(u32x2*)(wreg + (32 * j + r) * 272 + (32 * i + 8 * g4 + 4 * h) * 2) = pk;
      }
  }
  {
    const int inner0 = g.R0 + wm;
#pragma unroll
    for (int it = 0; it < 16; ++it) {
      const int row = 4 * it + (lane >> 4), ch = lane & 15;
      const u32x4 v = *(const u32x4*)(wreg + row * 272 + ch * 16);
      const int outer = g.C0 + wn + row;
      size_t o;
      if (mode == M_TRANS) o = ((size_t)(inner0 >> 13) * g.aux + outer) * 8192 + (inner0 & 8191);
      else o = (size_t)outer * g.ld + inner0;
      *(u32x4*)(g.d16 + o + ch * 8) = v;
    }
  }
}

using f32x4v = __attribute__((ext_vector_type(4))) float;
DI int lds_byte8(int r, int c) {
  const int st = (r >> 4) * 2 + (c >> 5), rr = r & 15, cc = c & 31, ob = rr * 64 + cc * 2;
  return st * 1024 + (ob ^ (((ob >> 9) & 1) << 5));
}
DI void stage_rc8(int b, int& R, int& C) {
  const int st = b / 1024, sb = b % 1024, swz = sb ^ (((sb >> 9) & 1) << 5);
  R = (st >> 1) * 16 + swz / 64; C = (st & 1) * 32 + (swz % 64) / 2;
}
template <bool KR = false>
DI void gemm_tile8(const GemmT& g, unsigned char* smem) {
  constexpr int BK = 64, HALF = 128, HT = HALF * BK;
  u16* shm = (u16*)smem;
  const u16* A = g.A; const u16* Bt = g.B; const int K = g.K;
  const int tid = TIDX();
  const int nact = g.nact;
  #define SA8(b,h) (shm+((b)*2+(h))*HT)
  #define SB8(b,h) (shm+(4+(b)*2+(h))*HT)
  unsigned soff0, soff1;
  { int r_, c_; stage_rc8(tid * 16, r_, c_); soff0 = (unsigned)(r_ * K + c_); stage_rc8(tid * 16 + 8192, r_, c_); soff1 = (unsigned)(r_ * K + c_); }
  #define STAGE8(P,BASE,br,kt) do{ const u16* _gb = (BASE) + ((long)(br)*K+(long)(kt)*BK); \
      __builtin_amdgcn_global_load_lds((const unsigned*)(_gb + soff0), (unsigned*)((char*)(P)+tid*16),16,0,0); \
      __builtin_amdgcn_global_load_lds((const unsigned*)(_gb + soff1), (unsigned*)((char*)(P)+tid*16+8192),16,0,0); }while(0)
  #define LDA8(dst,b,h) _Pragma("unroll") for(int m=0;m<4;++m) _Pragma("unroll") for(int k=0;k<2;++k) \
    dst[m][k]=*reinterpret_cast<const bf16x8*>((const char*)SA8(b,h)+lds_byte8(wr*64+m*16+fr,k*32+fq*8))
  #define LDB8(dst,b,h) _Pragma("unroll") for(int n=0;n<2;++n) _Pragma("unroll") for(int k=0;k<2;++k) \
    dst[n][k]=*reinterpret_cast<const bf16x8*>((const char*)SB8(b,h)+lds_byte8(wc*32+n*16+fr,k*32+fq*8))
  #define MMA8(ai,bj,At_,Bt_) do{__builtin_amdgcn_s_setprio(1); \
    _Pragma("unroll") for(int m=0;m<4;++m) _Pragma("unroll") for(int n=0;n<2;++n) _Pragma("unroll") for(int k=0;k<2;++k) \
      acc[ai][bj][m][n]=__builtin_amdgcn_mfma_f32_16x16x32_bf16(At_[m][k],Bt_[n][k],acc[ai][bj][m][n],0,0,0); \
    __builtin_amdgcn_s_setprio(0);}while(0)
  #define MMA8C(ai,bj,At_,Bt_) do{ if (!KR || ((ai)*128 + wr*64 < nact)) MMA8(ai,bj,At_,Bt_); }while(0)
  #define WAIT_V8(n) asm volatile("s_waitcnt vmcnt(" #n ")":::"memory")
  #define WAIT_L8(n) asm volatile("s_waitcnt lgkmcnt(" #n ")":::"memory")
  #define BAR8 __builtin_amdgcn_s_barrier()
  #define SCHED8 __builtin_amdgcn_sched_barrier(0)
  f32x4v acc[2][2][4][2];
#pragma unroll
  for (int a = 0; a < 2; ++a)
#pragma unroll
    for (int b = 0; b < 2; ++b)
#pragma unroll
      for (int m = 0; m < 4; ++m)
#pragma unroll
        for (int n = 0; n < 2; ++n) acc[a][b][m][n] = f32x4v{0.f, 0.f, 0.f, 0.f};
  {
  const int wid = tid >> 6, lane = tid & 63, wr = wid >> 2, wc = wid & 3, fr = lane & 15, fq = lane >> 4;
  bf16x8 At[4][2], B0[2][2], B1[2][2];
  const int nt = K / BK;
  asm volatile("s_waitcnt lgkmcnt(0)" ::: "memory");
  __builtin_amdgcn_s_barrier();
  STAGE8(SB8(0,0),Bt,0,0); STAGE8(SA8(0,0),A,0,0);
  STAGE8(SB8(0,1),Bt,HALF,0); STAGE8(SA8(0,1),A,HALF,0);
  if (wr == 1) BAR8;
  WAIT_V8(4); BAR8;
  STAGE8(SB8(1,0),Bt,0,1); STAGE8(SA8(1,0),A,0,1); STAGE8(SB8(1,1),Bt,HALF,1);
  WAIT_V8(6); BAR8;
  for (int t = 0; t < nt - 2; t += 2) {
    LDB8(B0,0,0); SCHED8; LDA8(At,0,0); STAGE8(SA8(1,1),A,HALF,t+1);
    WAIT_L8(8); BAR8; WAIT_L8(0); MMA8C(0,0,At,B0); BAR8; SCHED8;
    LDB8(B1,0,1); STAGE8(SB8(0,0),Bt,0,t+2);
    BAR8; WAIT_L8(0); MMA8C(0,1,At,B1); BAR8;
    LDA8(At,0,1); STAGE8(SA8(0,0),A,0,t+2);
    BAR8; WAIT_L8(0); MMA8C(1,0,At,B0); BAR8; SCHED8;
    STAGE8(SB8(0,1),Bt,HALF,t+2);
    WAIT_V8(6); BAR8; MMA8C(1,1,At,B1); BAR8;
    LDB8(B0,1,0); SCHED8; LDA8(At,1,0); STAGE8(SA8(0,1),A,HALF,t+2);
    WAIT_L8(8); BAR8; WAIT_L8(0); MMA8C(0,0,At,B0); BAR8; SCHED8;
    LDB8(B1,1,1); STAGE8(SB8(1,0),Bt,0,t+3);
    BAR8; WAIT_L8(0); MMA8C(0,1,At,B1); BAR8;
    LDA8(At,1,1); STAGE8(SA8(1,0),A,0,t+3);
    BAR8; WAIT_L8(0); MMA8C(1,0,At,B0); BAR8; SCHED8;
    STAGE8(SB8(1,1),Bt,HALF,t+3);
    WAIT_V8(6); BAR8; MMA8C(1,1,At,B1); BAR8;
  }
  { LDB8(B0,0,0); LDA8(At,0,0); STAGE8(SA8(1,1),A,HALF,nt-1);
    BAR8; WAIT_L8(0); MMA8C(0,0,At,B0); BAR8;
    LDB8(B1,0,1); BAR8; WAIT_L8(0); MMA8C(0,1,At,B1); BAR8;
    LDA8(At,0,1); WAIT_V8(4); BAR8; WAIT_L8(0); MMA8C(1,0,At,B0); MMA8C(1,1,At,B1); BAR8; }
  { LDB8(B0,1,0); LDA8(At,1,0); WAIT_V8(2); BAR8; WAIT_L8(0); MMA8C(0,0,At,B0); BAR8;
    LDB8(B1,1,1); WAIT_V8(0); BAR8; WAIT_L8(0); MMA8C(0,1,At,B1); BAR8;
    LDA8(At,1,1); BAR8; WAIT_L8(0); MMA8C(1,0,At,B0); MMA8C(1,1,At,B1); BAR8; }
  if (wr == 0) BAR8;
  }

  const int mode = g.mode;
  unsigned char* wreg;
  int lane, wr, wc, fr, fq;
  { const int t2 = TIDX(); const int w2 = t2 >> 6; lane = t2 & 63; wr = w2 >> 2; wc = w2 & 3; fr = lane & 15; fq = lane >> 4; wreg = smem + w2 * 17408; }
  if (mode == M_RESID) {
#pragma unroll
    for (int bj = 0; bj < 2; ++bj) {
#pragma unroll
      for (int ai = 0; ai < 2; ++ai)
#pragma unroll
        for (int m = 0; m < 4; ++m)
#pragma unroll
          for (int n = 0; n < 2; ++n)
            *(f32x4v*)(wreg + (n * 16 + fr) * 528 + (ai * 64 + m * 16 + fq * 4) * 4) = acc[ai][bj][m][n];
#pragma unroll
      for (int it = 0; it < 16; ++it) {
        const int row = 2 * it + (lane >> 5), c4 = lane & 31;
        const float4 v = *(const float4*)(wreg + row * 528 + c4 * 16);
        const int ai = c4 >> 4, iin = (c4 & 15) * 4;
        const size_t o = (size_t)(g.C0 + bj * 128 + wc * 32 + row) * 2048 + g.R0 + ai * 128 + wr * 64 + iin;
        const float4 x = *(const float4*)(g.xin + o);
        *(float4*)(g.d32 + o) = make_float4(x.x + v.x, x.y + v.y, x.z + v.z, x.w + v.w);
      }
    }
    return;
  }
  if (mode == M_ROPE) {
#pragma unroll
    for (int bj = 0; bj < 2; ++bj)
#pragma unroll
      for (int n = 0; n < 2; ++n) {
        const int tok = g.C0 + bj * 128 + wc * 32 + n * 16 + fr;
        const float sc = g.scale * (g.rs ? g.rs[tok] : 1.f);
#pragma unroll
        for (int ai = 0; ai < 2; ++ai) {
          if (ai * 128 + wr * 64 < g.aux) {
#pragma unroll
            for (int m = 0; m < 2; ++m) {
              const int c0 = m * 16 + fq * 4;
              const float4 cs = *(const float4*)(g.cs + (size_t)tok * 32 + c0);
              const float4 sn = *(const float4*)(g.sn + (size_t)tok * 32 + c0);
              const f32x4v a = acc[ai][bj][m][n] * sc, b = acc[ai][bj][m + 2][n] * sc;
              u32x2 o1, o2;
              o1[0] = pack_bf16(a[0] * cs.x - b[0] * sn.x, a[1] * cs.y - b[1] * sn.y);
              o1[1] = pack_bf16(a[2] * cs.z - b[2] * sn.z, a[3] * cs.w - b[3] * sn.w);
              o2[0] = pack_bf16(b[0] * cs.x + a[0] * sn.x, b[1] * cs.y + a[1] * sn.y);
              o2[1] = pack_bf16(b[2] * cs.z + a[2] * sn.z, b[3] * cs.w + a[3] * sn.w);
              u16* dp = g.d16 + (size_t)tok * g.ld + g.R0 + ai * 128 + wr * 64 + c0;
              *(u32x2*)dp = o1;
              *(u32x2*)(dp + 32) = o2;
            }
          }
        }
      }
    return;
  }
  {
    const int fqp = g.perm ? (((fq & 1) << 1) | (fq >> 1)) : fq;
    unsigned char* wb = wreg + fr * 272 + fqp * 8;
    if (mode == M_BF16) {
#pragma unroll
      for (int bj = 0; bj < 2; ++bj)
#pragma unroll
        for (int n = 0; n < 2; ++n) {
          const int outer = g.C0 + bj * 128 + wc * 32 + n * 16 + fr;
          const float sc = g.scale * (g.rs ? g.rs[outer] : 1.f);
#pragma unroll
          for (int ai = 0; ai < 2; ++ai)
#pragma unroll
            for (int m = 0; m < 4; ++m) {
              const f32x4v v = acc[ai][bj][m][n] * sc;
              u32x2 pk; pk[0] = pack_bf16(v[0], v[1]); pk[1] = pack_bf16(v[2], v[3]);
              *(u32x2*)(wb + (bj * 32 + n * 16) * 272 + (ai * 64 + m * 16) * 2) = pk;
            }
        }
    } else if (mode == M_SILU) {
#pragma unroll
      for (int bj = 0; bj < 2; ++bj)
#pragma unroll
        for (int n = 0; n < 2; ++n)
#pragma unroll
          for (int ai = 0; ai < 2; ++ai)
#pragma unroll
            for (int m = 0; m < 4; ++m) {
              const f32x4v v = acc[ai][bj][m][n];
              u32x2 pk; pk[0] = pack_bf16(silu_f(v[0]), silu_f(v[1])); pk[1] = pack_bf16(silu_f(v[2]), silu_f(v[3]));
              *(u32x2*)(wb + (bj * 32 + n * 16) * 272 + (ai * 64 + m * 16) * 2) = pk;
            }
    } else {
      const float* rsp = g.rs ? g.rs + g.R0 + wr * 64 + fq * 4 : nullptr;
#pragma unroll
      for (int ai = 0; ai < 2; ++ai)
#pragma unroll
        for (int m = 0; m < 4; ++m) {
          float4 r4 = make_float4(1.f, 1.f, 1.f, 1.f);
          if (rsp) r4 = *(const float4*)(rsp + ai * 128 + m * 16);
#pragma unroll
          for (int bj = 0; bj < 2; ++bj)
#pragma unroll
            for (int n = 0; n < 2; ++n) {
              const f32x4v v = acc[ai][bj][m][n];
              u32x2 pk; pk[0] = pack_bf16(v[0] * r4.x, v[1] * r4.y); pk[1] = pack_bf16(v[2] * r4.z, v[3] * r4.w);
              *(u32x2*)(wb + (bj * 32 + n * 16) * 272 + (ai * 64 + m * 16) * 2) = pk;
            }
        }
    }
  }
  {
    const int ch = lane & 15, rsub = lane >> 4, ai = ch >> 3;
    const int outer0 = g.C0 + wc * 32 + rsub;
    const int inner0 = g.R0 + ai * 128 + wr * 64 + (ch & 7) * 8;
    size_t obase, ostride;
    if (mode == M_TRANS) { obase = ((size_t)(inner0 >> 13) * g.aux + outer0) * 8192 + (inner0 & 8191); ostride = 8192; }
    else { obase = (size_t)outer0 * g.ld + inner0; ostride = (size_t)g.ld; }
    const unsigned char* rb = wreg + rsub * 272 + ch * 16;
    u16* dp = g.d16 + obase;
#pragma unroll
    for (int it = 0; it < 16; ++it) {
      const u32x4 v = *(const u32x4*)(rb + it * 4 * 272);
      *(u32x4*)(dp + (size_t)((it >> 3) * 128 + (it & 7) * 4) * ostride) = v;
    }
  }
}

template <int DK, bool SB, int LDQN, int LDQR, int LDKN, int LDKR, int LDG>
DI void attn_item(const u16* __restrict__ Qn, const u16* __restrict__ Qr,
                  const u16* __restrict__ Kn, const u16* __restrict__ Kr,
                  const u16* __restrict__ Vt, const u16* __restrict__ Gt,
                  u16* __restrict__ Y, int q0, unsigned char* smem, int probe = 0) {
  constexpr int KS = DK / 16;
  constexpr int KROW_B = DK * 2;
  constexpr int KCH = DK / 8;
  constexpr int K_B = 64 * KROW_B;
  constexpr int STAGE_B = K_B + 128 * 128;
  constexpr int NKI = K_B / 8192;
  constexpr int G = NKI + 2;
  volatile __attribute__((address_space(3))) int* sflag = (volatile __attribute__((address_space(3))) int*)(smem + 3 * STAGE_B);
  const int tid = TIDX(), lane = tid & 63, wave = tid >> 6;
  const int r = lane & 31, h = lane >> 5;
  const int qrow = q0 + 32 * wave + r;
  const int qmin = q0 + 32 * wave, qmax = qmin + 31;

  bf16x8 bq[KS];
  {
    const u16* qp = Qn + (unsigned)(qrow * LDQN + 8 * h);
#pragma unroll
    for (int ks = 0; ks < 8; ++ks) bq[ks] = *(const bf16x8*)(qp + 16 * ks);
    if constexpr (!SB) {
      const u16* qp2 = Qr + (unsigned)(qrow * LDQR + 8 * h);
#pragma unroll
      for (int ks = 8; ks < KS; ++ks) bq[ks] = *(const bf16x8*)(qp2 + 16 * (ks - 8));
    }
  }
  f32x16 O[4];
#pragma unroll
  for (int d = 0; d < 4; ++d)
#pragma unroll
    for (int q = 0; q < 16; ++q) O[d][q] = 0.f;
  float m_run = -INFINITY, l_run = 0.f, R = 0.f;
  const int nt = (q0 >> 6) + 4;

  const u16* kbase[NKI]; unsigned isr = 0u; unsigned voff0;
#pragma unroll
  for (int j = 0; j < NKI; ++j) {
    const int L = 64 * (wave + 8 * j) + lane, row = L / KCH, p = L - row * KCH;
    const int c = SB ? (p ^ (row & 15)) : ((p & ~7) | ((p & 7) ^ ((row >> 1) & 7)));
    if (SB || c < 16) { kbase[j] = Kn + (unsigned)(row * LDKN + c * 8); }
    else { kbase[j] = Kr + (unsigned)(row * LDKR + (c - 16) * 8); isr |= 1u << j; }
  }
  {
    const int L = 64 * wave + lane, row = L >> 3, p = L & 7;
    voff0 = (unsigned)(row * 8192 + (p ^ ((row >> 1) & 7)) * 8);
  }
  auto issue_tile = [&](int kt, int st) {
    unsigned char* sKb = smem + st * STAGE_B;
#pragma unroll
    for (int j = 0; j < NKI; ++j) {
      const unsigned kstr = ((isr >> j) & 1u) ? 64u * LDKR : 64u * LDKN;
      __builtin_amdgcn_global_load_lds((const unsigned*)(kbase[j] + (size_t)kt * kstr),
                                       (unsigned*)(sKb + (wave + 8 * j) * 1024), 16, 0, 0);
    }
    const u16* vb_ = Vt + kt * 64;
#pragma unroll
    for (int j = 0; j < 2; ++j)
      __builtin_amdgcn_global_load_lds((const unsigned*)(vb_ + (size_t)j * 64 * 8192 + voff0),
                                       (unsigned*)(sKb + K_B + (wave + 8 * j) * 1024), 16, 0, 0);
  };
  const int s3 = (r >> 1) & 7, s4 = r & 15;

  asm volatile("s_waitcnt vmcnt(0)" ::: "memory");
  __syncthreads();
  issue_tile(SB ? nt - 1 : 0, 0);
  issue_tile(SB ? nt - 2 : 1, 1);
  asm volatile("s_waitcnt vmcnt(%0)" :: "n"(G) : "memory");
  asm volatile("s_waitcnt lgkmcnt(0)" ::: "memory");
  __builtin_amdgcn_s_barrier();
  auto tile_body = [&](int it, auto st_c) -> bool {
    constexpr int ST = decltype(st_c)::value;
    const int kt = SB ? (nt - 1 - it) : it;
    if (it + 2 < nt && !(PROBE_MODE == 3 && probe)) issue_tile(SB ? (nt - 3 - it) : (it + 2), (ST + 2) % 3);
    __builtin_amdgcn_sched_barrier(0);
    const unsigned char* sK = smem + ST * STAGE_B;
    const unsigned char* sV = sK + K_B;
    auto kchunk = [&](int ks) -> int {
      const int c = 2 * ks + h;
      return (SB ? (c ^ s4) : ((c & ~7) | ((c & 7) ^ s3))) * 16;
    };
    const int kbA = SB ? 1 : 0, kbB = SB ? 0 : 1;
    const int keyA = kt * 64 + 32 * kbA, keyB = kt * 64 + 32 * kbB;
    const bool skipA = SB ? (keyA >= qmax) : (keyA > qmax);
    const bool skipB = SB ? (keyB >= qmax) : (keyB > qmax);
    f32x16 SA_, SB_;
    {
      bf16x8 kf[KS];
      if (!skipA) {
        const unsigned char* kp = sK + (32 * kbA + r) * KROW_B;
#pragma unroll
        for (int ks = 0; ks < KS; ++ks) kf[ks] = *(const bf16x8*)(kp + kchunk(ks));
#pragma unroll
        for (int q = 0; q < 16; ++q) SA_[q] = 0.f;
        __builtin_amdgcn_sched_barrier(0);
#pragma unroll
        for (int ks = 0; ks < KS; ++ks) SA_ = MFMA32(kf[ks], bq[ks], SA_);
        __builtin_amdgcn_sched_barrier(0);
      }
      if (!skipB) {
        const unsigned char* kp = sK + (32 * kbB + r) * KROW_B;
#pragma unroll
        for (int ks = 0; ks < KS; ++ks) kf[ks] = *(const bf16x8*)(kp + kchunk(ks));
#pragma unroll
        for (int q = 0; q < 16; ++q) SB_[q] = 0.f;
        __builtin_amdgcn_sched_barrier(0);
#pragma unroll
        for (int ks = 0; ks < KS; ++ks) SB_ = MFMA32(kf[ks], bq[ks], SB_);
        __builtin_amdgcn_sched_barrier(0);
      }
    }
    auto math_pv = [&](f32x16& Sx, const int kb, const int key0) {
      bf16x8 vf[8];
#pragma unroll
      for (int d = 0; d < 4; ++d) vf[d] = *(const bf16x8*)(sV + (32 * d + r) * 128 + (((4 * kb + h) ^ s3) * 16));
      __builtin_amdgcn_sched_barrier(0);
      if constexpr (!SB) {
       if (!(PROBE_MODE == 4 && probe)) {
        if (key0 + 31 > qmin) {
#pragma unroll
          for (int q = 0; q < 16; ++q)
            if (key0 + crow(q, h) > qrow) Sx[q] = -INFINITY;
        }
        float mloc = Sx[0];
#pragma unroll
        for (int q = 1; q < 16; ++q) mloc = fmaxf(mloc, Sx[q]);
        mloc = xh_max(mloc);
        float mnew = m_run, alpha = 1.f;
        const bool need = __builtin_amdgcn_ballot_w64(mloc > m_run + 8.f) != 0ull;
        if (need) {
          mnew = fmaxf(m_run, mloc);
          alpha = __builtin_amdgcn_exp2f(m_run - mnew);
          m_run = mnew;
        }
        typedef float f32x2v __attribute__((ext_vector_type(2)));
        const f32x2v mm = {mnew, mnew};
        f32x2v ls2 = {0.f, 0.f};
#pragma unroll
        for (int q = 0; q < 8; ++q) {
          f32x2v t = {Sx[2 * q], Sx[2 * q + 1]};
          t = t - mm;
          t[0] = __builtin_amdgcn_exp2f(t[0]);
          t[1] = __builtin_amdgcn_exp2f(t[1]);
          Sx[2 * q] = t[0]; Sx[2 * q + 1] = t[1];
          ls2 = ls2 + t;
        }
        const float lsum = ls2[0] + ls2[1];
        l_run = l_run * alpha + lsum;
        if (need) {
#pragma unroll
          for (int d = 0; d < 4; ++d)
#pragma unroll
            for (int q = 0; q < 16; ++q) O[d][q] *= alpha;
        }
       }
      } else {
        f32x16 Lx;
        float gs[4], ps[4];
        if (key0 + 31 < qmin) {
#pragma unroll
          for (int q = 0; q < 16; ++q) {
            const float z0 = Sx[q];
            Lx[q] = -(fmaxf(z0, 0.f) + __builtin_amdgcn_logf(1.f + __builtin_amdgcn_exp2f(-fabsf(z0))));
          }
#pragma unroll
          for (int gq = 0; gq < 4; ++gq) {
            gs[gq] = (Lx[4 * gq] + Lx[4 * gq + 1]) + (Lx[4 * gq + 2] + Lx[4 * gq + 3]);
            ps[gq] = xh_partner(gs[gq], h);
          }
          float run = 0.f;
#pragma unroll
          for (int gq = 3; gq >= 0; --gq) {
            const float own = R + run + (h == 0 ? ps[gq] : 0.f);
            run += gs[gq] + ps[gq];
            const float a3 = own, a2 = a3 + Lx[4 * gq + 3], a1 = a2 + Lx[4 * gq + 2], a0 = a1 + Lx[4 * gq + 1];
            Sx[4 * gq + 0] = __builtin_amdgcn_exp2f(Sx[4 * gq + 0] + Lx[4 * gq + 0] + a0);
            Sx[4 * gq + 1] = __builtin_amdgcn_exp2f(Sx[4 * gq + 1] + Lx[4 * gq + 1] + a1);
            Sx[4 * gq + 2] = __builtin_amdgcn_exp2f(Sx[4 * gq + 2] + Lx[4 * gq + 2] + a2);
            Sx[4 * gq + 3] = __builtin_amdgcn_exp2f(Sx[4 * gq + 3] + Lx[4 * gq + 3] + a3);
          }
          R += run;
        } else {
#pragma unroll
          for (int q = 0; q < 16; ++q) {
            const float z0 = Sx[q];
            const float sp0 = fmaxf(z0, 0.f) + __builtin_amdgcn_logf(1.f + __builtin_amdgcn_exp2f(-fabsf(z0)));
            Lx[q] = (key0 + crow(q, h) < qrow) ? -sp0 : 0.f;
          }
#pragma unroll
          for (int gq = 0; gq < 4; ++gq) {
            gs[gq] = (Lx[4 * gq] + Lx[4 * gq + 1]) + (Lx[4 * gq + 2] + Lx[4 * gq + 3]);
            ps[gq] = xh_partner(gs[gq], h);
          }
          float run = 0.f;
#pragma unroll
          for (int gq = 3; gq >= 0; --gq) {
            const float own = R + run + (h == 0 ? ps[gq] : 0.f);
            run += gs[gq] + ps[gq];
            const int key = key0 + 8 * gq + 4 * h;
            const float a3 = own, a2 = a3 + Lx[4 * gq + 3], a1 = a2 + Lx[4 * gq + 2], a0 = a1 + Lx[4 * gq + 1];
            const float e0 = __builtin_amdgcn_exp2f(Sx[4 * gq + 0] + Lx[4 * gq + 0] + a0);
            const float e1 = __builtin_amdgcn_exp2f(Sx[4 * gq + 1] + Lx[4 * gq + 1] + a1);
            const float e2 = __builtin_amdgcn_exp2f(Sx[4 * gq + 2] + Lx[4 * gq + 2] + a2);
            const float e3 = __builtin_amdgcn_exp2f(Sx[4 * gq + 3] + Lx[4 * gq + 3] + a3);
            Sx[4 * gq + 0] = (key + 0 < qrow) ? e0 : 0.f;
            Sx[4 * gq + 1] = (key + 1 < qrow) ? e1 : 0.f;
            Sx[4 * gq + 2] = (key + 2 < qrow) ? e2 : 0.f;
            Sx[4 * gq + 3] = (key + 3 < qrow) ? e3 : 0.f;
          }
          R += run;
        }
      }
      const bf16x8 pf0 = pack8(Sx, 0), pf1 = pack8(Sx, 1);
      __builtin_amdgcn_sched_barrier(0);
#pragma unroll
      for (int d = 0; d < 4; ++d) vf[4 + d] = *(const bf16x8*)(sV + (32 * d + r) * 128 + (((4 * kb + 2 + h) ^ s3) * 16));
#pragma unroll
      for (int d = 0; d < 4; ++d) O[d] = MFMA32(vf[d], pf0, O[d]);
      __builtin_amdgcn_sched_barrier(0);
#pragma unroll
      for (int d = 0; d < 4; ++d) O[d] = MFMA32(vf[4 + d], pf1, O[d]);
      __builtin_amdgcn_sched_barrier(0);
    };
    if (!skipA) math_pv(SA_, kbA, keyA);
    if (!skipB) math_pv(SB_, kbB, keyB);
    if constexpr (SB) {
      const bool done = (__builtin_amdgcn_ballot_w64(!(R < -150.1f)) == 0ull);
      if (lane == 0) sflag[(it & 1) * 8 + wave] = done ? 1 : 0;
    }
    if (it + 2 < nt) asm volatile("s_waitcnt vmcnt(%0)" :: "n"(G) : "memory");
    else asm volatile("s_waitcnt vmcnt(0)" ::: "memory");
    asm volatile("s_waitcnt lgkmcnt(0)" ::: "memory");
    __builtin_amdgcn_s_barrier();
    if constexpr (SB) {
      const volatile __attribute__((address_space(3))) int* f = sflag + (it & 1) * 8;
      if (f[0] & f[1] & f[2] & f[3] & f[4] & f[5] & f[6] & f[7]) return true;
    }
    return false;
  };
  for (int it = 0; it < nt; it += 3) {
    if (tile_body(it, std::integral_constant<int, 0>{})) break;
    if (it + 1 >= nt) break;
    if (tile_body(it + 1, std::integral_constant<int, 1>{})) break;
    if (it + 2 >= nt) break;
    if (tile_body(it + 2, std::integral_constant<int, 2>{})) break;
  }

  if (PROBE_MODE >= 3 && probe) {
    float sacc = l_run;
#pragma unroll
    for (int d = 0; d < 4; ++d)
#pragma unroll
      for (int q = 0; q < 16; ++q) sacc += O[d][q];
    if (sacc == 1.2345e-30f) Y[0] = 0;
    return;
  }
  float inv = 1.f;
  if constexpr (!SB) {
    const float lt = xh_sum(l_run);
    inv = 1.f / lt;
  }
  const u16* gp = Gt + (unsigned)(qrow * LDG + 4 * h);
  u16* yp = Y + (unsigned)(qrow * 2048 + 8 * h);
#pragma unroll
  for (int d = 0; d < 4; ++d)
#pragma unroll
    for (int pq = 0; pq < 2; ++pq) {
      u32x2 oa, ob;
      {
        const int gq = 2 * pq, dv = 32 * d + 8 * gq;
        const u32x2 gt = *(const u32x2*)(gp + dv);
        oa[0] = pack_bf16(O[d][4 * gq + 0] * inv * bf_lo(gt[0]), O[d][4 * gq + 1] * inv * bf_hi(gt[0]));
        oa[1] = pack_bf16(O[d][4 * gq + 2] * inv * bf_lo(gt[1]), O[d][4 * gq + 3] * inv * bf_hi(gt[1]));
      }
      {
        const int gq = 2 * pq + 1, dv = 32 * d + 8 * gq;
        const u32x2 gt = *(const u32x2*)(gp + dv);
        ob[0] = pack_bf16(O[d][4 * gq + 0] * inv * bf_lo(gt[0]), O[d][4 * gq + 1] * inv * bf_hi(gt[0]));
        ob[1] = pack_bf16(O[d][4 * gq + 2] * inv * bf_lo(gt[1]), O[d][4 * gq + 3] * inv * bf_hi(gt[1]));
      }
      const auto r0 = __builtin_amdgcn_permlane32_swap(oa[0], ob[0], false, false);
      const auto r1 = __builtin_amdgcn_permlane32_swap(oa[1], ob[1], false, false);
      u32x4 st; st[0] = r0[0]; st[1] = r1[0]; st[2] = r0[1]; st[3] = r1[1];
      *(u32x4*)(yp + 32 * d + 16 * pq) = st;
    }
}

DI void gla_g1(const Params& p, int li, int unit, unsigned char* smem) {
  const int c = unit & 127, bh = unit >> 7, b = bh >> 2, hh = bh & 3;
  const size_t m0 = (size_t)b * S_ + c * 64;
  float* lf = (float*)smem;
  u16* klT = (u16*)(smem + 32768);
  const float* GA = (const float*)(p.ws + E_GA);
  u16* GQ = (u16*)(p.ws + E_GQ);
  u16* GK = (u16*)(p.ws + E_GK);
  const u16* GVT = (const u16*)(p.ws + E_GVT);
  float* EBL = (float*)(p.ws + E_EBL);
  float* SC = (float*)(p.ws + E_SC);
  const float* au_p = p.alpha_up + (size_t)li * 16 * 512;
  const float* bias_p = p.alpha_bias + (size_t)li * 512;
  const int tid = TIDX(), lane = tid & 63, wave = tid >> 6;
  const int r = lane & 31, h = lane >> 5;
  {
    const int d = tid & 127, th = tid >> 7;
    float au[16];
#pragma unroll
    for (int q = 0; q < 16; ++q) au[q] = au_p[q * 512 + hh * 128 + d];
    const float bs = bias_p[hh * 128 + d];
    for (int tt = 0; tt < 16; ++tt) {
      const int t = th * 16 + tt;
      const float4* ga = (const float4*)(GA + (m0 + t) * 16);
      float s = bs;
#pragma unroll
      for (int q = 0; q < 4; ++q) {
        const float4 g4 = ga[q];
        s += g4.x * au[4 * q] + g4.y * au[4 * q + 1] + g4.z * au[4 * q + 2] + g4.w * au[4 * q + 3];
      }
      const float sp = fmaxf(-s, 0.f) + __logf(1.f + __expf(-fabsf(s)));
      lf[t * 128 + d] = -sp * (1.f / 16.f);
    }
  }
  __syncthreads();
  {
    const int d = tid & 127, sg = tid >> 7;
    float run = 0.f;
#pragma unroll
    for (int t = 0; t < 16; ++t) { run += lf[(sg * 16 + t) * 128 + d]; lf[(sg * 16 + t) * 128 + d] = run; }
    __syncthreads();
    float off = 0.f;
    if (sg > 0) off += lf[15 * 128 + d];
    if (sg > 1) off += lf[31 * 128 + d];
    if (sg > 2) off += lf[47 * 128 + d];
    __syncthreads();
    if (sg > 0) {
#pragma unroll
      for (int t = 0; t < 16; ++t) lf[(sg * 16 + t) * 128 + d] += off;
    }
  }
  __syncthreads();
#pragma unroll 1
  for (int i = 0; i < 2; ++i) {
    const int idx = tid + 512 * i;
    const int t = idx >> 4, d0 = (idx & 15) * 8;
    u16* qp = GQ + (m0 + t) * 512 + hh * 128 + d0;
    u16* kp = GK + (m0 + t) * 512 + hh * 128 + d0;
    const u32x4 qv = *(const u32x4*)qp;
    const u32x4 kv = *(const u32x4*)kp;
    u32x4 qo, ko;
#pragma unroll
    for (int jj = 0; jj < 4; ++jj) {
      const float bb0 = lf[t * 128 + d0 + 2 * jj], bb1 = lf[t * 128 + d0 + 2 * jj + 1];
      const float bl0 = lf[63 * 128 + d0 + 2 * jj], bl1 = lf[63 * 128 + d0 + 2 * jj + 1];
      const float q0 = bf_lo(qv[jj]), q1 = bf_hi(qv[jj]);
      const float k0 = bf_lo(kv[jj]), k1 = bf_hi(kv[jj]);
      qo[jj] = pack_bf16(q0 * 0.08838834764831845f * __expf(bb0), q1 * 0.08838834764831845f * __expf(bb1));
      ko[jj] = pack_bf16(k0 * __expf(-bb0), k1 * __expf(-bb1));
      klT[(d0 + 2 * jj) * 72 + t] = to_bf16(k0 * __expf(bl0 - bb0));
      klT[(d0 + 2 * jj + 1) * 72 + t] = to_bf16(k1 * __expf(bl1 - bb1));
    }
    *(u32x4*)qp = qo;
    *(u32x4*)kp = ko;
  }
  if (tid < 128) EBL[(size_t)unit * 128 + tid] = __expf(lf[63 * 128 + tid]);
  __syncthreads();
  {
    f32x16 acc[4];
#pragma unroll
    for (int j = 0; j < 4; ++j)
#pragma unroll
      for (int q = 0; q < 16; ++q) acc[j][q] = 0.f;
    const u16* vp = GVT + ((size_t)(bh * 256 + 32 * wave + r)) * 8192 + c * 64 + 8 * h;
#pragma unroll
    for (int ks = 0; ks < 4; ++ks) {
      const bf16x8 bv = *(const bf16x8*)(vp + 16 * ks);
#pragma unroll
      for (int db = 0; db < 4; ++db) {
        const bf16x8 ak = *(const bf16x8*)(klT + (32 * db + r) * 72 + 16 * ks + 8 * h);
        acc[db] = MFMA32(ak, bv, acc[db]);
      }
    }
    u16* SC16 = (u16*)SC;
    u16* sp = SC16 + ((size_t)unit * 256 + 32 * wave + r) * 128 + 4 * h;
#pragma unroll
    for (int db = 0; db < 4; ++db)
#pragma unroll
      for (int g4 = 0; g4 < 4; ++g4) {
        u32x2 pk;
        pk[0] = pack_bf16(acc[db][4 * g4 + 0], acc[db][4 * g4 + 1]);
        pk[1] = pack_bf16(acc[db][4 * g4 + 2], acc[db][4 * g4 + 3]);
        *(u32x2*)(sp + 32 * db + 8 * g4) = pk;
      }
  }
  __syncthreads();
}

DI void gla_scan(const Params& p) {
  u16* SC16 = (u16*)(p.ws + E_SC);
  const float* EBL = (const float*)(p.ws + E_EBL);
  for (int cp = blockIdx.x * 512 + TIDX(); cp < 131072; cp += gridDim.x * 512) {
    const int bh = cp >> 14, rem = cp & 16383, e = rem >> 6, d2 = (rem & 63) * 2;
    u16* base = SC16 + ((size_t)(bh * 128) * 256 + e) * 128 + d2;
    const float* eb = EBL + (size_t)(bh * 128) * 128 + d2;
    float sx = 0.f, sy = 0.f;
#pragma unroll 8
    for (int c = 0; c < 128; ++c) {
      const unsigned sv = *(const unsigned*)(base + (size_t)c * 32768);
      const float2 f = *(const float2*)(eb + c * 128);
      *(unsigned*)(base + (size_t)c * 32768) = pack_bf16(sx, sy);
      sx = f.x * sx + bf_lo(sv);
      sy = f.y * sy + bf_hi(sv);
    }
  }
}

DI void gla_g3(const Params& p, int li, int unit, unsigned char* smem) {
  const int c = unit & 127, bh = unit >> 7, b = bh >> 2, hh = bh & 3;
  const size_t m0 = (size_t)b * S_ + c * 64;
  float* red = (float*)smem;
  const u16* GQ = (const u16*)(p.ws + E_GQ);
  const u16* GK = (const u16*)(p.ws + E_GK);
  const u16* GVT = (const u16*)(p.ws + E_GVT);
  const u16* GG = (const u16*)(p.ws + E_GG);
  const float* SC = (const float*)(p.ws + E_SC);
  u16* Y = (u16*)(p.ws + OFF_H);
  const float* gn = p.gla_norm + (size_t)li * 256;
  const int tid = TIDX(), lane = tid & 63, wave = tid >> 6;
  const int r = lane & 31, h = lane >> 5;

  bf16x8 bq[2][8];
#pragma unroll
  for (int ib = 0; ib < 2; ++ib)
#pragma unroll
    for (int ks = 0; ks < 8; ++ks)
      bq[ib][ks] = *(const bf16x8*)(GQ + (m0 + 32 * ib + r) * 512 + hh * 128 + 16 * ks + 8 * h);
  f32x16 X00, X01, X11;
#pragma unroll
  for (int q = 0; q < 16; ++q) { X00[q] = 0.f; X01[q] = 0.f; X11[q] = 0.f; }
#pragma unroll
  for (int ks = 0; ks < 8; ++ks) {
    const bf16x8 a0 = *(const bf16x8*)(GK + (m0 + r) * 512 + hh * 128 + 16 * ks + 8 * h);
    const bf16x8 a1 = *(const bf16x8*)(GK + (m0 + 32 + r) * 512 + hh * 128 + 16 * ks + 8 * h);
    X00 = MFMA32(a0, bq[0][ks], X00);
    X01 = MFMA32(a0, bq[1][ks], X01);
    X11 = MFMA32(a1, bq[1][ks], X11);
  }
#pragma unroll
  for (int q = 0; q < 16; ++q) {
    if (crow(q, h) > r) { X00[q] = 0.f; X11[q] = 0.f; }
  }
  f32x16 acc[2];
#pragma unroll
  for (int j = 0; j < 2; ++j)
#pragma unroll
    for (int q = 0; q < 16; ++q) acc[j][q] = 0.f;
  {
    const u16* st = (const u16*)SC + ((size_t)unit * 256 + 32 * wave + r) * 128 + 8 * h;
#pragma unroll
    for (int ks = 0; ks < 8; ++ks) {
      const bf16x8 a = *(const bf16x8*)(st + 16 * ks);
      acc[0] = MFMA32(a, bq[0][ks], acc[0]);
      acc[1] = MFMA32(a, bq[1][ks], acc[1]);
    }
  }
  {
    const u16* vr = GVT + ((size_t)(bh * 256 + 32 * wave + r)) * 8192 + c * 64;
#pragma unroll
    for (int s = 0; s < 2; ++s) {
      const bf16x8 pf00 = pack8(X00, s), pf01 = pack8(X01, s), pf11 = pack8(X11, s);
      {
        const s16x4 lo = *(const s16x4*)(vr + 16 * s + 4 * h);
        const s16x4 hi = *(const s16x4*)(vr + 16 * s + 8 + 4 * h);
        const bf16x8 a = __builtin_shufflevector(lo, hi, 0, 1, 2, 3, 4, 5, 6, 7);
        acc[0] = MFMA32(a, pf00, acc[0]);
        acc[1] = MFMA32(a, pf01, acc[1]);
      }
      {
        const s16x4 lo = *(const s16x4*)(vr + 32 + 16 * s + 4 * h);
        const s16x4 hi = *(const s16x4*)(vr + 32 + 16 * s + 8 + 4 * h);
        const bf16x8 a = __builtin_shufflevector(lo, hi, 0, 1, 2, 3, 4, 5, 6, 7);
        acc[1] = MFMA32(a, pf11, acc[1]);
      }
    }
  }
  float rstd[2];
#pragma unroll
  for (int ib = 0; ib < 2; ++ib) {
    float ss = 0.f;
#pragma unroll
    for (int q = 0; q < 16; ++q) ss += acc[ib][q] * acc[ib][q];
    ss = xh_sum(ss);
    if (h == 0) red[wave * 64 + 32 * ib + r] = ss;
  }
  __syncthreads();
#pragma unroll
  for (int ib = 0; ib < 2; ++ib) {
    float tot = 0.f;
#pragma unroll
    for (int w = 0; w < 8; ++w) tot += red[w * 64 + 32 * ib + r];
    rstd[ib] = rsqrtf(tot * (1.f / 256.f) + 1e-6f);
  }
#pragma unroll
  for (int ib = 0; ib < 2; ++ib)
#pragma unroll
    for (int gq = 0; gq < 4; ++gq) {
      const int e = 32 * wave + 8 * gq + 4 * h;
      const size_t m = m0 + 32 * ib + r;
      const u32x2 gt = *(const u32x2*)(GG + m * 1024 + hh * 256 + e);
      const float4 g4 = *(const float4*)(gn + e);
      const float rs = rstd[ib];
      u32x2 o;
      o[0] = pack_bf16(acc[ib][4 * gq + 0] * rs * g4.x * bf_lo(gt[0]), acc[ib][4 * gq + 1] * rs * g4.y * bf_hi(gt[0]));
      o[1] = pack_bf16(acc[ib][4 * gq + 2] * rs * g4.z * bf_lo(gt[1]), acc[ib][4 * gq + 3] * rs * g4.w * bf_hi(gt[1]));
      *(u32x2*)(Y + m * 2048 + 1024 + hh * 256 + e) = o;
    }
  __syncthreads();
}

__device__ const double kInvFreq[32] = {1.0, 0.7498942093324559, 0.5623413251903491, 0.4216965034285822, 0.31622776601683794, 0.23713737056616552, 0.1778279410038923, 0.1333521432163324, 0.1, 0.07498942093324558, 0.05623413251903491, 0.042169650342858224, 0.03162277660168379, 0.023713737056616554, 0.01778279410038923, 0.01333521432163324, 0.01, 0.007498942093324558, 0.005623413251903491, 0.004216965034285823, 0.0031622776601683794, 0.0023713737056616554, 0.0017782794100389228, 0.001333521432163324, 0.001, 0.0007498942093324559, 0.0005623413251903491, 0.00042169650342858224, 0.00031622776601683794, 0.00023713737056616554, 0.00017782794100389227, 0.0001333521432163324};

#define XB_TMO      128
#define XB_XCNT(j)  (256  + 64 * (j))
#define XB_XSUB(j)  (1280 + 64 * (j))
#define XB_XGEN(j)  (2304 + 64 * (j))
#define XB_TOP      3328
#define XB_TOPGEN   3392
#define XCD_BAR_WORDS 3456
#define XB_SPIN_CAP (1u << 20)
#define LAS __attribute__((address_space(3)))
DI unsigned xb_ld(unsigned* p)              { return __hip_atomic_load(p, __ATOMIC_RELAXED, __HIP_MEMORY_SCOPE_AGENT); }
DI unsigned xb_add(unsigned* p, unsigned v) { return __hip_atomic_fetch_add(p, v, __ATOMIC_RELAXED, __HIP_MEMORY_SCOPE_AGENT); }
DI unsigned xb_xcc_id() { return (unsigned)__builtin_amdgcn_s_getreg((3 << 11) | 20) & 0xFu; }
#define XB_SPIN(cond, bar) do { unsigned _sp = 0; while (cond) { __builtin_amdgcn_s_sleep(1); \
    if ((++_sp & 255u) == 0u) { if (xb_ld(&(bar)[XB_TMO])) break; if (_sp > XB_SPIN_CAP) { atomicAdd(&(bar)[XB_TMO], 1u); break; } } } } while (0)
struct XcdBarrier { unsigned* bar; unsigned x; volatile LAS unsigned* st; };
DI XcdBarrier xcd_barrier_post(unsigned* bar, volatile LAS unsigned* st) {
  XcdBarrier b; b.bar = bar; b.x = xb_xcc_id(); b.st = st;
  if (__builtin_amdgcn_workitem_id_x() == 0) (void)xb_add(&bar[XB_XCNT(b.x)], 1u);
  return b;
}
DI void xcd_barrier_complete(unsigned* bar, unsigned x, unsigned& nloc, unsigned& nx) {
  const unsigned G = gridDim.x * gridDim.y * gridDim.z;
  unsigned sum, cnt, mine, sp = 0u;
  for (;;) {
    sum = 0u; cnt = 0u; mine = 0u;
#pragma unroll
    for (unsigned j = 0; j < 16; ++j) { const unsigned c = xb_ld(&bar[XB_XCNT(j)]); sum += c; cnt += (c > 0u) ? 1u : 0u; mine = (j == x) ? c : mine; }
    if (sum == G) break;
    __builtin_amdgcn_s_sleep(1);
    if ((++sp & 255u) == 0u) { if (xb_ld(&bar[XB_TMO])) break; if (sp > XB_SPIN_CAP) { atomicAdd(&bar[XB_TMO], 1u); break; } }
  }
  nloc = mine > 0u ? mine : 1u; nx = cnt > 0u ? cnt : 1u;
}
DI void xcd_barrier(const XcdBarrier& b) {
  asm volatile("s_waitcnt vmcnt(0)" ::: "memory");
  __syncthreads();
  if (__builtin_amdgcn_workitem_id_x() == 0) {
    unsigned* bar = b.bar;
    __builtin_amdgcn_s_waitcnt(0);
    unsigned nloc = b.st[0], nx = b.st[1];
    if (nloc == 0u) { xcd_barrier_complete(bar, b.x, nloc, nx); b.st[0] = nloc; b.st[1] = nx; }
    const unsigned old = xb_add(&bar[XB_XSUB(b.x)], 1u);
    const unsigned gen = old / nloc;
    if (old + 1u == (gen + 1u) * nloc) {
      __builtin_amdgcn_fence(__ATOMIC_RELEASE, "agent");
      asm volatile("s_waitcnt vmcnt(0)" ::: "memory");
      const unsigned og = xb_add(&bar[XB_TOP], 1u);
      const unsigned tg = og / nx;
      if (og + 1u == (tg + 1u) * nx) xb_add(&bar[XB_TOPGEN], 1u);
      else XB_SPIN(xb_ld(&bar[XB_TOPGEN]) == tg, bar);
      __builtin_amdgcn_fence(__ATOMIC_ACQUIRE, "agent");
      xb_add(&bar[XB_XGEN(b.x)], 1u);
      asm volatile("s_waitcnt vmcnt(0)" ::: "memory");
    } else {
      XB_SPIN(xb_ld(&bar[XB_XGEN(b.x)]) == gen, bar);
      __builtin_amdgcn_fence(__ATOMIC_ACQUIRE, "agent");
      asm volatile("s_waitcnt vmcnt(0)" ::: "memory");
    }
  }
  __syncthreads();
}

constexpr int WG_LD = 2052;

DI GemmT gt_init(int K) {
  GemmT g;
  g.A = nullptr; g.B = nullptr; g.K = K; g.lda = K; g.ldb = K;
  g.mode = M_BF16; g.R0 = 0; g.C0 = 0; g.ld = 0; g.aux = 0; g.nact = 256; g.probe = 0; g.perm = 0;
  g.d16 = nullptr; g.d32 = nullptr; g.scale = 1.f; g.rs = nullptr; g.xin = nullptr; g.cs = nullptr; g.sn = nullptr;
  return g;
}

DI void tile_map(int t, int TN, int& tm, int& tn) {
  const int b = t & 255, k = t >> 8;
  const int x = b & 7, j = b >> 3;
  const int G = k * 8 + x;
  const int gpr = TN >> 2;
  const int gm = G / gpr, gn = G - gm * gpr;
  tm = gm * 8 + (j >> 2); tn = gn * 4 + (j & 3);
}

DI void phase_prep(const Params& p, int L, unsigned char* smem) {
  const bool even = (L & 1) == 0;
  const int li = L >> 1;
  u16* WL = (u16*)(p.ws + OFF_WL);
  float* lds = (float*)smem;
  if (L == 0) {
    float* cs = (float*)(p.ws + OFF_COS);
    float* sn = (float*)(p.ws + OFF_SIN);
    for (int i = blockIdx.x * 512 + TIDX(); i < T_ * 32; i += gridDim.x * 512) {
      const int m = i >> 5, f = i & 31;
      const double ang = (double)p.pos[m] * kInvFreq[f];
      const double t = ang * 0.63661977236758134308;
      const double kq = rint(t);
      const double rr = (t - kq) * 1.57079632679489661923;
      const int qd = (int)((long long)kq & 3);
      const double r2 = rr * rr;
      const double sr = rr * (1.0 - r2 / 6.0 * (1.0 - r2 / 20.0 * (1.0 - r2 / 42.0 * (1.0 - r2 / 72.0 * (1.0 - r2 / 110.0 * (1.0 - r2 / 156.0))))));
      const double cr = 1.0 - r2 / 2.0 * (1.0 - r2 / 12.0 * (1.0 - r2 / 30.0 * (1.0 - r2 / 56.0 * (1.0 - r2 / 90.0 * (1.0 - r2 / 132.0 * (1.0 - r2 / 182.0))))));
      const double cc = (qd == 0) ? cr : (qd == 1) ? -sr : (qd == 2) ? -cr : sr;
      const double sv = (qd == 0) ? sr : (qd == 1) ? cr : (qd == 2) ? -sr : -cr;
      cs[i] = (float)cc;
      sn[i] = (float)sv;
    }
  }
  if (even) {
    const float* win = p.w_in_even + (size_t)li * 2048 * 7184;
    const float* wout = p.w_out_even + (size_t)li * 2048 * 2048;
    const int n1 = 28 * 32, n2 = 8 * 32;
    for (int t = blockIdx.x; t < n1 + n2; t += gridDim.x) {
      if (t < n1) convert_tile256(win, 7184, nullptr, WL + WE_IN, 2048, (t & 31) * 64, (t >> 5) * 256, 0, lds);
      else { const int u = t - n1; convert_tile256(wout, 2048, nullptr, WL + WE_OUT, 2048, (u & 31) * 64, (u >> 5) * 256, 0, lds); }
    }
  } else {
    const float* win = p.w_in_odd + (size_t)li * 2048 * 3136;
    const float* wq = p.w_q_up + (size_t)li * 512 * 3072;
    const float* wkv = p.w_kv_up + (size_t)li * 512 * 4096;
    const float* wout = p.w_out_odd + (size_t)li * 2048 * 2048;
    const int n1 = 13 * 32, n2 = 12 * 8, n3 = 16 * 8, n4 = 8 * 32;
    for (int t = blockIdx.x; t < n1 + n2 + n3 + n4; t += gridDim.x) {
      if (t < n1) convert_tile256(win, 3136, nullptr, WL + WO_IN, 2048, (t & 31) * 64, (t >> 5) * 256, 1, lds);
      else if (t < n1 + n2) { const int u = t - n1; convert_tile256(wq, 3072, p.q_norm + (size_t)li * 512, WL + WO_Q, 512, (u & 7) * 64, (u >> 3) * 256, 2, lds); }
      else if (t < n1 + n2 + n3) { const int u = t - n1 - n2; convert_tile256(wkv, 4096, p.kv_norm + (size_t)li * 512, WL + WO_KV, 512, (u & 7) * 64, (u >> 3) * 256, 3, lds); }
      else { const int u = t - n1 - n2 - n3; convert_tile256(wout, 2048, nullptr, WL + WO_OUT, 2048, (u & 31) * 64, (u >> 5) * 256, 0, lds); }
    }
  }
  const float* xin = (L == 0) ? p.x : p.out;
  const float* g = even ? (p.ln_even + (size_t)li * 2048) : (p.ln_odd + (size_t)li * 2048);
  u16* H = (u16*)(p.ws + OFF_H);
  const int wave = TIDX() >> 6;
  if (even) {
    const float* wsrc = p.w_in_even + (size_t)li * 2048 * 7184 + 7168;
    const int tid = TIDX();
    for (int idx = tid; idx < 2048 * 16; idx += 512) {
      const int k = idx >> 4, c = idx & 15;
      lds[c * WG_LD + k] = wsrc[(size_t)k * 7184 + c];
    }
    __syncthreads();
    float* GA = (float*)(p.ws + E_GA);
    for (int row = blockIdx.x * 8 + wave; row < T_; row += gridDim.x * 8)
      norm_row<true>(xin + (size_t)row * 2048, g, H + (size_t)row * 2048, nullptr, lds, GA + (size_t)row * 16);
    __syncthreads();
  } else {
    for (int row = blockIdx.x * 8 + wave; row < T_; row += gridDim.x * 8)
      norm_row<false>(xin + (size_t)row * 2048, g, H + (size_t)row * 2048, nullptr, nullptr, nullptr);
  }
}

DI void phase_gemm_in_even(const Params& p, unsigned char* smem, int probe) {
  const u16* WL = (const u16*)(p.ws + OFF_WL);
  const u16* H = (const u16*)(p.ws + OFF_H);
  const int NT = 28;
  for (int t = blockIdx.x; t < 64 * NT; t += gridDim.x) {
    int tm, tn; tile_map(t, NT, tm, tn);
    GemmT g = gt_init(2048);
    const u16* Wt = WL + WE_IN + (size_t)tn * 256 * 2048;
    const u16* Ht = H + (size_t)tm * 256 * 2048;
    const bool trans = (tn >= 8 && tn < 12) || (tn >= 20 && tn < 24);
    if (trans) { g.A = Ht; g.B = Wt; g.R0 = tm * 256; } else { g.A = Wt; g.B = Ht; g.C0 = tm * 256; }
    if (tn < 4)       { g.mode = M_BF16; g.d16 = (u16*)(p.ws + E_SQ); g.ld = 1024; g.R0 = tn * 256; g.scale = 0.08838834764831845f * 1.4426950408889634f; }
    else if (tn < 8)  { g.mode = M_BF16; g.d16 = (u16*)(p.ws + E_SK); g.ld = 1024; g.R0 = (tn - 4) * 256; }
    else if (tn < 12) { g.mode = M_TRANS; g.d16 = (u16*)(p.ws + E_SVT); g.aux = 1024; g.C0 = (tn - 8) * 256; g.perm = 1; }
    else if (tn < 16) { g.mode = M_SILU; g.d16 = (u16*)(p.ws + E_SG); g.ld = 1024; g.R0 = (tn - 12) * 256; }
    else if (tn < 18) { g.mode = M_BF16; g.d16 = (u16*)(p.ws + E_GQ); g.ld = 512; g.R0 = (tn - 16) * 256; }
    else if (tn < 20) { g.mode = M_BF16; g.d16 = (u16*)(p.ws + E_GK); g.ld = 512; g.R0 = (tn - 18) * 256; }
    else if (tn < 24) { g.mode = M_TRANS; g.d16 = (u16*)(p.ws + E_GVT); g.aux = 1024; g.C0 = (tn - 20) * 256; }
    else              { g.mode = M_SILU; g.d16 = (u16*)(p.ws + E_GG); g.ld = 1024; g.R0 = (tn - 24) * 256; }
    g.probe = probe;
    gemm_tile8(g, smem);
  }
}

DI void phase_gemm_in_odd(const Params& p, unsigned char* smem) {
  const u16* WL = (const u16*)(p.ws + OFF_WL);
  const u16* H = (const u16*)(p.ws + OFF_H);
  const int NT = 12;
  for (int t = blockIdx.x; t < 64 * NT; t += gridDim.x) {
    int tm, tn; tile_map(t, NT, tm, tn);
    GemmT g = gt_init(2048);
    g.A = WL + WO_IN + (size_t)tn * 256 * 2048;
    g.B = H + (size_t)tm * 256 * 2048;
    g.C0 = tm * 256;
    if (tn < 2)      { g.mode = M_BF16; g.d16 = (u16*)(p.ws + O_QL); g.ld = 512; g.R0 = tn * 256; }
    else if (tn < 4) { g.mode = M_BF16; g.d16 = (u16*)(p.ws + O_KVL); g.ld = 512; g.R0 = (tn - 2) * 256; }
    else             { g.mode = M_SILU; g.d16 = (u16*)(p.ws + O_GATE); g.ld = 2048; g.R0 = (tn - 4) * 256; }
    gemm_tile8(g, smem);
  }
}

DI void phase_rstd_kr(const Params& p, unsigned char* smem) {
  for (int t = blockIdx.x; t < 64; t += gridDim.x) {
    GemmT g = gt_init(2048);
    g.A = (const u16*)(p.ws + OFF_WL) + WO_IN + (size_t)3072 * 2048;
    g.B = (const u16*)(p.ws + OFF_H) + (size_t)t * 256 * 2048;
    g.R0 = 0; g.C0 = t * 256; g.nact = 64; g.aux = 64;
    g.mode = M_ROPE; g.d16 = (u16*)(p.ws + O_KR); g.ld = 64;
    g.cs = (const float*)(p.ws + OFF_COS); g.sn = (const float*)(p.ws + OFF_SIN);
    gemm_tile8<true>(g, smem);
  }
  const u16* QL = (const u16*)(p.ws + O_QL);
  const u16* KVL = (const u16*)(p.ws + O_KVL);
  float* RSQ = (float*)(p.ws + O_RSQ);
  float* RSKV = (float*)(p.ws + O_RSKV);
  const int wave = TIDX() >> 6, lane = TIDX() & 63;
  for (int row = blockIdx.x * 8 + wave; row < 2 * T_; row += gridDim.x * 8) {
    const int m = row >> 1;
    const u16* src = (row & 1) ? KVL : QL;
    const u32x4 v = *(const u32x4*)(src + (size_t)m * 512 + lane * 8);
    float ss = 0.f;
#pragma unroll
    for (int q = 0; q < 4; ++q) { const float a = bf_lo(v[q]), b = bf_hi(v[q]); ss += a * a + b * b; }
    ss = wave_sum(ss);
    if (lane == 0) ((row & 1) ? RSKV : RSQ)[m] = rsqrtf(ss * (1.f / 512.f) + 1e-6f);
  }
}

DI void phase_gemm_up(const Params& p, unsigned char* smem) {
  const u16* WL = (const u16*)(p.ws + OFF_WL);
  const u16* QL = (const u16*)(p.ws + O_QL);
  const u16* KVL = (const u16*)(p.ws + O_KVL);
  const float* RSQ = (const float*)(p.ws + O_RSQ);
  const float* RSKV = (const float*)(p.ws + O_RSKV);
  const float qscale = 0.07216878364870322f * 1.4426950408889634f;
  const int NT = 28;
  for (int t = blockIdx.x; t < 64 * NT; t += gridDim.x) {
    int tm, tn; tile_map(t, NT, tm, tn);
    GemmT g = gt_init(512);
    if (tn < 8) {
      g.A = WL + WO_Q + (size_t)tn * 256 * 512; g.B = QL + (size_t)tm * 256 * 512;
      g.mode = M_BF16; g.d16 = (u16*)(p.ws + O_QN); g.ld = 2048; g.R0 = tn * 256; g.C0 = tm * 256; g.rs = RSQ; g.scale = qscale;
    } else if (tn < 12) {
      g.A = WL + WO_Q + (size_t)(2048 + (tn - 8) * 256) * 512; g.B = QL + (size_t)tm * 256 * 512;
      g.mode = M_ROPE; g.d16 = (u16*)(p.ws + O_QR); g.ld = 1024; g.R0 = (tn - 8) * 256; g.C0 = tm * 256; g.aux = 256; g.rs = RSQ; g.scale = qscale;
      g.cs = (const float*)(p.ws + OFF_COS); g.sn = (const float*)(p.ws + OFF_SIN);
    } else if (tn < 20) {
      g.A = WL + WO_KV + (size_t)(tn - 12) * 256 * 512; g.B = KVL + (size_t)tm * 256 * 512;
      g.mode = M_BF16; g.d16 = (u16*)(p.ws + O_KN); g.ld = 2048; g.R0 = (tn - 12) * 256; g.C0 = tm * 256; g.rs = RSKV;
    } else {
      g.A = KVL + (size_t)tm * 256 * 512; g.B = WL + WO_KV + (size_t)(2048 + (tn - 20) * 256) * 512;
      g.mode = M_TRANS; g.d16 = (u16*)(p.ws + O_VT); g.aux = 2048; g.R0 = tm * 256; g.C0 = (tn - 20) * 256; g.rs = RSKV; g.perm = 1;
    }
    gemm_tile8(g, smem);
  }
}

DI void phase_gemm_out(const Params& p, int L, unsigned char* smem) {
  const bool even = (L & 1) == 0;
  const u16* WL = (const u16*)(p.ws + OFF_WL) + (even ? WE_OUT : WO_OUT);
  const u16* Y = (const u16*)(p.ws + OFF_H);
  const float* xin = (L == 0) ? p.x : p.out;
  for (int t = blockIdx.x; t < 64 * 8; t += gridDim.x) {
    int tm, tn; tile_map(t, 8, tm, tn);
    GemmT g = gt_init(2048);
    g.A = WL + (size_t)tn * 256 * 2048; g.B = Y + (size_t)tm * 256 * 2048;
    g.mode = M_RESID; g.R0 = tn * 256; g.C0 = tm * 256; g.d32 = p.out; g.xin = xin;
    gemm_tile8(g, smem);
  }
}

DI int next_item(int* ctr, int* sitem) {
  if (TIDX() == 0) *sitem = atomicAdd(ctr, 1);
  __syncthreads();
  const int it = *sitem;
  __syncthreads();
  return it;
}

DI void phase_even_mix(const Params& p, int L, int ph, unsigned char* smem, int* sitem, bool do_g1) {
  int* ctr = (int*)(p.ws + OFF_CTR) + ph;
  const int li = L >> 1;
  for (;;) {
    const int it = next_item(ctr, sitem);
    if (it >= 1536) break;
    if (it < 512) {
      const int qb = 31 - (it >> 4), bh = it & 15, b = bh >> 3, hh = bh & 7;
      const u16* SQ = (const u16*)(p.ws + E_SQ) + (size_t)b * S_ * 1024 + hh * 128;
      const u16* SK = (const u16*)(p.ws + E_SK) + (size_t)b * S_ * 1024 + hh * 128;
      const u16* SVT = (const u16*)(p.ws + E_SVT) + ((size_t)(b * 1024 + hh * 128)) * 8192;
      const u16* SG = (const u16*)(p.ws + E_SG) + (size_t)b * S_ * 1024 + hh * 128;
      u16* Y = (u16*)(p.ws + OFF_H) + (size_t)b * S_ * 2048 + hh * 128;
      attn_item<128, true, 1024, 0, 1024, 0, 1024>(SQ, nullptr, SK, nullptr, SVT, SG, Y, qb * 256, smem);
    } else {
      if (do_g1) gla_g1(p, li, it - 512, smem);
    }
  }
}

DI void phase_gla_out(const Params& p, int L, int ph, unsigned char* smem, int* sitem) {
  int* ctr = (int*)(p.ws + OFF_CTR) + ph;
  const int li = L >> 1;
  for (;;) {
    const int it = next_item(ctr, sitem);
    if (it >= 1024) break;
    gla_g3(p, li, it, smem);
  }
}

DI void mla_item(const Params& p, int bh, int qb, unsigned char* smem, int probe) {
  const int b = bh >> 4, hh = bh & 15;
  const u16* QN = (const u16*)(p.ws + O_QN) + (size_t)b * S_ * 2048 + hh * 128;
  const u16* QR = (const u16*)(p.ws + O_QR) + (size_t)b * S_ * 1024 + hh * 64;
  const u16* KN = (const u16*)(p.ws + O_KN) + (size_t)b * S_ * 2048 + hh * 128;
  const u16* KR = (const u16*)(p.ws + O_KR) + (size_t)b * S_ * 64;
  const u16* VT = (const u16*)(p.ws + O_VT) + ((size_t)(b * 2048 + hh * 128)) * 8192;
  const u16* GT = (const u16*)(p.ws + O_GATE) + (size_t)b * S_ * 2048 + hh * 128;
  u16* Y = (u16*)(p.ws + OFF_H) + (size_t)b * S_ * 2048 + hh * 128;
  attn_item<192, false, 2048, 1024, 2048, 64, 2048>(QN, QR, KN, KR, VT, GT, Y, qb * 256, smem, probe);
}

DI void phase_mla(const Params& p, int ph, unsigned char* smem, int* sitem, int probe) {
  if (gridDim.x == 256) {
    const int x = blockIdx.x & 7, j = blockIdx.x >> 3, half = j >> 4, jp = j & 15;
#pragma unroll 1
    for (int pass = 0; pass < 2; ++pass) {
      const int bh = 4 * x + 2 * pass + half;
      mla_item(p, bh, 31 - jp, smem, probe);
      mla_item(p, bh, jp, smem, probe);
    }
    return;
  }
  int* ctr = (int*)(p.ws + OFF_CTR) + 64 + (ph % 24) * 8;
  const int x = (int)(xb_xcc_id() & 7u);
  for (;;) {
    if (TIDX() == 0) {
      int it = -1;
      for (int k = 0; k < 8; ++k) {
        const int q = (x + k) & 7;
        const int v = atomicAdd(ctr + q, 1);
        if (v < 128) { it = q * 128 + v; break; }
      }
      *sitem = it;
    }
    __syncthreads();
    const int it = *sitem;
    __syncthreads();
    if (it < 0) break;
    const int q = it >> 7, v = it & 127;
    mla_item(p, 4 * q + (v >> 5), 31 - (v & 31), smem, probe);
  }
}

DI void phase_final(const Params& p) {
  const int wave = TIDX() >> 6;
  for (int row = blockIdx.x * 8 + wave; row < T_; row += gridDim.x * 8)
    norm_row<false>(p.out + (size_t)row * 2048, p.final_norm, nullptr, p.out + (size_t)row * 2048, nullptr, nullptr);
}

__global__ void __launch_bounds__(512, 2) fwd_kernel(Params p_arg, int ph0, int ph1) {
  __shared__ __attribute__((aligned(16))) unsigned char smem[SMEM_BYTES + 64];
  int& sitem = *(int*)(smem + SMEM_BYTES);
  uint4& xb_words = *(uint4*)(smem + SMEM_BYTES + 16);
  cg::grid_group grid = cg::this_grid();
  if (__builtin_amdgcn_workitem_id_x() == 0) xb_words = make_uint4(0u, 0u, 0u, 0u);
  __syncthreads();
  XcdBarrier xb = xcd_barrier_post((unsigned*)(p_arg.ws + OFF_BAR), (volatile LAS unsigned*)&xb_words);
  if (ph1 > 1000) grid.sync();
  typedef const __attribute__((address_space(4))) Params* KP;
  const KP kp0 = (KP)__builtin_amdgcn_kernarg_segment_ptr();
  for (int ph = ph0; ph < ph1; ++ph) {
   for (int rep = 0; rep < 2; ++rep) {
    if (rep == 1) { if (!((REPEAT_MASK >> ph) & 1)) break; xcd_barrier(xb); }
    const int cph = ph + 32 * rep;
    KP kq = kp0;
    asm volatile("" : "+s"(kq));
    const Params& p = *(const Params*)kq;
    if (ph == 24) {
      phase_final(p);
    } else {
      const int L = ph / 6, sub = ph % 6;
      const bool even = (L & 1) == 0;
      if (sub == 0) { if (PH_MASK & 1) phase_prep(p, L, smem); }
      else if (sub == 1) { if (even) { if (PH_MASK & 2) phase_gemm_in_even(p, smem, rep); } else { if (PH_MASK & 4) phase_gemm_in_odd(p, smem); } }
      else if (sub == 2) { if (even) { if (PH_MASK & 8) phase_even_mix(p, L, cph, smem, &sitem, rep == 0); } else { if (PH_MASK & 16) phase_rstd_kr(p, smem); } }
      else if (sub == 3) { if (even) { if (PH_MASK & 32) gla_scan(p); } else { if (PH_MASK & 64) phase_gemm_up(p, smem); } }
      else if (sub == 4) { if (even) { if (PH_MASK & 128) phase_gla_out(p, L, cph, smem, &sitem); } else { if (PH_MASK & 256) phase_mla(p, cph, smem, &sitem, rep); } }
      else { if (PH_MASK & 512) phase_gemm_out(p, L, smem); }
    }
   }
    if (ph + 1 < ph1) xcd_barrier(xb);
  }
}

extern "C" void kernel_launch(void* const* d_in, const int* in_sizes, int n_in, void* d_out, int out_size,
                              void* d_ws, size_t ws_size, hipStream_t stream) {
  static int grid_blocks = 0;
  if (!grid_blocks) {
    int dev = 0, cus = 0, per_cu = 0;
    (void)hipGetDevice(&dev);
    (void)hipDeviceGetAttribute(&cus, hipDeviceAttributeMultiprocessorCount, dev);
    (void)hipOccupancyMaxActiveBlocksPerMultiprocessor(&per_cu, fwd_kernel, 512, 0);
    if (per_cu < 1) per_cu = 1;
    if (per_cu > 1) per_cu = 1;
    grid_blocks = cus * per_cu;
  }
  if (ws_size < WS_NEED) { fprintf(stderr, "workspace too small: %zu\n", ws_size); return; }
  Params p{};
  p.x = (const float*)d_in[0]; p.pos = (const int*)d_in[1];
  p.ln_even = (const float*)d_in[2]; p.w_in_even = (const float*)d_in[3];
  p.alpha_up = (const float*)d_in[4]; p.alpha_bias = (const float*)d_in[5];
  p.gla_norm = (const float*)d_in[6]; p.w_out_even = (const float*)d_in[7];
  p.ln_odd = (const float*)d_in[8]; p.w_in_odd = (const float*)d_in[9];
  p.q_norm = (const float*)d_in[10]; p.w_q_up = (const float*)d_in[11];
  p.kv_norm = (const float*)d_in[12]; p.w_kv_up = (const float*)d_in[13];
  p.w_out_odd = (const float*)d_in[14]; p.final_norm = (const float*)d_in[15];
  p.out = (float*)d_out; p.ws = (unsigned char*)d_ws;
  (void)hipMemsetAsync((unsigned char*)d_ws + OFF_CTR, 0, 16384, stream);
  int a0 = 0, a1 = NPHASE;
  void* args[] = {&p, &a0, &a1};
  hipError_t e = hipLaunchCooperativeKernel((void*)fwd_kernel, dim3(grid_blocks), dim3(512), args, 0, stream);
  if (e != hipSuccess) fprintf(stderr, "cooperative launch failed: %s (grid %d)\n", hipGetErrorString(e), grid_blocks);
}
```

```cpp
#include <hip/hip_runtime.h>
#include <hip/hip_cooperative_groups.h>
#include <cstdio>
#include <cstdint>
#include <type_traits>
namespace cg = cooperative_groups;

#ifndef ONE_LAUNCH
#define ONE_LAUNCH 1
#endif

#ifndef REPEAT_MASK
#define REPEAT_MASK 0
#endif
#ifndef PROBE_MODE
#define PROBE_MODE 0
#endif
#ifndef PH_MASK
#define PH_MASK 0xFFFF
#endif
#define DI __device__ __forceinline__
typedef unsigned short u16;
using bf16x8 = __attribute__((ext_vector_type(8))) short;
using s16x4  = __attribute__((ext_vector_type(4))) short;
using f32x16 = __attribute__((ext_vector_type(16))) float;
using u32x4  = __attribute__((ext_vector_type(4))) unsigned;
using u32x2  = __attribute__((ext_vector_type(2))) unsigned;
#define MFMA32(a, b, c) __builtin_amdgcn_mfma_f32_32x32x16_bf16((a), (b), (c), 0, 0, 0)

constexpr int S_ = 8192;
constexpr int T_ = 16384;
constexpr size_t MiB = (size_t)1 << 20;

constexpr size_t OFF_WL = 0;
constexpr size_t OFF_H  = 40 * MiB;
constexpr size_t OFF_L  = 104 * MiB;
constexpr size_t E_SQ  = OFF_L + 0 * MiB;
constexpr size_t E_SK  = OFF_L + 32 * MiB;
constexpr size_t E_SVT = OFF_L + 64 * MiB;
constexpr size_t E_SG  = OFF_L + 96 * MiB;
constexpr size_t E_GQ  = OFF_L + 128 * MiB;
constexpr size_t E_GK  = OFF_L + 144 * MiB;
constexpr size_t E_GVT = OFF_L + 160 * MiB;
constexpr size_t E_GG  = OFF_L + 192 * MiB;
constexpr size_t E_GA  = OFF_L + 224 * MiB;
constexpr size_t E_EBL = OFF_L + 225 * MiB;
constexpr size_t E_SC  = OFF_L + 226 * MiB;
constexpr size_t O_QL   = OFF_L + 0 * MiB;
constexpr size_t O_KVL  = OFF_L + 16 * MiB;
constexpr size_t O_GATE = OFF_L + 32 * MiB;
constexpr size_t O_KR   = OFF_L + 96 * MiB;
constexpr size_t O_RSQ  = OFF_L + 98 * MiB;
constexpr size_t O_RSKV = OFF_L + 98 * MiB + 65536;
constexpr size_t O_QN   = OFF_L + 99 * MiB;
constexpr size_t O_QR   = OFF_L + 163 * MiB;
constexpr size_t O_KN   = OFF_L + 195 * MiB;
constexpr size_t O_VT   = OFF_L + 259 * MiB;
constexpr size_t OFF_COS = 460 * MiB;
constexpr size_t OFF_SIN = 462 * MiB;
constexpr size_t OFF_CTR = 464 * MiB;
constexpr size_t OFF_BAR = 464 * MiB + 1024;
constexpr size_t WS_NEED = 465 * MiB;

constexpr size_t WE_IN = 0;
constexpr size_t WE_OUT = (size_t)7168 * 2048;
constexpr size_t WO_IN = 0;
constexpr size_t WO_Q = (size_t)3328 * 2048;
constexpr size_t WO_KV = WO_Q + (size_t)3072 * 512;
constexpr size_t WO_OUT = WO_KV + (size_t)4096 * 512;

constexpr int NPHASE = 25;
constexpr int SMEM_BYTES = 147456;

struct Params {
  const float* x; const int* pos;
  const float* ln_even; const float* w_in_even; const float* alpha_up; const float* alpha_bias;
  const float* gla_norm; const float* w_out_even;
  const float* ln_odd; const float* w_in_odd; const float* q_norm; const float* w_q_up;
  const float* kv_norm; const float* w_kv_up; const float* w_out_odd;
  const float* final_norm;
  float* out; unsigned char* ws;
};

DI unsigned pack_bf16(float a, float b) {
  typedef __bf16 bf2 __attribute__((ext_vector_type(2)));
  typedef float f2 __attribute__((ext_vector_type(2)));
  f2 v = {a, b};
  bf2 r = __builtin_convertvector(v, bf2);
  return __builtin_bit_cast(unsigned, r);
}
DI u16 to_bf16(float a) { return (u16)(pack_bf16(a, 0.f) & 0xffffu); }
DI float bf_lo(unsigned w) { return __uint_as_float(w << 16); }
DI float bf_hi(unsigned w) { return __uint_as_float(w & 0xffff0000u); }
DI int TIDX() { int t = __builtin_amdgcn_workitem_id_x(); asm volatile("" : "+v"(t)); return t; }
DI int crow(int reg, int h) { return (reg & 3) + 8 * (reg >> 2) + 4 * h; }
DI float xh_max(float x) {
  const auto r = __builtin_amdgcn_permlane32_swap(__float_as_uint(x), __float_as_uint(x), false, false);
  return fmaxf(__uint_as_float(r[0]), __uint_as_float(r[1]));
}
DI float xh_sum(float x) {
  const auto r = __builtin_amdgcn_permlane32_swap(__float_as_uint(x), __float_as_uint(x), false, false);
  return __uint_as_float(r[0]) + __uint_as_float(r[1]);
}
DI float xh_partner(float x, int h) {
  const auto r = __builtin_amdgcn_permlane32_swap(__float_as_uint(x), __float_as_uint(x), false, false);
  return h ? __uint_as_float(r[0]) : __uint_as_float(r[1]);
}
DI float dpp_add(float v, const int ctrl_tag) {
  int r;
  if (ctrl_tag == 0) r = __builtin_amdgcn_update_dpp(0, __float_as_int(v), 0xB1, 0xf, 0xf, true);
  else if (ctrl_tag == 1) r = __builtin_amdgcn_update_dpp(0, __float_as_int(v), 0x4E, 0xf, 0xf, true);
  else if (ctrl_tag == 2) r = __builtin_amdgcn_update_dpp(0, __float_as_int(v), 0x141, 0xf, 0xf, true);
  else r = __builtin_amdgcn_update_dpp(0, __float_as_int(v), 0x140, 0xf, 0xf, true);
  return v + __int_as_float(r);
}
DI float wave_sum(float v) {
  v = dpp_add(v, 0); v = dpp_add(v, 1); v = dpp_add(v, 2); v = dpp_add(v, 3);
  { const auto r = __builtin_amdgcn_permlane16_swap(__float_as_uint(v), __float_as_uint(v), false, false);
    v = __uint_as_float(r[0]) + __uint_as_float(r[1]); }
  return xh_sum(v);
}
DI float silu_f(float v) { return v * __builtin_amdgcn_rcpf(1.f + __expf(-v)); }
DI bf16x8 pack8(const f32x16& x, int s) {
  u32x4 p;
  p[0] = pack_bf16(x[8 * s + 0], x[8 * s + 1]);
  p[1] = pack_bf16(x[8 * s + 2], x[8 * s + 3]);
  p[2] = pack_bf16(x[8 * s + 4], x[8 * s + 5]);
  p[3] = pack_bf16(x[8 * s + 6], x[8 * s + 7]);
  return __builtin_bit_cast(bf16x8, p);
}

DI void convert_tile(const float* __restrict__ src, int ldn, const float* __restrict__ gain,
                     u16* __restrict__ dst, int K, int k0, int nd0, int ns0, int nvalid, float* lds) {
  const int tid = TIDX();
  const int c = tid & 63, r0 = tid >> 6;
#pragma unroll
  for (int i = 0; i < 8; ++i) {
    const int r = r0 + 8 * i;
    float v = 0.f;
    if (c < nvalid) {
      v = src[(size_t)(k0 + r) * ldn + ns0 + c];
      if (gain) v *= gain[k0 + r];
    }
    lds[r * 65 + c] = v;
  }
  __syncthreads();
  const int kk = (tid & 31) * 2, n = tid >> 5;
#pragma unroll
  for (int i = 0; i < 4; ++i) {
    const int nn = n + 16 * i;
    const unsigned pk = pack_bf16(lds[kk * 65 + nn], lds[(kk + 1) * 65 + nn]);
    *(unsigned*)(dst + (size_t)(nd0 + nn) * K + k0 + kk) = pk;
  }
  __syncthreads();
}

DI int src_col(int mode, int nd) {
  if (mode == 0) return nd;
  if (mode == 1) return nd < 1024 ? nd : (nd < 3072 ? nd + 64 : (nd < 3136 ? nd - 2048 : -1));
  if (mode == 2) return nd < 2048 ? (nd >> 7) * 192 + (nd & 127) : ((nd - 2048) >> 6) * 192 + 128;
  return nd < 2048 ? (nd >> 7) * 256 + (nd & 127) : ((nd - 2048) >> 7) * 256 + 128 + ((nd - 2048) & 127);
}
DI void convert_tile256(const float* __restrict__ src, int ldn, const float* __restrict__ gain,
                        u16* __restrict__ dst, int K, int k0, int nd0, int mode, float* lds) {
  constexpr int LDW = 260;
  const int tid = TIDX();
  {
    const int col4 = tid & 63, row0 = tid >> 6;
    const int nd = nd0 + col4 * 4;
    const int sc = src_col(mode, nd & ~63);
    const float* sp = src + (size_t)(k0 + row0) * ldn + (sc + (nd & 63));
#pragma unroll
    for (int i = 0; i < 8; ++i) {
      float z = 0.f;
      asm volatile("" : "+v"(z));
      float4 v = make_float4(z, z, z, z);
      if (sc >= 0) {
        v = *(const float4*)(sp + (size_t)(8 * i) * ldn);
        if (gain) { const float gg = gain[k0 + row0 + 8 * i]; v.x *= gg; v.y *= gg; v.z *= gg; v.w *= gg; }
      }
      *(float4*)(lds + (row0 + 8 * i) * LDW + col4 * 4) = v;
    }
  }
  __syncthreads();
  {
    const int kc = tid & 7;
#pragma unroll
    for (int j = 0; j < 4; ++j) {
      const int n = (tid >> 3) + 64 * j;
      const float* lp = lds + (kc * 8) * LDW + n;
      u32x4 pk;
      pk[0] = pack_bf16(lp[0 * LDW], lp[1 * LDW]);
      pk[1] = pack_bf16(lp[2 * LDW], lp[3 * LDW]);
      pk[2] = pack_bf16(lp[4 * LDW], lp[5 * LDW]);
      pk[3] = pack_bf16(lp[6 * LDW], lp[7 * LDW]);
      *(u32x4*)(dst + (size_t)(nd0 + n) * K + k0 + kc * 8) = pk;
    }
  }
  __syncthreads();
}

template <bool GA>
DI void norm_row(const float* __restrict__ xrow, const float* __restrict__ g, u16* __restrict__ hrow,
                 float* __restrict__ orow, const float* wg, float* __restrict__ garow) {
  const int lane = TIDX() & 63;
  float4 v[8];
  float ss = 0.f;
#pragma unroll
  for (int i = 0; i < 8; ++i) {
    v[i] = ((const float4*)xrow)[lane + 64 * i];
    ss += v[i].x * v[i].x + v[i].y * v[i].y + v[i].z * v[i].z + v[i].w * v[i].w;
  }
  ss = wave_sum(ss);
  const float rstd = rsqrtf(ss * (1.f / 2048.f) + 1e-6f);
  float ga[16];
  if constexpr (GA) {
#pragma unroll
    for (int c = 0; c < 16; ++c) ga[c] = 0.f;
  }
#pragma unroll
  for (int i = 0; i < 8; ++i) {
    const float4 gg = ((const float4*)g)[lane + 64 * i];
    const float a = v[i].x * rstd * gg.x, b = v[i].y * rstd * gg.y, c = v[i].z * rstd * gg.z, d = v[i].w * rstd * gg.w;
    if (hrow) {
      u32x2 o; o[0] = pack_bf16(a, b); o[1] = pack_bf16(c, d);
      ((u32x2*)hrow)[lane + 64 * i] = o;
    } else {
      ((float4*)orow)[lane + 64 * i] = make_float4(a, b, c, d);
    }
    if constexpr (GA) {
#pragma unroll
      for (int cc = 0; cc < 16; ++cc) {
        const float4 w = ((const float4*)(wg + cc * 2052))[lane + 64 * i];
        ga[cc] += a * w.x + b * w.y + c * w.z + d * w.w;
      }
    }
  }
  if constexpr (GA) {
    float mine = 0.f;
#pragma unroll
    for (int cc = 0; cc < 16; ++cc) {
      const float t = wave_sum(ga[cc]);
      if (lane == cc) mine = t;
    }
    if (lane < 16) garow[lane] = mine;
  }
}

enum { M_BF16 = 0, M_SILU = 1, M_TRANS = 2, M_ROPE = 4, M_RESID = 5 };
struct GemmT {
  const u16* A; const u16* B; int lda, ldb, K;
  int mode, R0, C0, ld, aux, nact, probe, perm;
  u16* d16; float* d32; float scale; const float* rs; const float* xin; const float* cs; const float* sn;
};
constexpr int LDT = 72;

DI void gemm_tile(const GemmT& g, unsigned char* smem) {
  const int tid = TIDX(), lane = tid & 63, wave = tid >> 6;
  const int wm = (wave >> 2) * 128, wn = (wave & 3) * 64;
  const int r = lane & 31, h = lane >> 5;
  u16* sA = (u16*)smem;
  u16* sB = sA + 2 * 256 * LDT;
  const int lrow = tid >> 3, lch = (tid & 7) * 8;
  const u16* Ag = g.A + (size_t)lrow * g.lda + lch;
  const u16* Bg = g.B + (size_t)lrow * g.ldb + lch;
  const bool active = wm < g.nact;
  u32x4 ra[4], rb[4];
  f32x16 acc[4][2];
#pragma unroll
  for (int i = 0; i < 4; ++i)
#pragma unroll
    for (int j = 0; j < 2; ++j)
#pragma unroll
      for (int q = 0; q < 16; ++q) acc[i][j][q] = 0.f;

#pragma unroll
  for (int i = 0; i < 4; ++i) {
    ra[i] = *(const u32x4*)(Ag + (size_t)(64 * i) * g.lda);
    rb[i] = *(const u32x4*)(Bg + (size_t)(64 * i) * g.ldb);
  }
  __syncthreads();
#pragma unroll
  for (int i = 0; i < 4; ++i) {
    *(u32x4*)(sA + (lrow + 64 * i) * LDT + lch) = ra[i];
    *(u32x4*)(sB + (lrow + 64 * i) * LDT + lch) = rb[i];
  }
#pragma unroll
  for (int i = 0; i < 4; ++i) {
    ra[i] = *(const u32x4*)(Ag + (size_t)(64 * i) * g.lda + 64);
    rb[i] = *(const u32x4*)(Bg + (size_t)(64 * i) * g.ldb + 64);
  }
  __syncthreads();
  const int KT = g.K >> 6;
  for (int kt = 0; kt < KT; ++kt) {
    if (kt + 1 < KT) {
      u16* a_d = sA + ((kt + 1) & 1) * 256 * LDT;
      u16* b_d = sB + ((kt + 1) & 1) * 256 * LDT;
#pragma unroll
      for (int i = 0; i < 4; ++i) {
        *(u32x4*)(a_d + (lrow + 64 * i) * LDT + lch) = ra[i];
        *(u32x4*)(b_d + (lrow + 64 * i) * LDT + lch) = rb[i];
      }
    }
    if (kt + 2 < KT && !(PROBE_MODE == 1 && g.probe)) {
#pragma unroll
      for (int i = 0; i < 4; ++i) {
        ra[i] = *(const u32x4*)(Ag + (size_t)(64 * i) * g.lda + (kt + 2) * 64);
        rb[i] = *(const u32x4*)(Bg + (size_t)(64 * i) * g.ldb + (kt + 2) * 64);
      }
    }
    __builtin_amdgcn_sched_barrier(0);
    if (active) {
      const u16* a_s = sA + (kt & 1) * 256 * LDT + (wm + r) * LDT + 8 * h;
      const u16* b_s = sB + (kt & 1) * 256 * LDT + (wn + r) * LDT + 8 * h;
#pragma unroll
      for (int ks = 0; ks < 4; ++ks) {
        bf16x8 af[4], bf[2];
#pragma unroll
        for (int i = 0; i < 4; ++i) af[i] = *(const bf16x8*)(a_s + 32 * i * LDT + ks * 16);
#pragma unroll
        for (int j = 0; j < 2; ++j) bf[j] = *(const bf16x8*)(b_s + 32 * j * LDT + ks * 16);
#pragma unroll
        for (int i = 0; i < 4; ++i)
#pragma unroll
          for (int j = 0; j < 2; ++j) acc[i][j] = MFMA32(af[i], bf[j], acc[i][j]);
      }
    }
    __syncthreads();
  }
  if (!active) return;
  if (PROBE_MODE && g.probe) {
    float sacc = 0.f;
#pragma unroll
    for (int i = 0; i < 4; ++i)
#pragma unroll
      for (int j = 0; j < 2; ++j)
#pragma unroll
        for (int q = 0; q < 16; ++q) sacc += acc[i][j][q];
    if (sacc == 1.2345e-30f) g.d16[0] = 0;
    return;
  }

  const int mode = g.mode;
  if (mode == M_ROPE) {
#pragma unroll
    for (int j = 0; j < 2; ++j) {
      const int tok = g.C0 + wn + 32 * j + r;
      const float sc = g.scale * (g.rs ? g.rs[tok] : 1.f);
#pragma unroll
      for (int ip = 0; ip < 2; ++ip) {
        if (wm + 64 * ip < g.aux) {
#pragma unroll
          for (int g4 = 0; g4 < 4; ++g4) {
            const int c0 = 8 * g4 + 4 * h;
            const float4 cs = *(const float4*)(g.cs + (size_t)tok * 32 + c0);
            const float4 sn = *(const float4*)(g.sn + (size_t)tok * 32 + c0);
            const float a0 = acc[2 * ip][j][4 * g4 + 0] * sc, a1 = acc[2 * ip][j][4 * g4 + 1] * sc;
            const float a2 = acc[2 * ip][j][4 * g4 + 2] * sc, a3 = acc[2 * ip][j][4 * g4 + 3] * sc;
            const float b0 = acc[2 * ip + 1][j][4 * g4 + 0] * sc, b1 = acc[2 * ip + 1][j][4 * g4 + 1] * sc;
            const float b2 = acc[2 * ip + 1][j][4 * g4 + 2] * sc, b3 = acc[2 * ip + 1][j][4 * g4 + 3] * sc;
            u32x2 o1, o2;
            o1[0] = pack_bf16(a0 * cs.x - b0 * sn.x, a1 * cs.y - b1 * sn.y);
            o1[1] = pack_bf16(a2 * cs.z - b2 * sn.z, a3 * cs.w - b3 * sn.w);
            o2[0] = pack_bf16(b0 * cs.x + a0 * sn.x, b1 * cs.y + a1 * sn.y);
            o2[1] = pack_bf16(b2 * cs.z + a2 * sn.z, b3 * cs.w + a3 * sn.w);
            u16* dp = g.d16 + (size_t)tok * g.ld + g.R0 + wm + 64 * ip + c0;
            *(u32x2*)dp = o1;
            *(u32x2*)(dp + 32) = o2;
          }
        }
      }
    }
    return;
  }
  unsigned char* wreg = smem + wave * 17408;
  if (mode == M_RESID) {
#pragma unroll
    for (int j = 0; j < 2; ++j) {
#pragma unroll
      for (int i = 0; i < 4; ++i)
#pragma unroll
        for (int g4 = 0; g4 < 4; ++g4)
          *(float4*)(wreg + r * 528 + (32 * i + 8 * g4 + 4 * h) * 4) =
              make_float4(acc[i][j][4 * g4 + 0], acc[i][j][4 * g4 + 1], acc[i][j][4 * g4 + 2], acc[i][j][4 * g4 + 3]);
#pragma unroll
      for (int it = 0; it < 16; ++it) {
        const int row = 2 * it + h;
        const float4 v = *(const float4*)(wreg + row * 528 + r * 16);
        const size_t o = (size_t)(g.C0 + wn + 32 * j + row) * 2048 + g.R0 + wm + r * 4;
        const float4 x = *(const float4*)(g.xin + o);
        *(float4*)(g.d32 + o) = make_float4(x.x + v.x, x.y + v.y, x.z + v.z, x.w + v.w);
      }
    }
    return;
  }
#pragma unroll
  for (int j = 0; j < 2; ++j) {
    const int outer = g.C0 + wn + 32 * j + r;
    const float sc = (mode == M_BF16) ? g.scale * (g.rs ? g.rs[outer] : 1.f) : 1.f;
#pragma unroll
    for (int i = 0; i < 4; ++i)
#pragma unroll
      for (int g4 = 0; g4 < 4; ++g4) {
        float v0 = acc[i][j][4 * g4 + 0], v1 = acc[i][j][4 * g4 + 1], v2 = acc[i][j][4 * g4 + 2], v3 = acc[i][j][4 * g4 + 3];
        if (mode == M_BF16) { v0 *= sc; v1 *= sc; v2 *= sc; v3 *= sc; }
        else if (mode == M_SILU) { v0 = silu_f(v0); v1 = silu_f(v1); v2 = silu_f(v2); v3 = silu_f(v3); }
        else if (g.rs) {
          const float4 r4 = *(const float4*)(g.rs + g.R0 + wm + 32 * i + 8 * g4 + 4 * h);
          v0 *= r4.x; v1 *= r4.y; v2 *= r4.z; v3 *= r4.w;
        }
        u32x2 pk; pk[0] = pack_bf16(v0, v1); pk[1] = pack_bf16(v2, v3);
        *(u32x2*)(wreg + (32 * j + r) * 272 + (32 * i + 8 * g4 + 4 * h) * 2) = pk;
      }
  }
  {
    const int inner0 = g.R0 + wm;
#pragma unroll
    for (int it = 0; it < 16; ++it) {
      const int row = 4 * it + (lane >> 4), ch = lane & 15;
      const u32x4 v = *(const u32x4*)(wreg + row * 272 + ch * 16);
      const int outer = g.C0 + wn + row;
      size_t o;
      if (mode == M_TRANS) o = ((size_t)(inner0 >> 13) * g.aux + outer) * 8192 + (inner0 & 8191);
      else o = (size_t)outer * g.ld + inner0;
      *(u32x4*)(g.d16 + o + ch * 8) = v;
    }
  }
}

using f32x4v = __attribute__((ext_vector_type(4))) float;
DI int lds_byte8(int r, int c) {
  const int st = (r >> 4) * 2 + (c >> 5), rr = r & 15, cc = c & 31, ob = rr * 64 + cc * 2;
  return st * 1024 + (ob ^ (((ob >> 9) & 1) << 5));
}
DI void stage_rc8(int b, int& R, int& C) {
  const int st = b / 1024, sb = b % 1024, swz = sb ^ (((sb >> 9) & 1) << 5);
  R = (st >> 1) * 16 + swz / 64; C = (st & 1) * 32 + (swz % 64) / 2;
}
template <bool KR = false>
DI void gemm_tile8(const GemmT& g, unsigned char* smem) {
  constexpr int BK = 64, HALF = 128, HT = HALF * BK;
  u16* shm = (u16*)smem;
  const u16* A = g.A; const u16* Bt = g.B; const int K = g.K;
  const int tid = TIDX();
  const int nact = g.nact;
  #define SA8(b,h) (shm+((b)*2+(h))*HT)
  #define SB8(b,h) (shm+(4+(b)*2+(h))*HT)
  unsigned soff0, soff1;
  { int r_, c_; stage_rc8(tid * 16, r_, c_); soff0 = (unsigned)(r_ * K + c_); stage_rc8(tid * 16 + 8192, r_, c_); soff1 = (unsigned)(r_ * K + c_); }
  #define STAGE8(P,BASE,br,kt) do{ const u16* _gb = (BASE) + ((long)(br)*K+(long)(kt)*BK); \
      __builtin_amdgcn_global_load_lds((const unsigned*)(_gb + soff0), (unsigned*)((char*)(P)+tid*16),16,0,0); \
      __builtin_amdgcn_global_load_lds((const unsigned*)(_gb + soff1), (unsigned*)((char*)(P)+tid*16+8192),16,0,0); }while(0)
  #define LDA8(dst,b,h) _Pragma("unroll") for(int m=0;m<4;++m) _Pragma("unroll") for(int k=0;k<2;++k) \
    dst[m][k]=*reinterpret_cast<const bf16x8*>((const char*)SA8(b,h)+lds_byte8(wr*64+m*16+fr,k*32+fq*8))
  #define LDB8(dst,b,h) _Pragma("unroll") for(int n=0;n<2;++n) _Pragma("unroll") for(int k=0;k<2;++k) \
    dst[n][k]=*reinterpret_cast<const bf16x8*>((const char*)SB8(b,h)+lds_byte8(wc*32+n*16+fr,k*32+fq*8))
  #define MMA8(ai,bj,At_,Bt_) do{__builtin_amdgcn_s_setprio(1); \
    _Pragma("unroll") for(int m=0;m<4;++m) _Pragma("unroll") for(int n=0;n<2;++n) _Pragma("unroll") for(int k=0;k<2;++k) \
      acc[ai][bj][m][n]=__builtin_amdgcn_mfma_f32_16x16x32_bf16(At_[m][k],Bt_[n][k],acc[ai][bj][m][n],0,0,0); \
    __builtin_amdgcn_s_setprio(0);}while(0)
  #define MMA8C(ai,bj,At_,Bt_) do{ if (!KR || ((ai)*128 + wr*64 < nact)) MMA8(ai,bj,At_,Bt_); }while(0)
  #define WAIT_V8(n) asm volatile("s_waitcnt vmcnt(" #n ")":::"memory")
  #define WAIT_L8(n) asm volatile("s_waitcnt lgkmcnt(" #n ")":::"memory")
  #define BAR8 __builtin_amdgcn_s_barrier()
  #define SCHED8 __builtin_amdgcn_sched_barrier(0)
  f32x4v acc[2][2][4][2];
#pragma unroll
  for (int a = 0; a < 2; ++a)
#pragma unroll
    for (int b = 0; b < 2; ++b)
#pragma unroll
      for (int m = 0; m < 4; ++m)
#pragma unroll
        for (int n = 0; n < 2; ++n) acc[a][b][m][n] = f32x4v{0.f, 0.f, 0.f, 0.f};
  {
  const int wid = tid >> 6, lane = tid & 63, wr = wid >> 2, wc = wid & 3, fr = lane & 15, fq = lane >> 4;
  bf16x8 At[4][2], B0[2][2], B1[2][2];
  const int nt = K / BK;
  asm volatile("s_waitcnt lgkmcnt(0)" ::: "memory");
  __builtin_amdgcn_s_barrier();
  STAGE8(SB8(0,0),Bt,0,0); STAGE8(SA8(0,0),A,0,0);
  STAGE8(SB8(0,1),Bt,HALF,0); STAGE8(SA8(0,1),A,HALF,0);
  if (wr == 1) BAR8;
  WAIT_V8(4); BAR8;
  STAGE8(SB8(1,0),Bt,0,1); STAGE8(SA8(1,0),A,0,1); STAGE8(SB8(1,1),Bt,HALF,1);
  WAIT_V8(6); BAR8;
  for (int t = 0; t < nt - 2; t += 2) {
    LDB8(B0,0,0); SCHED8; LDA8(At,0,0); STAGE8(SA8(1,1),A,HALF,t+1);
    WAIT_L8(8); BAR8; WAIT_L8(0); MMA8C(0,0,At,B0); BAR8; SCHED8;
    LDB8(B1,0,1); STAGE8(SB8(0,0),Bt,0,t+2);
    BAR8; WAIT_L8(0); MMA8C(0,1,At,B1); BAR8;
    LDA8(At,0,1); STAGE8(SA8(0,0),A,0,t+2);
    BAR8; WAIT_L8(0); MMA8C(1,0,At,B0); BAR8; SCHED8;
    STAGE8(SB8(0,1),Bt,HALF,t+2);
    WAIT_V8(6); BAR8; MMA8C(1,1,At,B1); BAR8;
    LDB8(B0,1,0); SCHED8; LDA8(At,1,0); STAGE8(SA8(0,1),A,HALF,t+2);
    WAIT_L8(8); BAR8; WAIT_L8(0); MMA8C(0,0,At,B0); BAR8; SCHED8;
    LDB8(B1,1,1); STAGE8(SB8(1,0),Bt,0,t+3);
    BAR8; WAIT_L8(0); MMA8C(0,1,At,B1); BAR8;
    LDA8(At,1,1); STAGE8(SA8(1,0),A,0,t+3);
    BAR8; WAIT_L8(0); MMA8C(1,0,At,B0); BAR8; SCHED8;
    STAGE8(SB8(1,1),Bt,HALF,t+3);
    WAIT_V8(6); BAR8; MMA8C(1,1,At,B1); BAR8;
  }
  { LDB8(B0,0,0); LDA8(At,0,0); STAGE8(SA8(1,1),A,HALF,nt-1);
    BAR8; WAIT_L8(0); MMA8C(0,0,At,B0); BAR8;
    LDB8(B1,0,1); BAR8; WAIT_L8(0); MMA8C(0,1,At,B1); BAR8;
    LDA8(At,0,1); WAIT_V8(4); BAR8; WAIT_L8(0); MMA8C(1,0,At,B0); MMA8C(1,1,At,B1); BAR8; }
  { LDB8(B0,1,0); LDA8(At,1,0); WAIT_V8(2); BAR8; WAIT_L8(0); MMA8C(0,0,At,B0); BAR8;
    LDB8(B1,1,1); WAIT_V8(0); BAR8; WAIT_L8(0); MMA8C(0,1,At,B1); BAR8;
    LDA8(At,1,1); BAR8; WAIT_L8(0); MMA8C(1,0,At,B0); MMA8C(1,1,At,B1); BAR8; }
  if (wr == 0) BAR8;
  }

  const int mode = g.mode;
  unsigned char* wreg;
  int lane, wr, wc, fr, fq;
  { const int t2 = TIDX(); const int w2 = t2 >> 6; lane = t2 & 63; wr = w2 >> 2; wc = w2 & 3; fr = lane & 15; fq = lane >> 4; wreg = smem + w2 * 17408; }
  if (mode == M_RESID) {
#pragma unroll
    for (int bj = 0; bj < 2; ++bj) {
#pragma unroll
      for (int ai = 0; ai < 2; ++ai)
#pragma unroll
        for (int m = 0; m < 4; ++m)
#pragma unroll
          for (int n = 0; n < 2; ++n)
            *(f32x4v*)(wreg + (n * 16 + fr) * 528 + (ai * 64 + m * 16 + fq * 4) * 4) = acc[ai][bj][m][n];
#pragma unroll
      for (int it = 0; it < 16; ++it) {
        const int row = 2 * it + (lane >> 5), c4 = lane & 31;
        const float4 v = *(const float4*)(wreg + row * 528 + c4 * 16);
        const int ai = c4 >> 4, iin = (c4 & 15) * 4;
        const size_t o = (size_t)(g.C0 + bj * 128 + wc * 32 + row) * 2048 + g.R0 + ai * 128 + wr * 64 + iin;
        const float4 x = *(const float4*)(g.xin + o);
        *(float4*)(g.d32 + o) = make_float4(x.x + v.x, x.y + v.y, x.z + v.z, x.w + v.w);
      }
    }
    return;
  }
  if (mode == M_ROPE) {
#pragma unroll
    for (int bj = 0; bj < 2; ++bj)
#pragma unroll
      for (int n = 0; n < 2; ++n) {
        const int tok = g.C0 + bj * 128 + wc * 32 + n * 16 + fr;
        const float sc = g.scale * (g.rs ? g.rs[tok] : 1.f);
#pragma unroll
        for (int ai = 0; ai < 2; ++ai) {
          if (ai * 128 + wr * 64 < g.aux) {
#pragma unroll
            for (int m = 0; m < 2; ++m) {
              const int c0 = m * 16 + fq * 4;
              const float4 cs = *(const float4*)(g.cs + (size_t)tok * 32 + c0);
              const float4 sn = *(const float4*)(g.sn + (size_t)tok * 32 + c0);
              const f32x4v a = acc[ai][bj][m][n] * sc, b = acc[ai][bj][m + 2][n] * sc;
              u32x2 o1, o2;
              o1[0] = pack_bf16(a[0] * cs.x - b[0] * sn.x, a[1] * cs.y - b[1] * sn.y);
              o1[1] = pack_bf16(a[2] * cs.z - b[2] * sn.z, a[3] * cs.w - b[3] * sn.w);
              o2[0] = pack_bf16(b[0] * cs.x + a[0] * sn.x, b[1] * cs.y + a[1] * sn.y);
              o2[1] = pack_bf16(b[2] * cs.z + a[2] * sn.z, b[3] * cs.w + a[3] * sn.w);
              u16* dp = g.d16 + (size_t)tok * g.ld + g.R0 + ai * 128 + wr * 64 + c0;
              *(u32x2*)dp = o1;
              *(u32x2*)(dp + 32) = o2;
            }
          }
        }
      }
    return;
  }
  {
    const int fqp = g.perm ? (((fq & 1) << 1) | (fq >> 1)) : fq;
    unsigned char* wb = wreg + fr * 272 + fqp * 8;
    if (mode == M_BF16) {
#pragma unroll
      for (int bj = 0; bj < 2; ++bj)
#pragma unroll
        for (int n = 0; n < 2; ++n) {
          const int outer = g.C0 + bj * 128 + wc * 32 + n * 16 + fr;
          const float sc = g.scale * (g.rs ? g.rs[outer] : 1.f);
#pragma unroll
          for (int ai = 0; ai < 2; ++ai)
#pragma unroll
            for (int m = 0; m < 4; ++m) {
              const f32x4v v = acc[ai][bj][m][n] * sc;
              u32x2 pk; pk[0] = pack_bf16(v[0], v[1]); pk[1] = pack_bf16(v[2], v[3]);
              *(u32x2*)(wb + (bj * 32 + n * 16) * 272 + (ai * 64 + m * 16) * 2) = pk;
            }
        }
    } else if (mode == M_SILU) {
#pragma unroll
      for (int bj = 0; bj < 2; ++bj)
#pragma unroll
        for (int n = 0; n < 2; ++n)
#pragma unroll
          for (int ai = 0; ai < 2; ++ai)
#pragma unroll
            for (int m = 0; m < 4; ++m) {
              const f32x4v v = acc[ai][bj][m][n];
              u32x2 pk; pk[0] = pack_bf16(silu_f(v[0]), silu_f(v[1])); pk[1] = pack_bf16(silu_f(v[2]), silu_f(v[3]));
              *(u32x2*)(wb + (bj * 32 + n * 16) * 272 + (ai * 64 + m * 16) * 2) = pk;
            }
    } else {
      const float* rsp = g.rs ? g.rs + g.R0 + wr * 64 + fq * 4 : nullptr;
#pragma unroll
      for (int ai = 0; ai < 2; ++ai)
#pragma unroll
        for (int m = 0; m < 4; ++m) {
          float4 r4 = make_float4(1.f, 1.f, 1.f, 1.f);
          if (rsp) r4 = *(const float4*)(rsp + ai * 128 + m * 16);
#pragma unroll
          for (int bj = 0; bj < 2; ++bj)
#pragma unroll
            for (int n = 0; n < 2; ++n) {
              const f32x4v v = acc[ai][bj][m][n];
              u32x2 pk; pk[0] = pack_bf16(v[0] * r4.x, v[1] * r4.y); pk[1] = pack_bf16(v[2] * r4.z, v[3] * r4.w);
              *(u32x2*)(wb + (bj * 32 + n * 16) * 272 + (ai * 64 + m * 16) * 2) = pk;
            }
        }
    }
  }
  {
    const int ch = lane & 15, rsub = lane >> 4, ai = ch >> 3;
    const int outer0 = g.C0 + wc * 32 + rsub;
    const int inner0 = g.R0 + ai * 128 + wr * 64 + (ch & 7) * 8;
    size_t obase, ostride;
    if (mode == M_TRANS) { obase = ((size_t)(inner0 >> 13) * g.aux + outer0) * 8192 + (inner0 & 8191); ostride = 8192; }
    else { obase = (size_t)outer0 * g.ld + inner0; ostride = (size_t)g.ld; }
    const unsigned char* rb = wreg + rsub * 272 + ch * 16;
    u16* dp = g.d16 + obase;
#pragma unroll
    for (int it = 0; it < 16; ++it) {
      const u32x4 v = *(const u32x4*)(rb + it * 4 * 272);
      *(u32x4*)(dp + (size_t)((it >> 3) * 128 + (it & 7) * 4) * ostride) = v;
    }
  }
}

template <int DK, bool SB, int LDQN, int LDQR, int LDKN, int LDKR, int LDG>
DI void attn_item(const u16* __restrict__ Qn, const u16* __restrict__ Qr,
                  const u16* __restrict__ Kn, const u16* __restrict__ Kr,
                  const u16* __restrict__ Vt, const u16* __restrict__ Gt,
                  u16* __restrict__ Y, int q0, unsigned char* smem, int probe = 0) {
  constexpr int KS = DK / 16;
  constexpr int KROW_B = DK * 2;
  constexpr int KCH = DK / 8;
  constexpr int K_B = 64 * KROW_B;
  constexpr int STAGE_B = K_B + 128 * 128;
  constexpr int NKI = K_B / 8192;
  constexpr int G = NKI + 2;
  volatile __attribute__((address_space(3))) int* sflag = (volatile __attribute__((address_space(3))) int*)(smem + 3 * STAGE_B);
  const int tid = TIDX(), lane = tid & 63, wave = tid >> 6;
  const int r = lane & 31, h = lane >> 5;
  const int qrow = q0 + 32 * wave + r;
  const int qmin = q0 + 32 * wave, qmax = qmin + 31;

  bf16x8 bq[KS];
  {
    const u16* qp = Qn + (unsigned)(qrow * LDQN + 8 * h);
#pragma unroll
    for (int ks = 0; ks < 8; ++ks) bq[ks] = *(const bf16x8*)(qp + 16 * ks);
    if constexpr (!SB) {
      const u16* qp2 = Qr + (unsigned)(qrow * LDQR + 8 * h);
#pragma unroll
      for (int ks = 8; ks < KS; ++ks) bq[ks] = *(const bf16x8*)(qp2 + 16 * (ks - 8));
    }
  }
  f32x16 O[4];
#pragma unroll
  for (int d = 0; d < 4; ++d)
#pragma unroll
    for (int q = 0; q < 16; ++q) O[d][q] = 0.f;
  float m_run = -INFINITY, l_run = 0.f, R = 0.f;
  const int nt = (q0 >> 6) + 4;

  const u16* kbase[NKI]; unsigned isr = 0u; unsigned voff0;
#pragma unroll
  for (int j = 0; j < NKI; ++j) {
    const int L = 64 * (wave + 8 * j) + lane, row = L / KCH, p = L - row * KCH;
    const int c = SB ? (p ^ (row & 15)) : ((p & ~7) | ((p & 7) ^ ((row >> 1) & 7)));
    if (SB || c < 16) { kbase[j] = Kn + (unsigned)(row * LDKN + c * 8); }
    else { kbase[j] = Kr + (unsigned)(row * LDKR + (c - 16) * 8); isr |= 1u << j; }
  }
  {
    const int L = 64 * wave + lane, row = L >> 3, p = L & 7;
    voff0 = (unsigned)(row * 8192 + (p ^ ((row >> 1) & 7)) * 8);
  }
  auto issue_tile = [&](int kt, int st) {
    unsigned char* sKb = smem + st * STAGE_B;
#pragma unroll
    for (int j = 0; j < NKI; ++j) {
      const unsigned kstr = ((isr >> j) & 1u) ? 64u * LDKR : 64u * LDKN;
      __builtin_amdgcn_global_load_lds((const unsigned*)(kbase[j] + (size_t)kt * kstr),
                                       (unsigned*)(sKb + (wave + 8 * j) * 1024), 16, 0, 0);
    }
    const u16* vb_ = Vt + kt * 64;
#pragma unroll
    for (int j = 0; j < 2; ++j)
      __builtin_amdgcn_global_load_lds((const unsigned*)(vb_ + (size_t)j * 64 * 8192 + voff0),
                                       (unsigned*)(sKb + K_B + (wave + 8 * j) * 1024), 16, 0, 0);
  };
  const int s3 = (r >> 1) & 7, s4 = r & 15;

  asm volatile("s_waitcnt vmcnt(0)" ::: "memory");
  __syncthreads();
  issue_tile(SB ? nt - 1 : 0, 0);
  issue_tile(SB ? nt - 2 : 1, 1);
  asm volatile("s_waitcnt vmcnt(%0)" :: "n"(G) : "memory");
  asm volatile("s_waitcnt lgkmcnt(0)" ::: "memory");
  __builtin_amdgcn_s_barrier();
  auto tile_body = [&](int it, auto st_c) -> bool {
    constexpr int ST = decltype(st_c)::value;
    const int kt = SB ? (nt - 1 - it) : it;
    if (it + 2 < nt && !(PROBE_MODE == 3 && probe)) issue_tile(SB ? (nt - 3 - it) : (it + 2), (ST + 2) % 3);
    __builtin_amdgcn_sched_barrier(0);
    const unsigned char* sK = smem + ST * STAGE_B;
    const unsigned char* sV = sK + K_B;
    auto kchunk = [&](int ks) -> int {
      const int c = 2 * ks + h;
      return (SB ? (c ^ s4) : ((c & ~7) | ((c & 7) ^ s3))) * 16;
    };
    const int kbA = SB ? 1 : 0, kbB = SB ? 0 : 1;
    const int keyA = kt * 64 + 32 * kbA, keyB = kt * 64 + 32 * kbB;
    const bool skipA = SB ? (keyA >= qmax) : (keyA > qmax);
    const bool skipB = SB ? (keyB >= qmax) : (keyB > qmax);
    f32x16 SA_, SB_;
    {
      bf16x8 kf[KS];
      if (!skipA) {
        const unsigned char* kp = sK + (32 * kbA + r) * KROW_B;
#pragma unroll
        for (int ks = 0; ks < KS; ++ks) kf[ks] = *(const bf16x8*)(kp + kchunk(ks));
#pragma unroll
        for (int q = 0; q < 16; ++q) SA_[q] = 0.f;
        __builtin_amdgcn_sched_barrier(0);
#pragma unroll
        for (int ks = 0; ks < KS; ++ks) SA_ = MFMA32(kf[ks], bq[ks], SA_);
        __builtin_amdgcn_sched_barrier(0);
      }
      if (!skipB) {
        const unsigned char* kp = sK + (32 * kbB + r) * KROW_B;
#pragma unroll
        for (int ks = 0; ks < KS; ++ks) kf[ks] = *(const bf16x8*)(kp + kchunk(ks));
#pragma unroll
        for (int q = 0; q < 16; ++q) SB_[q] = 0.f;
        __builtin_amdgcn_sched_barrier(0);
#pragma unroll
        for (int ks = 0; ks < KS; ++ks) SB_ = MFMA32(kf[ks], bq[ks], SB_);
        __builtin_amdgcn_sched_barrier(0);
      }
    }
    auto math_pv = [&](f32x16& Sx, const int kb, const int key0) {
      bf16x8 vf[8];
#pragma unroll
      for (int d = 0; d < 4; ++d) vf[d] = *(const bf16x8*)(sV + (32 * d + r) * 128 + (((4 * kb + h) ^ s3) * 16));
      __builtin_amdgcn_sched_barrier(0);
      if constexpr (!SB) {
       if (!(PROBE_MODE == 4 && probe)) {
        if (key0 + 31 > qmin) {
#pragma unroll
          for (int q = 0; q < 16; ++q)
            if (key0 + crow(q, h) > qrow) Sx[q] = -INFINITY;
        }
        float mloc = Sx[0];
#pragma unroll
        for (int q = 1; q < 16; ++q) mloc = fmaxf(mloc, Sx[q]);
        mloc = xh_max(mloc);
        float mnew = m_run, alpha = 1.f;
        const bool need = __builtin_amdgcn_ballot_w64(mloc > m_run + 8.f) != 0ull;
        if (need) {
          mnew = fmaxf(m_run, mloc);
          alpha = __builtin_amdgcn_exp2f(m_run - mnew);
          m_run = mnew;
        }
        typedef float f32x2v __attribute__((ext_vector_type(2)));
        const f32x2v mm = {mnew, mnew};
        f32x2v ls2 = {0.f, 0.f};
#pragma unroll
        for (int q = 0; q < 8; ++q) {
          f32x2v t = {Sx[2 * q], Sx[2 * q + 1]};
          t = t - mm;
          t[0] = __builtin_amdgcn_exp2f(t[0]);
          t[1] = __builtin_amdgcn_exp2f(t[1]);
          Sx[2 * q] = t[0]; Sx[2 * q + 1] = t[1];
          ls2 = ls2 + t;
        }
        const float lsum = ls2[0] + ls2[1];
        l_run = l_run * alpha + lsum;
        if (need) {
#pragma unroll
          for (int d = 0; d < 4; ++d)
#pragma unroll
            for (int q = 0; q < 16; ++q) O[d][q] *= alpha;
        }
       }
      } else {
        f32x16 Lx;
        float gs[4], ps[4];
        if (key0 + 31 < qmin) {
#pragma unroll
          for (int q = 0; q < 16; ++q) {
            const float z0 = Sx[q];
            Lx[q] = -(fmaxf(z0, 0.f) + __builtin_amdgcn_logf(1.f + __builtin_amdgcn_exp2f(-fabsf(z0))));
          }
#pragma unroll
          for (int gq = 0; gq < 4; ++gq) {
            gs[gq] = (Lx[4 * gq] + Lx[4 * gq + 1]) + (Lx[4 * gq + 2] + Lx[4 * gq + 3]);
            ps[gq] = xh_partner(gs[gq], h);
          }
          float run = 0.f;
#pragma unroll
          for (int gq = 3; gq >= 0; --gq) {
            const float own = R + run + (h == 0 ? ps[gq] : 0.f);
            run += gs[gq] + ps[gq];
            const float a3 = own, a2 = a3 + Lx[4 * gq + 3], a1 = a2 + Lx[4 * gq + 2], a0 = a1 + Lx[4 * gq + 1];
            Sx[4 * gq + 0] = __builtin_amdgcn_exp2f(Sx[4 * gq + 0] + Lx[4 * gq + 0] + a0);
            Sx[4 * gq + 1] = __builtin_amdgcn_exp2f(Sx[4 * gq + 1] + Lx[4 * gq + 1] + a1);
            Sx[4 * gq + 2] = __builtin_amdgcn_exp2f(Sx[4 * gq + 2] + Lx[4 * gq + 2] + a2);
            Sx[4 * gq + 3] = __builtin_amdgcn_exp2f(Sx[4 * gq + 3] + Lx[4 * gq + 3] + a3);
          }
          R += run;
        } else {
#pragma unroll
          for (int q = 0; q < 16; ++q) {
            const float z0 = Sx[q];
            const float sp0 = fmaxf(z0, 0.f) + __builtin_amdgcn_logf(1.f + __builtin_amdgcn_exp2f(-fabsf(z0)));
            Lx[q] = (key0 + crow(q, h) < qrow) ? -sp0 : 0.f;
          }
#pragma unroll
          for (int gq = 0; gq < 4; ++gq) {
            gs[gq] = (Lx[4 * gq] + Lx[4 * gq + 1]) + (Lx[4 * gq + 2] + Lx[4 * gq + 3]);
            ps[gq] = xh_partner(gs[gq], h);
          }
          float run = 0.f;
#pragma unroll
          for (int gq = 3; gq >= 0; --gq) {
            const float own = R + run + (h == 0 ? ps[gq] : 0.f);
            run += gs[gq] + ps[gq];
            const int key = key0 + 8 * gq + 4 * h;
            const float a3 = own, a2 = a3 + Lx[4 * gq + 3], a1 = a2 + Lx[4 * gq + 2], a0 = a1 + Lx[4 * gq + 1];
            const float e0 = __builtin_amdgcn_exp2f(Sx[4 * gq + 0] + Lx[4 * gq + 0] + a0);
            const float e1 = __builtin_amdgcn_exp2f(Sx[4 * gq + 1] + Lx[4 * gq + 1] + a1);
            const float e2 = __builtin_amdgcn_exp2f(Sx[4 * gq + 2] + Lx[4 * gq + 2] + a2);
            const float e3 = __builtin_amdgcn_exp2f(Sx[4 * gq + 3] + Lx[4 * gq + 3] + a3);
            Sx[4 * gq + 0] = (key + 0 < qrow) ? e0 : 0.f;
            Sx[4 * gq + 1] = (key + 1 < qrow) ? e1 : 0.f;
            Sx[4 * gq + 2] = (key + 2 < qrow) ? e2 : 0.f;
            Sx[4 * gq + 3] = (key + 3 < qrow) ? e3 : 0.f;
          }
          R += run;
        }
      }
      const bf16x8 pf0 = pack8(Sx, 0), pf1 = pack8(Sx, 1);
      __builtin_amdgcn_sched_barrier(0);
#pragma unroll
      for (int d = 0; d < 4; ++d) vf[4 + d] = *(const bf16x8*)(sV + (32 * d + r) * 128 + (((4 * kb + 2 + h) ^ s3) * 16));
#pragma unroll
      for (int d = 0; d < 4; ++d) O[d] = MFMA32(vf[d], pf0, O[d]);
      __builtin_amdgcn_sched_barrier(0);
#pragma unroll
      for (int d = 0; d < 4; ++d) O[d] = MFMA32(vf[4 + d], pf1, O[d]);
      __builtin_amdgcn_sched_barrier(0);
    };
    if (!skipA) math_pv(SA_, kbA, keyA);
    if (!skipB) math_pv(SB_, kbB, keyB);
    if constexpr (SB) {
      const bool done = (__builtin_amdgcn_ballot_w64(!(R < -150.1f)) == 0ull);
      if (lane == 0) sflag[(it & 1) * 8 + wave] = done ? 1 : 0;
    }
    if (it + 2 < nt) asm volatile("s_waitcnt vmcnt(%0)" :: "n"(G) : "memory");
    else asm volatile("s_waitcnt vmcnt(0)" ::: "memory");
    asm volatile("s_waitcnt lgkmcnt(0)" ::: "memory");
    __builtin_amdgcn_s_barrier();
    if constexpr (SB) {
      const volatile __attribute__((address_space(3))) int* f = sflag + (it & 1) * 8;
      if (f[0] & f[1] & f[2] & f[3] & f[4] & f[5] & f[6] & f[7]) return true;
    }
    return false;
  };
  for (int it = 0; it < nt; it += 3) {
    if (tile_body(it, std::integral_constant<int, 0>{})) break;
    if (it + 1 >= nt) break;
    if (tile_body(it + 1, std::integral_constant<int, 1>{})) break;
    if (it + 2 >= nt) break;
    if (tile_body(it + 2, std::integral_constant<int, 2>{})) break;
  }

  if (PROBE_MODE >= 3 && probe) {
    float sacc = l_run;
#pragma unroll
    for (int d = 0; d < 4; ++d)
#pragma unroll
      for (int q = 0; q < 16; ++q) sacc += O[d][q];
    if (sacc == 1.2345e-30f) Y[0] = 0;
    return;
  }
  float inv = 1.f;
  if constexpr (!SB) {
    const float lt = xh_sum(l_run);
    inv = 1.f / lt;
  }
  const u16* gp16 = Gt + (unsigned)(qrow * LDG + 8 * h);
  u16* yp = Y + (unsigned)(qrow * 2048 + 8 * h);
#pragma unroll
  for (int d = 0; d < 4; ++d)
#pragma unroll
    for (int pq = 0; pq < 2; ++pq) {
      u32x2 oa, ob;
      const u32x4 g16 = *(const u32x4*)(gp16 + 32 * d + 16 * pq);
      const auto s0 = __builtin_amdgcn_permlane32_swap(g16[0], g16[2], false, false);
      const auto s1 = __builtin_amdgcn_permlane32_swap(g16[1], g16[3], false, false);
      {
        const int gq = 2 * pq;
        oa[0] = pack_bf16(O[d][4 * gq + 0] * inv * bf_lo(s0[0]), O[d][4 * gq + 1] * inv * bf_hi(s0[0]));
        oa[1] = pack_bf16(O[d][4 * gq + 2] * inv * bf_lo(s1[0]), O[d][4 * gq + 3] * inv * bf_hi(s1[0]));
      }
      {
        const int gq = 2 * pq + 1;
        ob[0] = pack_bf16(O[d][4 * gq + 0] * inv * bf_lo(s0[1]), O[d][4 * gq + 1] * inv * bf_hi(s0[1]));
        ob[1] = pack_bf16(O[d][4 * gq + 2] * inv * bf_lo(s1[1]), O[d][4 * gq + 3] * inv * bf_hi(s1[1]));
      }
      const auto r0 = __builtin_amdgcn_permlane32_swap(oa[0], ob[0], false, false);
      const auto r1 = __builtin_amdgcn_permlane32_swap(oa[1], ob[1], false, false);
      u32x4 st; st[0] = r0[0]; st[1] = r1[0]; st[2] = r0[1]; st[3] = r1[1];
      *(u32x4*)(yp + 32 * d + 16 * pq) = st;
    }
}

DI void gla_g1(const Params& p, int li, int unit, unsigned char* smem) {
  const int c = unit & 127, bh = unit >> 7, b = bh >> 2, hh = bh & 3;
  const size_t m0 = (size_t)b * S_ + c * 64;
  float* lf = (float*)smem;
  u16* klT = (u16*)(smem + 32768);
  const float* GA = (const float*)(p.ws + E_GA);
  u16* GQ = (u16*)(p.ws + E_GQ);
  u16* GK = (u16*)(p.ws + E_GK);
  const u16* GVT = (const u16*)(p.ws + E_GVT);
  float* EBL = (float*)(p.ws + E_EBL);
  float* SC = (float*)(p.ws + E_SC);
  const float* au_p = p.alpha_up + (size_t)li * 16 * 512;
  const float* bias_p = p.alpha_bias + (size_t)li * 512;
  const int tid = TIDX(), lane = tid & 63, wave = tid >> 6;
  const int r = lane & 31, h = lane >> 5;
  {
    const int d = tid & 127, th = tid >> 7;
    float au[16];
#pragma unroll
    for (int q = 0; q < 16; ++q) au[q] = au_p[q * 512 + hh * 128 + d];
    const float bs = bias_p[hh * 128 + d];
    for (int tt = 0; tt < 16; ++tt) {
      const int t = th * 16 + tt;
      const float4* ga = (const float4*)(GA + (m0 + t) * 16);
      float s = bs;
#pragma unroll
      for (int q = 0; q < 4; ++q) {
        const float4 g4 = ga[q];
        s += g4.x * au[4 * q] + g4.y * au[4 * q + 1] + g4.z * au[4 * q + 2] + g4.w * au[4 * q + 3];
      }
      const float sp = fmaxf(-s, 0.f) + __logf(1.f + __expf(-fabsf(s)));
      lf[t * 128 + d] = -sp * (1.f / 16.f);
    }
  }
  __syncthreads();
  {
    const int d = tid & 127, sg = tid >> 7;
    float run = 0.f;
#pragma unroll
    for (int t = 0; t < 16; ++t) { run += lf[(sg * 16 + t) * 128 + d]; lf[(sg * 16 + t) * 128 + d] = run; }
    __syncthreads();
    float off = 0.f;
    if (sg > 0) off += lf[15 * 128 + d];
    if (sg > 1) off += lf[31 * 128 + d];
    if (sg > 2) off += lf[47 * 128 + d];
    __syncthreads();
    if (sg > 0) {
#pragma unroll
      for (int t = 0; t < 16; ++t) lf[(sg * 16 + t) * 128 + d] += off;
    }
  }
  __syncthreads();
#pragma unroll 1
  for (int i = 0; i < 2; ++i) {
    const int idx = tid + 512 * i;
    const int t = idx >> 4, d0 = (idx & 15) * 8;
    u16* qp = GQ + (m0 + t) * 512 + hh * 128 + d0;
    u16* kp = GK + (m0 + t) * 512 + hh * 128 + d0;
    const u32x4 qv = *(const u32x4*)qp;
    const u32x4 kv = *(const u32x4*)kp;
    u32x4 qo, ko;
#pragma unroll
    for (int jj = 0; jj < 4; ++jj) {
      const float bb0 = lf[t * 128 + d0 + 2 * jj], bb1 = lf[t * 128 + d0 + 2 * jj + 1];
      const float bl0 = lf[63 * 128 + d0 + 2 * jj], bl1 = lf[63 * 128 + d0 + 2 * jj + 1];
      const float q0 = bf_lo(qv[jj]), q1 = bf_hi(qv[jj]);
      const float k0 = bf_lo(kv[jj]), k1 = bf_hi(kv[jj]);
      qo[jj] = pack_bf16(q0 * 0.08838834764831845f * __expf(bb0), q1 * 0.08838834764831845f * __expf(bb1));
      ko[jj] = pack_bf16(k0 * __expf(-bb0), k1 * __expf(-bb1));
      klT[(d0 + 2 * jj) * 72 + t] = to_bf16(k0 * __expf(bl0 - bb0));
      klT[(d0 + 2 * jj + 1) * 72 + t] = to_bf16(k1 * __expf(bl1 - bb1));
    }
    *(u32x4*)qp = qo;
    *(u32x4*)kp = ko;
  }
  if (tid < 128) EBL[(size_t)unit * 128 + tid] = __expf(lf[63 * 128 + tid]);
  __syncthreads();
  {
    f32x16 acc[4];
#pragma unroll
    for (int j = 0; j < 4; ++j)
#pragma unroll
      for (int q = 0; q < 16; ++q) acc[j][q] = 0.f;
    const u16* vp = GVT + ((size_t)(bh * 256 + 32 * wave + r)) * 8192 + c * 64 + 8 * h;
#pragma unroll
    for (int ks = 0; ks < 4; ++ks) {
      const bf16x8 bv = *(const bf16x8*)(vp + 16 * ks);
#pragma unroll
      for (int db = 0; db < 4; ++db) {
        const bf16x8 ak = *(const bf16x8*)(klT + (32 * db + r) * 72 + 16 * ks + 8 * h);
        acc[db] = MFMA32(ak, bv, acc[db]);
      }
    }
    u16* SC16 = (u16*)SC;
    u16* sp = SC16 + ((size_t)unit * 256 + 32 * wave + r) * 128 + 4 * h;
#pragma unroll
    for (int db = 0; db < 4; ++db)
#pragma unroll
      for (int g4 = 0; g4 < 4; ++g4) {
        u32x2 pk;
        pk[0] = pack_bf16(acc[db][4 * g4 + 0], acc[db][4 * g4 + 1]);
        pk[1] = pack_bf16(acc[db][4 * g4 + 2], acc[db][4 * g4 + 3]);
        *(u32x2*)(sp + 32 * db + 8 * g4) = pk;
      }
  }
  __syncthreads();
}

DI void gla_scan(const Params& p) {
  u16* SC16 = (u16*)(p.ws + E_SC);
  const float* EBL = (const float*)(p.ws + E_EBL);
  for (int cp = blockIdx.x * 512 + TIDX(); cp < 131072; cp += gridDim.x * 512) {
    const int bh = cp >> 14, rem = cp & 16383, e = rem >> 6, d2 = (rem & 63) * 2;
    u16* base = SC16 + ((size_t)(bh * 128) * 256 + e) * 128 + d2;
    const float* eb = EBL + (size_t)(bh * 128) * 128 + d2;
    float sx = 0.f, sy = 0.f;
#pragma unroll 8
    for (int c = 0; c < 128; ++c) {
      const unsigned sv = *(const unsigned*)(base + (size_t)c * 32768);
      const float2 f = *(const float2*)(eb + c * 128);
      *(unsigned*)(base + (size_t)c * 32768) = pack_bf16(sx, sy);
      sx = f.x * sx + bf_lo(sv);
      sy = f.y * sy + bf_hi(sv);
    }
  }
}

DI void gla_g3(const Params& p, int li, int unit, unsigned char* smem) {
  const int c = unit & 127, bh = unit >> 7, b = bh >> 2, hh = bh & 3;
  const size_t m0 = (size_t)b * S_ + c * 64;
  float* red = (float*)smem;
  const u16* GQ = (const u16*)(p.ws + E_GQ);
  const u16* GK = (const u16*)(p.ws + E_GK);
  const u16* GVT = (const u16*)(p.ws + E_GVT);
  const u16* GG = (const u16*)(p.ws + E_GG);
  const float* SC = (const float*)(p.ws + E_SC);
  u16* Y = (u16*)(p.ws + OFF_H);
  const float* gn = p.gla_norm + (size_t)li * 256;
  const int tid = TIDX(), lane = tid & 63, wave = tid >> 6;
  const int r = lane & 31, h = lane >> 5;

  bf16x8 bq[2][8];
#pragma unroll
  for (int ib = 0; ib < 2; ++ib)
#pragma unroll
    for (int ks = 0; ks < 8; ++ks)
      bq[ib][ks] = *(const bf16x8*)(GQ + (m0 + 32 * ib + r) * 512 + hh * 128 + 16 * ks + 8 * h);
  f32x16 X00, X01, X11;
#pragma unroll
  for (int q = 0; q < 16; ++q) { X00[q] = 0.f; X01[q] = 0.f; X11[q] = 0.f; }
#pragma unroll
  for (int ks = 0; ks < 8; ++ks) {
    const bf16x8 a0 = *(const bf16x8*)(GK + (m0 + r) * 512 + hh * 128 + 16 * ks + 8 * h);
    const bf16x8 a1 = *(const bf16x8*)(GK + (m0 + 32 + r) * 512 + hh * 128 + 16 * ks + 8 * h);
    X00 = MFMA32(a0, bq[0][ks], X00);
    X01 = MFMA32(a0, bq[1][ks], X01);
    X11 = MFMA32(a1, bq[1][ks], X11);
  }
#pragma unroll
  for (int q = 0; q < 16; ++q) {
    if (crow(q, h) > r) { X00[q] = 0.f; X11[q] = 0.f; }
  }
  f32x16 acc[2];
#pragma unroll
  for (int j = 0; j < 2; ++j)
#pragma unroll
    for (int q = 0; q < 16; ++q) acc[j][q] = 0.f;
  {
    const u16* st = (const u16*)SC + ((size_t)unit * 256 + 32 * wave + r) * 128 + 8 * h;
#pragma unroll
    for (int ks = 0; ks < 8; ++ks) {
      const bf16x8 a = *(const bf16x8*)(st + 16 * ks);
      acc[0] = MFMA32(a, bq[0][ks], acc[0]);
      acc[1] = MFMA32(a, bq[1][ks], acc[1]);
    }
  }
  {
    const u16* vr = GVT + ((size_t)(bh * 256 + 32 * wave + r)) * 8192 + c * 64;
#pragma unroll
    for (int s = 0; s < 2; ++s) {
      const bf16x8 pf00 = pack8(X00, s), pf01 = pack8(X01, s), pf11 = pack8(X11, s);
      {
        const s16x4 lo = *(const s16x4*)(vr + 16 * s + 4 * h);
        const s16x4 hi = *(const s16x4*)(vr + 16 * s + 8 + 4 * h);
        const bf16x8 a = __builtin_shufflevector(lo, hi, 0, 1, 2, 3, 4, 5, 6, 7);
        acc[0] = MFMA32(a, pf00, acc[0]);
        acc[1] = MFMA32(a, pf01, acc[1]);
      }
      {
        const s16x4 lo = *(const s16x4*)(vr + 32 + 16 * s + 4 * h);
        const s16x4 hi = *(const s16x4*)(vr + 32 + 16 * s + 8 + 4 * h);
        const bf16x8 a = __builtin_shufflevector(lo, hi, 0, 1, 2, 3, 4, 5, 6, 7);
        acc[1] = MFMA32(a, pf11, acc[1]);
      }
    }
  }
  float rstd[2];
#pragma unroll
  for (int ib = 0; ib < 2; ++ib) {
    float ss = 0.f;
#pragma unroll
    for (int q = 0; q < 16; ++q) ss += acc[ib][q] * acc[ib][q];
    ss = xh_sum(ss);
    if (h == 0) red[wave * 64 + 32 * ib + r] = ss;
  }
  __syncthreads();
#pragma unroll
  for (int ib = 0; ib < 2; ++ib) {
    float tot = 0.f;
#pragma unroll
    for (int w = 0; w < 8; ++w) tot += red[w * 64 + 32 * ib + r];
    rstd[ib] = rsqrtf(tot * (1.f / 256.f) + 1e-6f);
  }
#pragma unroll
  for (int ib = 0; ib < 2; ++ib)
#pragma unroll
    for (int gq = 0; gq < 4; ++gq) {
      const int e = 32 * wave + 8 * gq + 4 * h;
      const size_t m = m0 + 32 * ib + r;
      const u32x2 gt = *(const u32x2*)(GG + m * 1024 + hh * 256 + e);
      const float4 g4 = *(const float4*)(gn + e);
      const float rs = rstd[ib];
      u32x2 o;
      o[0] = pack_bf16(acc[ib][4 * gq + 0] * rs * g4.x * bf_lo(gt[0]), acc[ib][4 * gq + 1] * rs * g4.y * bf_hi(gt[0]));
      o[1] = pack_bf16(acc[ib][4 * gq + 2] * rs * g4.z * bf_lo(gt[1]), acc[ib][4 * gq + 3] * rs * g4.w * bf_hi(gt[1]));
      *(u32x2*)(Y + m * 2048 + 1024 + hh * 256 + e) = o;
    }
  __syncthreads();
}

__device__ const double kInvFreq[32] = {1.0, 0.7498942093324559, 0.5623413251903491, 0.4216965034285822, 0.31622776601683794, 0.23713737056616552, 0.1778279410038923, 0.1333521432163324, 0.1, 0.07498942093324558, 0.05623413251903491, 0.042169650342858224, 0.03162277660168379, 0.023713737056616554, 0.01778279410038923, 0.01333521432163324, 0.01, 0.007498942093324558, 0.005623413251903491, 0.004216965034285823, 0.0031622776601683794, 0.0023713737056616554, 0.0017782794100389228, 0.001333521432163324, 0.001, 0.0007498942093324559, 0.0005623413251903491, 0.00042169650342858224, 0.00031622776601683794, 0.00023713737056616554, 0.00017782794100389227, 0.0001333521432163324};

#define XB_TMO      128
#define XB_XCNT(j)  (256  + 64 * (j))
#define XB_XSUB(j)  (1280 + 64 * (j))
#define XB_XGEN(j)  (2304 + 64 * (j))
#define XB_TOP      3328
#define XB_TOPGEN   3392
#define XCD_BAR_WORDS 3456
#define XB_SPIN_CAP (1u << 20)
#define LAS __attribute__((address_space(3)))
DI unsigned xb_ld(unsigned* p)              { return __hip_atomic_load(p, __ATOMIC_RELAXED, __HIP_MEMORY_SCOPE_AGENT); }
DI unsigned xb_add(unsigned* p, unsigned v) { return __hip_atomic_fetch_add(p, v, __ATOMIC_RELAXED, __HIP_MEMORY_SCOPE_AGENT); }
DI unsigned xb_xcc_id() { return (unsigned)__builtin_amdgcn_s_getreg((3 << 11) | 20) & 0xFu; }
#define XB_SPIN(cond, bar) do { unsigned _sp = 0; while (cond) { __builtin_amdgcn_s_sleep(1); \
    if ((++_sp & 255u) == 0u) { if (xb_ld(&(bar)[XB_TMO])) break; if (_sp > XB_SPIN_CAP) { atomicAdd(&(bar)[XB_TMO], 1u); break; } } } } while (0)
struct XcdBarrier { unsigned* bar; unsigned x; volatile LAS unsigned* st; };
DI XcdBarrier xcd_barrier_post(unsigned* bar, volatile LAS unsigned* st) {
  XcdBarrier b; b.bar = bar; b.x = xb_xcc_id(); b.st = st;
  if (__builtin_amdgcn_workitem_id_x() == 0) (void)xb_add(&bar[XB_XCNT(b.x)], 1u);
  return b;
}
DI void xcd_barrier_complete(unsigned* bar, unsigned x, unsigned& nloc, unsigned& nx) {
  const unsigned G = gridDim.x * gridDim.y * gridDim.z;
  unsigned sum, cnt, mine, sp = 0u;
  for (;;) {
    sum = 0u; cnt = 0u; mine = 0u;
#pragma unroll
    for (unsigned j = 0; j < 16; ++j) { const unsigned c = xb_ld(&bar[XB_XCNT(j)]); sum += c; cnt += (c > 0u) ? 1u : 0u; mine = (j == x) ? c : mine; }
    if (sum == G) break;
    __builtin_amdgcn_s_sleep(1);
    if ((++sp & 255u) == 0u) { if (xb_ld(&bar[XB_TMO])) break; if (sp > XB_SPIN_CAP) { atomicAdd(&bar[XB_TMO], 1u); break; } }
  }
  nloc = mine > 0u ? mine : 1u; nx = cnt > 0u ? cnt : 1u;
}
DI void xcd_barrier(const XcdBarrier& b) {
  asm volatile("s_waitcnt vmcnt(0)" ::: "memory");
  __syncthreads();
  if (__builtin_amdgcn_workitem_id_x() == 0) {
    unsigned* bar = b.bar;
    __builtin_amdgcn_s_waitcnt(0);
    unsigned nloc = b.st[0], nx = b.st[1];
    if (nloc == 0u) { xcd_barrier_complete(bar, b.x, nloc, nx); b.st[0] = nloc; b.st[1] = nx; }
    const unsigned old = xb_add(&bar[XB_XSUB(b.x)], 1u);
    const unsigned gen = old / nloc;
    if (old + 1u == (gen + 1u) * nloc) {
      __builtin_amdgcn_fence(__ATOMIC_RELEASE, "agent");
      asm volatile("s_waitcnt vmcnt(0)" ::: "memory");
      const unsigned og = xb_add(&bar[XB_TOP], 1u);
      const unsigned tg = og / nx;
      if (og + 1u == (tg + 1u) * nx) xb_add(&bar[XB_TOPGEN], 1u);
      else XB_SPIN(xb_ld(&bar[XB_TOPGEN]) == tg, bar);
      __builtin_amdgcn_fence(__ATOMIC_ACQUIRE, "agent");
      xb_add(&bar[XB_XGEN(b.x)], 1u);
      asm volatile("s_waitcnt vmcnt(0)" ::: "memory");
    } else {
      XB_SPIN(xb_ld(&bar[XB_XGEN(b.x)]) == gen, bar);
      __builtin_amdgcn_fence(__ATOMIC_ACQUIRE, "agent");
      asm volatile("s_waitcnt vmcnt(0)" ::: "memory");
    }
  }
  __syncthreads();
}

constexpr int WG_LD = 2052;

DI GemmT gt_init(int K) {
  GemmT g;
  g.A = nullptr; g.B = nullptr; g.K = K; g.lda = K; g.ldb = K;
  g.mode = M_BF16; g.R0 = 0; g.C0 = 0; g.ld = 0; g.aux = 0; g.nact = 256; g.probe = 0; g.perm = 0;
  g.d16 = nullptr; g.d32 = nullptr; g.scale = 1.f; g.rs = nullptr; g.xin = nullptr; g.cs = nullptr; g.sn = nullptr;
  return g;
}

DI void tile_map(int t, int TN, int& tm, int& tn) {
  const int b = t & 255, k = t >> 8;
  const int x = b & 7, j = b >> 3;
  const int G = k * 8 + x;
  const int gpr = TN >> 2;
  const int gm = G / gpr, gn = G - gm * gpr;
  tm = gm * 8 + (j >> 2); tn = gn * 4 + (j & 3);
}

DI void phase_prep(const Params& p, int L, unsigned char* smem) {
  const bool even = (L & 1) == 0;
  const int li = L >> 1;
  u16* WL = (u16*)(p.ws + OFF_WL);
  float* lds = (float*)smem;
  if (L == 0) {
    float* cs = (float*)(p.ws + OFF_COS);
    float* sn = (float*)(p.ws + OFF_SIN);
    for (int i = blockIdx.x * 512 + TIDX(); i < T_ * 32; i += gridDim.x * 512) {
      const int m = i >> 5, f = i & 31;
      const double ang = (double)p.pos[m] * kInvFreq[f];
      const double t = ang * 0.63661977236758134308;
      const double kq = rint(t);
      const double rr = (t - kq) * 1.57079632679489661923;
      const int qd = (int)((long long)kq & 3);
      const double r2 = rr * rr;
      const double sr = rr * (1.0 - r2 / 6.0 * (1.0 - r2 / 20.0 * (1.0 - r2 / 42.0 * (1.0 - r2 / 72.0 * (1.0 - r2 / 110.0 * (1.0 - r2 / 156.0))))));
      const double cr = 1.0 - r2 / 2.0 * (1.0 - r2 / 12.0 * (1.0 - r2 / 30.0 * (1.0 - r2 / 56.0 * (1.0 - r2 / 90.0 * (1.0 - r2 / 132.0 * (1.0 - r2 / 182.0))))));
      const double cc = (qd == 0) ? cr : (qd == 1) ? -sr : (qd == 2) ? -cr : sr;
      const double sv = (qd == 0) ? sr : (qd == 1) ? cr : (qd == 2) ? -sr : -cr;
      cs[i] = (float)cc;
      sn[i] = (float)sv;
    }
  }
  if (even) {
    const float* win = p.w_in_even + (size_t)li * 2048 * 7184;
    const float* wout = p.w_out_even + (size_t)li * 2048 * 2048;
    const int n1 = 28 * 32, n2 = 8 * 32;
    for (int t = blockIdx.x; t < n1 + n2; t += gridDim.x) {
      if (t < n1) convert_tile256(win, 7184, nullptr, WL + WE_IN, 2048, (t & 31) * 64, (t >> 5) * 256, 0, lds);
      else { const int u = t - n1; convert_tile256(wout, 2048, nullptr, WL + WE_OUT, 2048, (u & 31) * 64, (u >> 5) * 256, 0, lds); }
    }
  } else {
    const float* win = p.w_in_odd + (size_t)li * 2048 * 3136;
    const float* wq = p.w_q_up + (size_t)li * 512 * 3072;
    const float* wkv = p.w_kv_up + (size_t)li * 512 * 4096;
    const float* wout = p.w_out_odd + (size_t)li * 2048 * 2048;
    const int n1 = 13 * 32, n2 = 12 * 8, n3 = 16 * 8, n4 = 8 * 32;
    for (int t = blockIdx.x; t < n1 + n2 + n3 + n4; t += gridDim.x) {
      if (t < n1) convert_tile256(win, 3136, nullptr, WL + WO_IN, 2048, (t & 31) * 64, (t >> 5) * 256, 1, lds);
      else if (t < n1 + n2) { const int u = t - n1; convert_tile256(wq, 3072, p.q_norm + (size_t)li * 512, WL + WO_Q, 512, (u & 7) * 64, (u >> 3) * 256, 2, lds); }
      else if (t < n1 + n2 + n3) { const int u = t - n1 - n2; convert_tile256(wkv, 4096, p.kv_norm + (size_t)li * 512, WL + WO_KV, 512, (u & 7) * 64, (u >> 3) * 256, 3, lds); }
      else { const int u = t - n1 - n2 - n3; convert_tile256(wout, 2048, nullptr, WL + WO_OUT, 2048, (u & 31) * 64, (u >> 5) * 256, 0, lds); }
    }
  }
  const float* xin = (L == 0) ? p.x : p.out;
  const float* g = even ? (p.ln_even + (size_t)li * 2048) : (p.ln_odd + (size_t)li * 2048);
  u16* H = (u16*)(p.ws + OFF_H);
  const int wave = TIDX() >> 6;
  if (even) {
    const float* wsrc = p.w_in_even + (size_t)li * 2048 * 7184 + 7168;
    const int tid = TIDX();
    for (int idx = tid; idx < 2048 * 16; idx += 512) {
      const int k = idx >> 4, c = idx & 15;
      lds[c * WG_LD + k] = wsrc[(size_t)k * 7184 + c];
    }
    __syncthreads();
    float* GA = (float*)(p.ws + E_GA);
    for (int row = blockIdx.x * 8 + wave; row < T_; row += gridDim.x * 8)
      norm_row<true>(xin + (size_t)row * 2048, g, H + (size_t)row * 2048, nullptr, lds, GA + (size_t)row * 16);
    __syncthreads();
  } else {
    for (int row = blockIdx.x * 8 + wave; row < T_; row += gridDim.x * 8)
      norm_row<false>(xin + (size_t)row * 2048, g, H + (size_t)row * 2048, nullptr, nullptr, nullptr);
  }
}

DI void phase_gemm_in_even(const Params& p, unsigned char* smem, int probe) {
  const u16* WL = (const u16*)(p.ws + OFF_WL);
  const u16* H = (const u16*)(p.ws + OFF_H);
  const int NT = 28;
  for (int t = blockIdx.x; t < 64 * NT; t += gridDim.x) {
    int tm, tn; tile_map(t, NT, tm, tn);
    GemmT g = gt_init(2048);
    const u16* Wt = WL + WE_IN + (size_t)tn * 256 * 2048;
    const u16* Ht = H + (size_t)tm * 256 * 2048;
    const bool trans = (tn >= 8 && tn < 12) || (tn >= 20 && tn < 24);
    if (trans) { g.A = Ht; g.B = Wt; g.R0 = tm * 256; } else { g.A = Wt; g.B = Ht; g.C0 = tm * 256; }
    if (tn < 4)       { g.mode = M_BF16; g.d16 = (u16*)(p.ws + E_SQ); g.ld = 1024; g.R0 = tn * 256; g.scale = 0.08838834764831845f * 1.4426950408889634f; }
    else if (tn < 8)  { g.mode = M_BF16; g.d16 = (u16*)(p.ws + E_SK); g.ld = 1024; g.R0 = (tn - 4) * 256; }
    else if (tn < 12) { g.mode = M_TRANS; g.d16 = (u16*)(p.ws + E_SVT); g.aux = 1024; g.C0 = (tn - 8) * 256; g.perm = 1; }
    else if (tn < 16) { g.mode = M_SILU; g.d16 = (u16*)(p.ws + E_SG); g.ld = 1024; g.R0 = (tn - 12) * 256; }
    else if (tn < 18) { g.mode = M_BF16; g.d16 = (u16*)(p.ws + E_GQ); g.ld = 512; g.R0 = (tn - 16) * 256; }
    else if (tn < 20) { g.mode = M_BF16; g.d16 = (u16*)(p.ws + E_GK); g.ld = 512; g.R0 = (tn - 18) * 256; }
    else if (tn < 24) { g.mode = M_TRANS; g.d16 = (u16*)(p.ws + E_GVT); g.aux = 1024; g.C0 = (tn - 20) * 256; }
    else              { g.mode = M_SILU; g.d16 = (u16*)(p.ws + E_GG); g.ld = 1024; g.R0 = (tn - 24) * 256; }
    g.probe = probe;
    gemm_tile8(g, smem);
  }
}

DI void phase_gemm_in_odd(const Params& p, unsigned char* smem) {
  const u16* WL = (const u16*)(p.ws + OFF_WL);
  const u16* H = (const u16*)(p.ws + OFF_H);
  const int NT = 12;
  for (int t = blockIdx.x; t < 64 * NT; t += gridDim.x) {
    int tm, tn; tile_map(t, NT, tm, tn);
    GemmT g = gt_init(2048);
    g.A = WL + WO_IN + (size_t)tn * 256 * 2048;
    g.B = H + (size_t)tm * 256 * 2048;
    g.C0 = tm * 256;
    if (tn < 2)      { g.mode = M_BF16; g.d16 = (u16*)(p.ws + O_QL); g.ld = 512; g.R0 = tn * 256; }
    else if (tn < 4) { g.mode = M_BF16; g.d16 = (u16*)(p.ws + O_KVL); g.ld = 512; g.R0 = (tn - 2) * 256; }
    else             { g.mode = M_SILU; g.d16 = (u16*)(p.ws + O_GATE); g.ld = 2048; g.R0 = (tn - 4) * 256; }
    gemm_tile8(g, smem);
  }
}

DI void phase_rstd_kr(const Params& p, unsigned char* smem) {
  for (int t = blockIdx.x; t < 64; t += gridDim.x) {
    GemmT g = gt_init(2048);
    g.A = (const u16*)(p.ws + OFF_WL) + WO_IN + (size_t)3072 * 2048;
    g.B = (const u16*)(p.ws + OFF_H) + (size_t)t * 256 * 2048;
    g.R0 = 0; g.C0 = t * 256; g.nact = 64; g.aux = 64;
    g.mode = M_ROPE; g.d16 = (u16*)(p.ws + O_KR); g.ld = 64;
    g.cs = (const float*)(p.ws + OFF_COS); g.sn = (const float*)(p.ws + OFF_SIN);
    gemm_tile8<true>(g, smem);
  }
  const u16* QL = (const u16*)(p.ws + O_QL);
  const u16* KVL = (const u16*)(p.ws + O_KVL);
  float* RSQ = (float*)(p.ws + O_RSQ);
  float* RSKV = (float*)(p.ws + O_RSKV);
  const int wave = TIDX() >> 6, lane = TIDX() & 63;
  for (int row = blockIdx.x * 8 + wave; row < 2 * T_; row += gridDim.x * 8) {
    const int m = row >> 1;
    const u16* src = (row & 1) ? KVL : QL;
    const u32x4 v = *(const u32x4*)(src + (size_t)m * 512 + lane * 8);
    float ss = 0.f;
#pragma unroll
    for (int q = 0; q < 4; ++q) { const float a = bf_lo(v[q]), b = bf_hi(v[q]); ss += a * a + b * b; }
    ss = wave_sum(ss);
    if (lane == 0) ((row & 1) ? RSKV : RSQ)[m] = rsqrtf(ss * (1.f / 512.f) + 1e-6f);
  }
}

DI void phase_gemm_up(const Params& p, unsigned char* smem) {
  const u16* WL = (const u16*)(p.ws + OFF_WL);
  const u16* QL = (const u16*)(p.ws + O_QL);
  const u16* KVL = (const u16*)(p.ws + O_KVL);
  const float* RSQ = (const float*)(p.ws + O_RSQ);
  const float* RSKV = (const float*)(p.ws + O_RSKV);
  const float qscale = 0.07216878364870322f * 1.4426950408889634f;
  const int NT = 28;
  for (int t = blockIdx.x; t < 64 * NT; t += gridDim.x) {
    int tm, tn; tile_map(t, NT, tm, tn);
    GemmT g = gt_init(512);
    if (tn < 8) {
      g.A = WL + WO_Q + (size_t)tn * 256 * 512; g.B = QL + (size_t)tm * 256 * 512;
      g.mode = M_BF16; g.d16 = (u16*)(p.ws + O_QN); g.ld = 2048; g.R0 = tn * 256; g.C0 = tm * 256; g.rs = RSQ; g.scale = qscale;
    } else if (tn < 12) {
      g.A = WL + WO_Q + (size_t)(2048 + (tn - 8) * 256) * 512; g.B = QL + (size_t)tm * 256 * 512;
      g.mode = M_ROPE; g.d16 = (u16*)(p.ws + O_QR); g.ld = 1024; g.R0 = (tn - 8) * 256; g.C0 = tm * 256; g.aux = 256; g.rs = RSQ; g.scale = qscale;
      g.cs = (const float*)(p.ws + OFF_COS); g.sn = (const float*)(p.ws + OFF_SIN);
    } else if (tn < 20) {
      g.A = WL + WO_KV + (size_t)(tn - 12) * 256 * 512; g.B = KVL + (size_t)tm * 256 * 512;
      g.mode = M_BF16; g.d16 = (u16*)(p.ws + O_KN); g.ld = 2048; g.R0 = (tn - 12) * 256; g.C0 = tm * 256; g.rs = RSKV;
    } else {
      g.A = KVL + (size_t)tm * 256 * 512; g.B = WL + WO_KV + (size_t)(2048 + (tn - 20) * 256) * 512;
      g.mode = M_TRANS; g.d16 = (u16*)(p.ws + O_VT); g.aux = 2048; g.R0 = tm * 256; g.C0 = (tn - 20) * 256; g.rs = RSKV; g.perm = 1;
    }
    gemm_tile8(g, smem);
  }
}

DI void phase_gemm_out(const Params& p, int L, unsigned char* smem) {
  const bool even = (L & 1) == 0;
  const u16* WL = (const u16*)(p.ws + OFF_WL) + (even ? WE_OUT : WO_OUT);
  const u16* Y = (const u16*)(p.ws + OFF_H);
  const float* xin = (L == 0) ? p.x : p.out;
  for (int t = blockIdx.x; t < 64 * 8; t += gridDim.x) {
    int tm, tn; tile_map(t, 8, tm, tn);
    GemmT g = gt_init(2048);
    g.A = WL + (size_t)tn * 256 * 2048; g.B = Y + (size_t)tm * 256 * 2048;
    g.mode = M_RESID; g.R0 = tn * 256; g.C0 = tm * 256; g.d32 = p.out; g.xin = xin;
    gemm_tile8(g, smem);
  }
}

DI int next_item(int* ctr, int* sitem) {
  if (TIDX() == 0) *sitem = atomicAdd(ctr, 1);
  __syncthreads();
  const int it = *sitem;
  __syncthreads();
  return it;
}

DI void phase_even_mix(const Params& p, int L, int ph, unsigned char* smem, int* sitem, bool do_g1) {
  int* ctr = (int*)(p.ws + OFF_CTR) + ph;
  const int li = L >> 1;
  for (;;) {
    const int it = next_item(ctr, sitem);
    if (it >= 1536) break;
    if (it < 512) {
      const int qb = 31 - (it >> 4), bh = it & 15, b = bh >> 3, hh = bh & 7;
      const u16* SQ = (const u16*)(p.ws + E_SQ) + (size_t)b * S_ * 1024 + hh * 128;
      const u16* SK = (const u16*)(p.ws + E_SK) + (size_t)b * S_ * 1024 + hh * 128;
      const u16* SVT = (const u16*)(p.ws + E_SVT) + ((size_t)(b * 1024 + hh * 128)) * 8192;
      const u16* SG = (const u16*)(p.ws + E_SG) + (size_t)b * S_ * 1024 + hh * 128;
      u16* Y = (u16*)(p.ws + OFF_H) + (size_t)b * S_ * 2048 + hh * 128;
      attn_item<128, true, 1024, 0, 1024, 0, 1024>(SQ, nullptr, SK, nullptr, SVT, SG, Y, qb * 256, smem);
    } else {
      if (do_g1) gla_g1(p, li, it - 512, smem);
    }
  }
}

DI void phase_gla_out(const Params& p, int L, int ph, unsigned char* smem, int* sitem) {
  int* ctr = (int*)(p.ws + OFF_CTR) + ph;
  const int li = L >> 1;
  for (;;) {
    const int it = next_item(ctr, sitem);
    if (it >= 1024) break;
    gla_g3(p, li, it, smem);
  }
}

DI void mla_item(const Params& p, int bh, int qb, unsigned char* smem, int probe) {
  const int b = bh >> 4, hh = bh & 15;
  const u16* QN = (const u16*)(p.ws + O_QN) + (size_t)b * S_ * 2048 + hh * 128;
  const u16* QR = (const u16*)(p.ws + O_QR) + (size_t)b * S_ * 1024 + hh * 64;
  const u16* KN = (const u16*)(p.ws + O_KN) + (size_t)b * S_ * 2048 + hh * 128;
  const u16* KR = (const u16*)(p.ws + O_KR) + (size_t)b * S_ * 64;
  const u16* VT = (const u16*)(p.ws + O_VT) + ((size_t)(b * 2048 + hh * 128)) * 8192;
  const u16* GT = (const u16*)(p.ws + O_GATE) + (size_t)b * S_ * 2048 + hh * 128;
  u16* Y = (u16*)(p.ws + OFF_H) + (size_t)b * S_ * 2048 + hh * 128;
  attn_item<192, false, 2048, 1024, 2048, 64, 2048>(QN, QR, KN, KR, VT, GT, Y, qb * 256, smem, probe);
}

DI void phase_mla(const Params& p, int ph, unsigned char* smem, int* sitem, int probe) {
  if (gridDim.x == 256) {
    const int x = blockIdx.x & 7, j = blockIdx.x >> 3, half = j >> 4, jp = j & 15;
#pragma unroll 1
    for (int pass = 0; pass < 2; ++pass) {
      const int bh = 4 * x + 2 * pass + half;
      mla_item(p, bh, 31 - jp, smem, probe);
      mla_item(p, bh, jp, smem, probe);
    }
    return;
  }
  int* ctr = (int*)(p.ws + OFF_CTR) + 64 + (ph % 24) * 8;
  const int x = (int)(xb_xcc_id() & 7u);
  for (;;) {
    if (TIDX() == 0) {
      int it = -1;
      for (int k = 0; k < 8; ++k) {
        const int q = (x + k) & 7;
        const int v = atomicAdd(ctr + q, 1);
        if (v < 128) { it = q * 128 + v; break; }
      }
      *sitem = it;
    }
    __syncthreads();
    const int it = *sitem;
    __syncthreads();
    if (it < 0) break;
    const int q = it >> 7, v = it & 127;
    mla_item(p, 4 * q + (v >> 5), 31 - (v & 31), smem, probe);
  }
}

DI void phase_final(const Params& p) {
  const int wave = TIDX() >> 6;
  for (int row = blockIdx.x * 8 + wave; row < T_; row += gridDim.x * 8)
    norm_row<false>(p.out + (size_t)row * 2048, p.final_norm, nullptr, p.out + (size_t)row * 2048, nullptr, nullptr);
}

__global__ void __launch_bounds__(512, 2) fwd_kernel(Params p_arg, int ph0, int ph1) {
  __shared__ __attribute__((aligned(16))) unsigned char smem[SMEM_BYTES + 64];
  int& sitem = *(int*)(smem + SMEM_BYTES);
  uint4& xb_words = *(uint4*)(smem + SMEM_BYTES + 16);
  cg::grid_group grid = cg::this_grid();
  if (__builtin_amdgcn_workitem_id_x() == 0) xb_words = make_uint4(0u, 0u, 0u, 0u);
  __syncthreads();
  XcdBarrier xb = xcd_barrier_post((unsigned*)(p_arg.ws + OFF_BAR), (volatile LAS unsigned*)&xb_words);
  if (ph1 > 1000) grid.sync();
  typedef const __attribute__((address_space(4))) Params* KP;
  const KP kp0 = (KP)__builtin_amdgcn_kernarg_segment_ptr();
  for (int ph = ph0; ph < ph1; ++ph) {
   for (int rep = 0; rep < 2; ++rep) {
    if (rep == 1) { if (!((REPEAT_MASK >> ph) & 1)) break; xcd_barrier(xb); }
    const int cph = ph + 32 * rep;
    KP kq = kp0;
    asm volatile("" : "+s"(kq));
    const Params& p = *(const Params*)kq;
    if (ph == 24) {
      phase_final(p);
    } else {
      const int L = ph / 6, sub = ph % 6;
      const bool even = (L & 1) == 0;
      if (sub == 0) { if (PH_MASK & 1) phase_prep(p, L, smem); }
      else if (sub == 1) { if (even) { if (PH_MASK & 2) phase_gemm_in_even(p, smem, rep); } else { if (PH_MASK & 4) phase_gemm_in_odd(p, smem); } }
      else if (sub == 2) { if (even) { if (PH_MASK & 8) phase_even_mix(p, L, cph, smem, &sitem, rep == 0); } else { if (PH_MASK & 16) phase_rstd_kr(p, smem); } }
      else if (sub == 3) { if (even) { if (PH_MASK & 32) gla_scan(p); } else { if (PH_MASK & 64) phase_gemm_up(p, smem); } }
      else if (sub == 4) { if (even) { if (PH_MASK & 128) phase_gla_out(p, L, cph, smem, &sitem); } else { if (PH_MASK & 256) phase_mla(p, cph, smem, &sitem, rep); } }
      else { if (PH_MASK & 512) phase_gemm_out(p, L, smem); }
    }
   }
    if (ph + 1 < ph1) xcd_barrier(xb);
  }
}

extern "C" void kernel_launch(void* const* d_in, const int* in_sizes, int n_in, void* d_out, int out_size,
                              void* d_ws, size_t ws_size, hipStream_t stream) {
  static int grid_blocks = 0;
  if (!grid_blocks) {
    int dev = 0, cus = 0, per_cu = 0;
    (void)hipGetDevice(&dev);
    (void)hipDeviceGetAttribute(&cus, hipDeviceAttributeMultiprocessorCount, dev);
    (void)hipOccupancyMaxActiveBlocksPerMultiprocessor(&per_cu, fwd_kernel, 512, 0);
    if (per_cu < 1) per_cu = 1;
    if (per_cu > 1) per_cu = 1;
    grid_blocks = cus * per_cu;
  }
  if (ws_size < WS_NEED) { fprintf(stderr, "workspace too small: %zu\n", ws_size); return; }
  Params p{};
  p.x = (const float*)d_in[0]; p.pos = (const int*)d_in[1];
  p.ln_even = (const float*)d_in[2]; p.w_in_even = (const float*)d_in[3];
  p.alpha_up = (const float*)d_in[4]; p.alpha_bias = (const float*)d_in[5];
  p.gla_norm = (const float*)d_in[6]; p.w_out_even = (const float*)d_in[7];
  p.ln_odd = (const float*)d_in[8]; p.w_in_odd = (const float*)d_in[9];
  p.q_norm = (const float*)d_in[10]; p.w_q_up = (const float*)d_in[11];
  p.kv_norm = (const float*)d_in[12]; p.w_kv_up = (const float*)d_in[13];
  p.w_out_odd = (const float*)d_in[14]; p.final_norm = (const float*)d_in[15];
  p.out = (float*)d_out; p.ws = (unsigned char*)d_ws;
  (void)hipMemsetAsync((unsigned char*)d_ws + OFF_CTR, 0, 16384, stream);
  int a0 = 0, a1 = NPHASE;
  void* args[] = {&p, &a0, &a1};
  hipError_t e = hipLaunchCooperativeKernel((void*)fwd_kernel, dim3(grid_blocks), dim3(512), args, 0, stream);
  if (e != hipSuccess) fprintf(stderr, "cooperative launch failed: %s (grid %d)\n", hipGetErrorString(e), grid_blocks);
}
```

```cpp
#include <hip/hip_runtime.h>
#include <hip/hip_cooperative_groups.h>
#include <cstdio>
#include <cstdint>
#include <type_traits>
namespace cg = cooperative_groups;

#ifndef ONE_LAUNCH
#define ONE_LAUNCH 1
#endif

#ifndef REPEAT_MASK
#define REPEAT_MASK 0
#endif
#ifndef PROBE_MODE
#define PROBE_MODE 0
#endif
#ifndef PH_MASK
#define PH_MASK 0xFFFF
#endif
#define DI __device__ __forceinline__
typedef unsigned short u16;
using bf16x8 = __attribute__((ext_vector_type(8))) short;
using s16x4  = __attribute__((ext_vector_type(4))) short;
using f32x16 = __attribute__((ext_vector_type(16))) float;
using u32x4  = __attribute__((ext_vector_type(4))) unsigned;
using u32x2  = __attribute__((ext_vector_type(2))) unsigned;
#define MFMA32(a, b, c) __builtin_amdgcn_mfma_f32_32x32x16_bf16((a), (b), (c), 0, 0, 0)

constexpr int S_ = 8192;
constexpr int T_ = 16384;
constexpr size_t MiB = (size_t)1 << 20;

constexpr size_t OFF_WL = 0;
constexpr size_t OFF_H  = 40 * MiB;
constexpr size_t OFF_L  = 104 * MiB;
constexpr size_t E_SQ  = OFF_L + 0 * MiB;
constexpr size_t E_SK  = OFF_L + 32 * MiB;
constexpr size_t E_SVT = OFF_L + 64 * MiB;
constexpr size_t E_SG  = OFF_L + 96 * MiB;
constexpr size_t E_GQ  = OFF_L + 128 * MiB;
constexpr size_t E_GK  = OFF_L + 144 * MiB;
constexpr size_t E_GVT = OFF_L + 160 * MiB;
constexpr size_t E_GG  = OFF_L + 192 * MiB;
constexpr size_t E_GA  = OFF_L + 224 * MiB;
constexpr size_t E_EBL = OFF_L + 225 * MiB;
constexpr size_t E_SC  = OFF_L + 226 * MiB;
constexpr size_t O_QL   = OFF_L + 0 * MiB;
constexpr size_t O_KVL  = OFF_L + 16 * MiB;
constexpr size_t O_GATE = OFF_L + 32 * MiB;
constexpr size_t O_KR   = OFF_L + 96 * MiB;
constexpr size_t O_RSQ  = OFF_L + 98 * MiB;
constexpr size_t O_RSKV = OFF_L + 98 * MiB + 65536;
constexpr size_t O_QN   = OFF_L + 99 * MiB;
constexpr size_t O_QR   = OFF_L + 163 * MiB;
constexpr size_t O_KN   = OFF_L + 195 * MiB;
constexpr size_t O_VT   = OFF_L + 259 * MiB;
constexpr size_t OFF_COS = 460 * MiB;
constexpr size_t OFF_SIN = 462 * MiB;
constexpr size_t OFF_CTR = 464 * MiB;
constexpr size_t OFF_BAR = 464 * MiB + 1024;
constexpr size_t WS_NEED = 465 * MiB;

constexpr size_t WE_IN = 0;
constexpr size_t WE_OUT = (size_t)7168 * 2048;
constexpr size_t WO_IN = 0;
constexpr size_t WO_Q = (size_t)3328 * 2048;
constexpr size_t WO_KV = WO_Q + (size_t)3072 * 512;
constexpr size_t WO_OUT = WO_KV + (size_t)4096 * 512;

constexpr int NPHASE = 25;
constexpr int SMEM_BYTES = 147456;

struct Params {
  const float* x; const int* pos;
  const float* ln_even; const float* w_in_even; const float* alpha_up; const float* alpha_bias;
  const float* gla_norm; const float* w_out_even;
  const float* ln_odd; const float* w_in_odd; const float* q_norm; const float* w_q_up;
  const float* kv_norm; const float* w_kv_up; const float* w_out_odd;
  const float* final_norm;
  float* out; unsigned char* ws;
};

DI unsigned pack_bf16(float a, float b) {
  typedef __bf16 bf2 __attribute__((ext_vector_type(2)));
  typedef float f2 __attribute__((ext_vector_type(2)));
  f2 v = {a, b};
  bf2 r = __builtin_convertvector(v, bf2);
  return __builtin_bit_cast(unsigned, r);
}
DI u16 to_bf16(float a) { return (u16)(pack_bf16(a, 0.f) & 0xffffu); }
DI float bf_lo(unsigned w) { return __uint_as_float(w << 16); }
DI float bf_hi(unsigned w) { return __uint_as_float(w & 0xffff0000u); }
DI int TIDX() { int t = __builtin_amdgcn_workitem_id_x(); asm volatile("" : "+v"(t)); return t; }
DI int crow(int reg, int h) { return (reg & 3) + 8 * (reg >> 2) + 4 * h; }
DI float xh_max(float x) {
  const auto r = __builtin_amdgcn_permlane32_swap(__float_as_uint(x), __float_as_uint(x), false, false);
  return fmaxf(__uint_as_float(r[0]), __uint_as_float(r[1]));
}
DI float xh_sum(float x) {
  const auto r = __builtin_amdgcn_permlane32_swap(__float_as_uint(x), __float_as_uint(x), false, false);
  return __uint_as_float(r[0]) + __uint_as_float(r[1]);
}
DI float xh_partner(float x, int h) {
  const auto r = __builtin_amdgcn_permlane32_swap(__float_as_uint(x), __float_as_uint(x), false, false);
  return h ? __uint_as_float(r[0]) : __uint_as_float(r[1]);
}
DI float dpp_add(float v, const int ctrl_tag) {
  int r;
  if (ctrl_tag == 0) r = __builtin_amdgcn_update_dpp(0, __float_as_int(v), 0xB1, 0xf, 0xf, true);
  else if (ctrl_tag == 1) r = __builtin_amdgcn_update_dpp(0, __float_as_int(v), 0x4E, 0xf, 0xf, true);
  else if (ctrl_tag == 2) r = __builtin_amdgcn_update_dpp(0, __float_as_int(v), 0x141, 0xf, 0xf, true);
  else r = __builtin_amdgcn_update_dpp(0, __float_as_int(v), 0x140, 0xf, 0xf, true);
  return v + __int_as_float(r);
}
DI float wave_sum(float v) {
  v = dpp_add(v, 0); v = dpp_add(v, 1); v = dpp_add(v, 2); v = dpp_add(v, 3);
  { const auto r = __builtin_amdgcn_permlane16_swap(__float_as_uint(v), __float_as_uint(v), false, false);
    v = __uint_as_float(r[0]) + __uint_as_float(r[1]); }
  return xh_sum(v);
}
DI float silu_f(float v) { return v * __builtin_amdgcn_rcpf(1.f + __expf(-v)); }
DI bf16x8 pack8(const f32x16& x, int s) {
  u32x4 p;
  p[0] = pack_bf16(x[8 * s + 0], x[8 * s + 1]);
  p[1] = pack_bf16(x[8 * s + 2], x[8 * s + 3]);
  p[2] = pack_bf16(x[8 * s + 4], x[8 * s + 5]);
  p[3] = pack_bf16(x[8 * s + 6], x[8 * s + 7]);
  return __builtin_bit_cast(bf16x8, p);
}

DI void convert_tile(const float* __restrict__ src, int ldn, const float* __restrict__ gain,
                     u16* __restrict__ dst, int K, int k0, int nd0, int ns0, int nvalid, float* lds) {
  const int tid = TIDX();
  const int c = tid & 63, r0 = tid >> 6;
#pragma unroll
  for (int i = 0; i < 8; ++i) {
    const int r = r0 + 8 * i;
    float v = 0.f;
    if (c < nvalid) {
      v = src[(size_t)(k0 + r) * ldn + ns0 + c];
      if (gain) v *= gain[k0 + r];
    }
    lds[r * 65 + c] = v;
  }
  __syncthreads();
  const int kk = (tid & 31) * 2, n = tid >> 5;
#pragma unroll
  for (int i = 0; i < 4; ++i) {
    const int nn = n + 16 * i;
    const unsigned pk = pack_bf16(lds[kk * 65 + nn], lds[(kk + 1) * 65 + nn]);
    *(unsigned*)(dst + (size_t)(nd0 + nn) * K + k0 + kk) = pk;
  }
  __syncthreads();
}

DI int src_col(int mode, int nd) {
  if (mode == 0) return nd;
  if (mode == 1) return nd < 1024 ? nd : (nd < 3072 ? nd + 64 : (nd < 3136 ? nd - 2048 : -1));
  if (mode == 2) return nd < 2048 ? (nd >> 7) * 192 + (nd & 127) : ((nd - 2048) >> 6) * 192 + 128;
  return nd < 2048 ? (nd >> 7) * 256 + (nd & 127) : ((nd - 2048) >> 7) * 256 + 128 + ((nd - 2048) & 127);
}
DI void convert_tile256(const float* __restrict__ src, int ldn, const float* __restrict__ gain,
                        u16* __restrict__ dst, int K, int k0, int nd0, int mode, float* lds) {
  constexpr int LDW = 260;
  const int tid = TIDX();
  {
    const int col4 = tid & 63, row0 = tid >> 6;
    const int nd = nd0 + col4 * 4;
    const int sc = src_col(mode, nd & ~63);
    const float* sp = src + (size_t)(k0 + row0) * ldn + (sc + (nd & 63));
#pragma unroll
    for (int i = 0; i < 8; ++i) {
      float z = 0.f;
      asm volatile("" : "+v"(z));
      float4 v = make_float4(z, z, z, z);
      if (sc >= 0) {
        v = *(const float4*)(sp + (size_t)(8 * i) * ldn);
        if (gain) { const float gg = gain[k0 + row0 + 8 * i]; v.x *= gg; v.y *= gg; v.z *= gg; v.w *= gg; }
      }
      *(float4*)(lds + (row0 + 8 * i) * LDW + col4 * 4) = v;
    }
  }
  __syncthreads();
  {
    const int kc = tid & 7;
#pragma unroll
    for (int j = 0; j < 4; ++j) {
      const int n = (tid >> 3) + 64 * j;
      const float* lp = lds + (kc * 8) * LDW + n;
      u32x4 pk;
      pk[0] = pack_bf16(lp[0 * LDW], lp[1 * LDW]);
      pk[1] = pack_bf16(lp[2 * LDW], lp[3 * LDW]);
      pk[2] = pack_bf16(lp[4 * LDW], lp[5 * LDW]);
      pk[3] = pack_bf16(lp[6 * LDW], lp[7 * LDW]);
      *(u32x4*)(dst + (size_t)(nd0 + n) * K + k0 + kc * 8) = pk;
    }
  }
  __syncthreads();
}

template <bool GA>
DI void norm_row(const float* __restrict__ xrow, const float* __restrict__ g, u16* __restrict__ hrow,
                 float* __restrict__ orow, const float* wg, float* __restrict__ garow) {
  const int lane = TIDX() & 63;
  float4 v[8];
  float ss = 0.f;
#pragma unroll
  for (int i = 0; i < 8; ++i) {
    v[i] = ((const float4*)xrow)[lane + 64 * i];
    ss += v[i].x * v[i].x + v[i].y * v[i].y + v[i].z * v[i].z + v[i].w * v[i].w;
  }
  ss = wave_sum(ss);
  const float rstd = rsqrtf(ss * (1.f / 2048.f) + 1e-6f);
  float ga[16];
  if constexpr (GA) {
#pragma unroll
    for (int c = 0; c < 16; ++c) ga[c] = 0.f;
  }
#pragma unroll
  for (int i = 0; i < 8; ++i) {
    const float4 gg = ((const float4*)g)[lane + 64 * i];
    const float a = v[i].x * rstd * gg.x, b = v[i].y * rstd * gg.y, c = v[i].z * rstd * gg.z, d = v[i].w * rstd * gg.w;
    if (hrow) {
      u32x2 o; o[0] = pack_bf16(a, b); o[1] = pack_bf16(c, d);
      ((u32x2*)hrow)[lane + 64 * i] = o;
    } else {
      ((float4*)orow)[lane + 64 * i] = make_float4(a, b, c, d);
    }
    if constexpr (GA) {
#pragma unroll
      for (int cc = 0; cc < 16; ++cc) {
        const float4 w = ((const float4*)(wg + cc * 2052))[lane + 64 * i];
        ga[cc] += a * w.x + b * w.y + c * w.z + d * w.w;
      }
    }
  }
  if constexpr (GA) {
    float mine = 0.f;
#pragma unroll
    for (int cc = 0; cc < 16; ++cc) {
      const float t = wave_sum(ga[cc]);
      if (lane == cc) mine = t;
    }
    if (lane < 16) garow[lane] = mine;
  }
}

enum { M_BF16 = 0, M_SILU = 1, M_TRANS = 2, M_ROPE = 4, M_RESID = 5 };
struct GemmT {
  const u16* A; const u16* B; int lda, ldb, K;
  int mode, R0, C0, ld, aux, nact, probe, perm;
  u16* d16; float* d32; float scale; const float* rs; const float* xin; const float* cs; const float* sn;
};
constexpr int LDT = 72;

DI void gemm_tile(const GemmT& g, unsigned char* smem) {
  const int tid = TIDX(), lane = tid & 63, wave = tid >> 6;
  const int wm = (wave >> 2) * 128, wn = (wave & 3) * 64;
  const int r = lane & 31, h = lane >> 5;
  u16* sA = (u16*)smem;
  u16* sB = sA + 2 * 256 * LDT;
  const int lrow = tid >> 3, lch = (tid & 7) * 8;
  const u16* Ag = g.A + (size_t)lrow * g.lda + lch;
  const u16* Bg = g.B + (size_t)lrow * g.ldb + lch;
  const bool active = wm < g.nact;
  u32x4 ra[4], rb[4];
  f32x16 acc[4][2];
#pragma unroll
  for (int i = 0; i < 4; ++i)
#pragma unroll
    for (int j = 0; j < 2; ++j)
#pragma unroll
      for (int q = 0; q < 16; ++q) acc[i][j][q] = 0.f;

#pragma unroll
  for (int i = 0; i < 4; ++i) {
    ra[i] = *(const u32x4*)(Ag + (size_t)(64 * i) * g.lda);
    rb[i] = *(const u32x4*)(Bg + (size_t)(64 * i) * g.ldb);
  }
  __syncthreads();
#pragma unroll
  for (int i = 0; i < 4; ++i) {
    *(u32x4*)(sA + (lrow + 64 * i) * LDT + lch) = ra[i];
    *(u32x4*)(sB + (lrow + 64 * i) * LDT + lch) = rb[i];
  }
#pragma unroll
  for (int i = 0; i < 4; ++i) {
    ra[i] = *(const u32x4*)(Ag + (size_t)(64 * i) * g.lda + 64);
    rb[i] = *(const u32x4*)(Bg + (size_t)(64 * i) * g.ldb + 64);
  }
  __syncthreads();
  const int KT = g.K >> 6;
  for (int kt = 0; kt < KT; ++kt) {
    if (kt + 1 < KT) {
      u16* a_d = sA + ((kt + 1) & 1) * 256 * LDT;
      u16* b_d = sB + ((kt + 1) & 1) * 256 * LDT;
#pragma unroll
      for (int i = 0; i < 4; ++i) {
        *(u32x4*)(a_d + (lrow + 64 * i) * LDT + lch) = ra[i];
        *(u32x4*)(b_d + (lrow + 64 * i) * LDT + lch) = rb[i];
      }
    }
    if (kt + 2 < KT && !(PROBE_MODE == 1 && g.probe)) {
#pragma unroll
      for (int i = 0; i < 4; ++i) {
        ra[i] = *(const u32x4*)(Ag + (size_t)(64 * i) * g.lda + (kt + 2) * 64);
        rb[i] = *(const u32x4*)(Bg + (size_t)(64 * i) * g.ldb + (kt + 2) * 64);
      }
    }
    __builtin_amdgcn_sched_barrier(0);
    if (active) {
      const u16* a_s = sA + (kt & 1) * 256 * LDT + (wm + r) * LDT + 8 * h;
      const u16* b_s = sB + (kt & 1) * 256 * LDT + (wn + r) * LDT + 8 * h;
#pragma unroll
      for (int ks = 0; ks < 4; ++ks) {
        bf16x8 af[4], bf[2];
#pragma unroll
        for (int i = 0; i < 4; ++i) af[i] = *(const bf16x8*)(a_s + 32 * i * LDT + ks * 16);
#pragma unroll
        for (int j = 0; j < 2; ++j) bf[j] = *(const bf16x8*)(b_s + 32 * j * LDT + ks * 16);
#pragma unroll
        for (int i = 0; i < 4; ++i)
#pragma unroll
          for (int j = 0; j < 2; ++j) acc[i][j] = MFMA32(af[i], bf[j], acc[i][j]);
      }
    }
    __syncthreads();
  }
  if (!active) return;
  if (PROBE_MODE && g.probe) {
    float sacc = 0.f;
#pragma unroll
    for (int i = 0; i < 4; ++i)
#pragma unroll
      for (int j = 0; j < 2; ++j)
#pragma unroll
        for (int q = 0; q < 16; ++q) sacc += acc[i][j][q];
    if (sacc == 1.2345e-30f) g.d16[0] = 0;
    return;
  }

  const int mode = g.mode;
  if (mode == M_ROPE) {
#pragma unroll
    for (int j = 0; j < 2; ++j) {
      const int tok = g.C0 + wn + 32 * j + r;
      const float sc = g.scale * (g.rs ? g.rs[tok] : 1.f);
#pragma unroll
      for (int ip = 0; ip < 2; ++ip) {
        if (wm + 64 * ip < g.aux) {
#pragma unroll
          for (int g4 = 0; g4 < 4; ++g4) {
            const int c0 = 8 * g4 + 4 * h;
            const float4 cs = *(const float4*)(g.cs + (size_t)tok * 32 + c0);
            const float4 sn = *(const float4*)(g.sn + (size_t)tok * 32 + c0);
            const float a0 = acc[2 * ip][j][4 * g4 + 0] * sc, a1 = acc[2 * ip][j][4 * g4 + 1] * sc;
            const float a2 = acc[2 * ip][j][4 * g4 + 2] * sc, a3 = acc[2 * ip][j][4 * g4 + 3] * sc;
            const float b0 = acc[2 * ip + 1][j][4 * g4 + 0] * sc, b1 = acc[2 * ip + 1][j][4 * g4 + 1] * sc;
            const float b2 = acc[2 * ip + 1][j][4 * g4 + 2] * sc, b3 = acc[2 * ip + 1][j][4 * g4 + 3] * sc;
            u32x2 o1, o2;
            o1[0] = pack_bf16(a0 * cs.x - b0 * sn.x, a1 * cs.y - b1 * sn.y);
            o1[1] = pack_bf16(a2 * cs.z - b2 * sn.z, a3 * cs.w - b3 * sn.w);
            o2[0] = pack_bf16(b0 * cs.x + a0 * sn.x, b1 * cs.y + a1 * sn.y);
            o2[1] = pack_bf16(b2 * cs.z + a2 * sn.z, b3 * cs.w + a3 * sn.w);
            u16* dp = g.d16 + (size_t)tok * g.ld + g.R0 + wm + 64 * ip + c0;
            *(u32x2*)dp = o1;
            *(u32x2*)(dp + 32) = o2;
          }
        }
      }
    }
    return;
  }
  unsigned char* wreg = smem + wave * 17408;
  if (mode == M_RESID) {
#pragma unroll
    for (int j = 0; j < 2; ++j) {
#pragma unroll
      for (int i = 0; i < 4; ++i)
#pragma unroll
        for (int g4 = 0; g4 < 4; ++g4)
          *(float4*)(wreg + r * 528 + (32 * i + 8 * g4 + 4 * h) * 4) =
              make_float4(acc[i][j][4 * g4 + 0], acc[i][j][4 * g4 + 1], acc[i][j][4 * g4 + 2], acc[i][j][4 * g4 + 3]);
#pragma unroll
      for (int it = 0; it < 16; ++it) {
        const int row = 2 * it + h;
        const float4 v = *(const float4*)(wreg + row * 528 + r * 16);
        const size_t o = (size_t)(g.C0 + wn + 32 * j + row) * 2048 + g.R0 + wm + r * 4;
        const float4 x = *(const float4*)(g.xin + o);
        *(float4*)(g.d32 + o) = make_float4(x.x + v.x, x.y + v.y, x.z + v.z, x.w + v.w);
      }
    }
    return;
  }
#pragma unroll
  for (int j = 0; j < 2; ++j) {
    const int outer = g.C0 + wn + 32 * j + r;
    const float sc = (mode == M_BF16) ? g.scale * (g.rs ? g.rs[outer] : 1.f) : 1.f;
#pragma unroll
    for (int i = 0; i < 4; ++i)
#pragma unroll
      for (int g4 = 0; g4 < 4; ++g4) {
        float v0 = acc[i][j][4 * g4 + 0], v1 = acc[i][j][4 * g4 + 1], v2 = acc[i][j][4 * g4 + 2], v3 = acc[i][j][4 * g4 + 3];
        if (mode == M_BF16) { v0 *= sc; v1 *= sc; v2 *= sc; v3 *= sc; }
        else if (mode == M_SILU) { v0 = silu_f(v0); v1 = silu_f(v1); v2 = silu_f(v2); v3 = silu_f(v3); }
        else if (g.rs) {
          const float4 r4 = *(const float4*)(g.rs + g.R0 + wm + 32 * i + 8 * g4 + 4 * h);
          v0 *= r4.x; v1 *= r4.y; v2 *= r4.z; v3 *= r4.w;
        }
        u32x2 pk; pk[0] = pack_bf16(v0, v1); pk[1] = pack_bf16(v2, v3);
        *(u32x2*)(wreg + (32 * j + r) * 272 + (32 * i + 8 * g4 + 4 * h) * 2) = pk;
      }
  }
  {
    const int inner0 = g.R0 + wm;
#pragma unroll
    for (int it = 0; it < 16; ++it) {
      const int row = 4 * it + (lane >> 4), ch = lane & 15;
      const u32x4 v = *(const u32x4*)(wreg + row * 272 + ch * 16);
      const int outer = g.C0 + wn + row;
      size_t o;
      if (mode == M_TRANS) o = ((size_t)(inner0 >> 13) * g.aux + outer) * 8192 + (inner0 & 8191);
      else o = (size_t)outer * g.ld + inner0;
      *(u32x4*)(g.d16 + o + ch * 8) = v;
    }
  }
}

using f32x4v = __attribute__((ext_vector_type(4))) float;
DI int lds_byte8(int r, int c) {
  const int st = (r >> 4) * 2 + (c >> 5), rr = r & 15, cc = c & 31, ob = rr * 64 + cc * 2;
  return st * 1024 + (ob ^ (((ob >> 9) & 1) << 5));
}
DI void stage_rc8(int b, int& R, int& C) {
  const int st = b / 1024, sb = b % 1024, swz = sb ^ (((sb >> 9) & 1) << 5);
  R = (st >> 1) * 16 + swz / 64; C = (st & 1) * 32 + (swz % 64) / 2;
}
template <bool KR = false>
DI void gemm_tile8(const GemmT& g, unsigned char* smem) {
  constexpr int BK = 64, HALF = 128, HT = HALF * BK;
  u16* shm = (u16*)smem;
  const u16* A = g.A; const u16* Bt = g.B; const int K = g.K;
  const int tid = TIDX();
  const int nact = g.nact;
  #define SA8(b,h) (shm+((b)*2+(h))*HT)
  #define SB8(b,h) (shm+(4+(b)*2+(h))*HT)
  unsigned soff0, soff1;
  { int r_, c_; stage_rc8(tid * 16, r_, c_); soff0 = (unsigned)(r_ * K + c_); stage_rc8(tid * 16 + 8192, r_, c_); soff1 = (unsigned)(r_ * K + c_); }
  #define STAGE8(P,BASE,br,kt) do{ const u16* _gb = (BASE) + ((long)(br)*K+(long)(kt)*BK); \
      __builtin_amdgcn_global_load_lds((const unsigned*)(_gb + soff0), (unsigned*)((char*)(P)+tid*16),16,0,0); \
      __builtin_amdgcn_global_load_lds((const unsigned*)(_gb + soff1), (unsigned*)((char*)(P)+tid*16+8192),16,0,0); }while(0)
  #define LDA8(dst,b,h) _Pragma("unroll") for(int m=0;m<4;++m) _Pragma("unroll") for(int k=0;k<2;++k) \
    dst[m][k]=*reinterpret_cast<const bf16x8*>((const char*)SA8(b,h)+lds_byte8(wr*64+m*16+fr,k*32+fq*8))
  #define LDB8(dst,b,h) _Pragma("unroll") for(int n=0;n<2;++n) _Pragma("unroll") for(int k=0;k<2;++k) \
    dst[n][k]=*reinterpret_cast<const bf16x8*>((const char*)SB8(b,h)+lds_byte8(wc*32+n*16+fr,k*32+fq*8))
  #define MMA8(ai,bj,At_,Bt_) do{__builtin_amdgcn_s_setprio(1); \
    _Pragma("unroll") for(int m=0;m<4;++m) _Pragma("unroll") for(int n=0;n<2;++n) _Pragma("unroll") for(int k=0;k<2;++k) \
      acc[ai][bj][m][n]=__builtin_amdgcn_mfma_f32_16x16x32_bf16(At_[m][k],Bt_[n][k],acc[ai][bj][m][n],0,0,0); \
    __builtin_amdgcn_s_setprio(0);}while(0)
  #define MMA8C(ai,bj,At_,Bt_) do{ if (!KR || ((ai)*128 + wr*64 < nact)) MMA8(ai,bj,At_,Bt_); }while(0)
  #define WAIT_V8(n) asm volatile("s_waitcnt vmcnt(" #n ")":::"memory")
  #define WAIT_L8(n) asm volatile("s_waitcnt lgkmcnt(" #n ")":::"memory")
  #define BAR8 __builtin_amdgcn_s_barrier()
  #define SCHED8 __builtin_amdgcn_sched_barrier(0)
  f32x4v acc[2][2][4][2];
#pragma unroll
  for (int a = 0; a < 2; ++a)
#pragma unroll
    for (int b = 0; b < 2; ++b)
#pragma unroll
      for (int m = 0; m < 4; ++m)
#pragma unroll
        for (int n = 0; n < 2; ++n) acc[a][b][m][n] = f32x4v{0.f, 0.f, 0.f, 0.f};
  {
  const int wid = tid >> 6, lane = tid & 63, wr = wid >> 2, wc = wid & 3, fr = lane & 15, fq = lane >> 4;
  bf16x8 At[4][2], B0[2][2], B1[2][2];
  const int nt = K / BK;
  asm volatile("s_waitcnt lgkmcnt(0)" ::: "memory");
  __builtin_amdgcn_s_barrier();
  STAGE8(SB8(0,0),Bt,0,0); STAGE8(SA8(0,0),A,0,0);
  STAGE8(SB8(0,1),Bt,HALF,0); STAGE8(SA8(0,1),A,HALF,0);
  if (wr == 1) BAR8;
  WAIT_V8(4); BAR8;
  STAGE8(SB8(1,0),Bt,0,1); STAGE8(SA8(1,0),A,0,1); STAGE8(SB8(1,1),Bt,HALF,1);
  WAIT_V8(6); BAR8;
  for (int t = 0; t < nt - 2; t += 2) {
    LDB8(B0,0,0); SCHED8; LDA8(At,0,0); STAGE8(SA8(1,1),A,HALF,t+1);
    WAIT_L8(8); BAR8; WAIT_L8(0); MMA8C(0,0,At,B0); BAR8; SCHED8;
    LDB8(B1,0,1); STAGE8(SB8(0,0),Bt,0,t+2);
    BAR8; WAIT_L8(0); MMA8C(0,1,At,B1); BAR8;
    LDA8(At,0,1); STAGE8(SA8(0,0),A,0,t+2);
    BAR8; WAIT_L8(0); MMA8C(1,0,At,B0); BAR8; SCHED8;
    STAGE8(SB8(0,1),Bt,HALF,t+2);
    WAIT_V8(6); BAR8; MMA8C(1,1,At,B1); BAR8;
    LDB8(B0,1,0); SCHED8; LDA8(At,1,0); STAGE8(SA8(0,1),A,HALF,t+2);
    WAIT_L8(8); BAR8; WAIT_L8(0); MMA8C(0,0,At,B0); BAR8; SCHED8;
    LDB8(B1,1,1); STAGE8(SB8(1,0),Bt,0,t+3);
    BAR8; WAIT_L8(0); MMA8C(0,1,At,B1); BAR8;
    LDA8(At,1,1); STAGE8(SA8(1,0),A,0,t+3);
    BAR8; WAIT_L8(0); MMA8C(1,0,At,B0); BAR8; SCHED8;
    STAGE8(SB8(1,1),Bt,HALF,t+3);
    WAIT_V8(6); BAR8; MMA8C(1,1,At,B1); BAR8;
  }
  { LDB8(B0,0,0); LDA8(At,0,0); STAGE8(SA8(1,1),A,HALF,nt-1);
    BAR8; WAIT_L8(0); MMA8C(0,0,At,B0); BAR8;
    LDB8(B1,0,1); BAR8; WAIT_L8(0); MMA8C(0,1,At,B1); BAR8;
    LDA8(At,0,1); WAIT_V8(4); BAR8; WAIT_L8(0); MMA8C(1,0,At,B0); MMA8C(1,1,At,B1); BAR8; }
  { LDB8(B0,1,0); LDA8(At,1,0); WAIT_V8(2); BAR8; WAIT_L8(0); MMA8C(0,0,At,B0); BAR8;
    LDB8(B1,1,1); WAIT_V8(0); BAR8; WAIT_L8(0); MMA8C(0,1,At,B1); BAR8;
    LDA8(At,1,1); BAR8; WAIT_L8(0); MMA8C(1,0,At,B0); MMA8C(1,1,At,B1); BAR8; }
  if (wr == 0) BAR8;
  }

  const int mode = g.mode;
  unsigned char* wreg;
  int lane, wr, wc, fr, fq;
  { const int t2 = TIDX(); const int w2 = t2 >> 6; lane = t2 & 63; wr = w2 >> 2; wc = w2 & 3; fr = lane & 15; fq = lane >> 4; wreg = smem + w2 * 17408; }
  if (mode == M_RESID) {
#pragma unroll
    for (int bj = 0; bj < 2; ++bj) {
#pragma unroll
      for (int ai = 0; ai < 2; ++ai)
#pragma unroll
        for (int m = 0; m < 4; ++m)
#pragma unroll
          for (int n = 0; n < 2; ++n)
            *(f32x4v*)(wreg + (n * 16 + fr) * 528 + (ai * 64 + m * 16 + fq * 4) * 4) = acc[ai][bj][m][n];
#pragma unroll
      for (int it = 0; it < 16; ++it) {
        const int row = 2 * it + (lane >> 5), c4 = lane & 31;
        const float4 v = *(const float4*)(wreg + row * 528 + c4 * 16);
        const int ai = c4 >> 4, iin = (c4 & 15) * 4;
        const size_t o = (size_t)(g.C0 + bj * 128 + wc * 32 + row) * 2048 + g.R0 + ai * 128 + wr * 64 + iin;
        const float4 x = *(const float4*)(g.xin + o);
        *(float4*)(g.d32 + o) = make_float4(x.x + v.x, x.y + v.y, x.z + v.z, x.w + v.w);
      }
    }
    return;
  }
  if (mode == M_ROPE) {
#pragma unroll
    for (int bj = 0; bj < 2; ++bj)
#pragma unroll
      for (int n = 0; n < 2; ++n) {
        const int tok = g.C0 + bj * 128 + wc * 32 + n * 16 + fr;
        const float sc = g.scale * (g.rs ? g.rs[tok] : 1.f);
#pragma unroll
        for (int ai = 0; ai < 2; ++ai) {
          if (ai * 128 + wr * 64 < g.aux) {
#pragma unroll
            for (int m = 0; m < 2; ++m) {
              const int c0 = m * 16 + fq * 4;
              const float4 cs = *(const float4*)(g.cs + (size_t)tok * 32 + c0);
              const float4 sn = *(const float4*)(g.sn + (size_t)tok * 32 + c0);
              const f32x4v a = acc[ai][bj][m][n] * sc, b = acc[ai][bj][m + 2][n] * sc;
              u32x2 o1, o2;
              o1[0] = pack_bf16(a[0] * cs.x - b[0] * sn.x, a[1] * cs.y - b[1] * sn.y);
              o1[1] = pack_bf16(a[2] * cs.z - b[2] * sn.z, a[3] * cs.w - b[3] * sn.w);
              o2[0] = pack_bf16(b[0] * cs.x + a[0] * sn.x, b[1] * cs.y + a[1] * sn.y);
              o2[1] = pack_bf16(b[2] * cs.z + a[2] * sn.z, b[3] * cs.w + a[3] * sn.w);
              u16* dp = g.d16 + (size_t)tok * g.ld + g.R0 + ai * 128 + wr * 64 + c0;
              *(u32x2*)dp = o1;
              *(u32x2*)(dp + 32) = o2;
            }
          }
        }
      }
    return;
  }
  {
    const int fqp = g.perm ? (((fq & 1) << 1) | (fq >> 1)) : fq;
    unsigned char* wb = wreg + fr * 272 + fqp * 8;
    if (mode == M_BF16) {
#pragma unroll
      for (int bj = 0; bj < 2; ++bj)
#pragma unroll
        for (int n = 0; n < 2; ++n) {
          const int outer = g.C0 + bj * 128 + wc * 32 + n * 16 + fr;
          const float sc = g.scale * (g.rs ? g.rs[outer] : 1.f);
#pragma unroll
          for (int ai = 0; ai < 2; ++ai)
#pragma unroll
            for (int m = 0; m < 4; ++m) {
              const f32x4v v = acc[ai][bj][m][n] * sc;
              u32x2 pk; pk[0] = pack_bf16(v[0], v[1]); pk[1] = pack_bf16(v[2], v[3]);
              *(u32x2*)(wb + (bj * 32 + n * 16) * 272 + (ai * 64 + m * 16) * 2) = pk;
            }
        }
    } else if (mode == M_SILU) {
#pragma unroll
      for (int bj = 0; bj < 2; ++bj)
#pragma unroll
        for (int n = 0; n < 2; ++n)
#pragma unroll
          for (int ai = 0; ai < 2; ++ai)
#pragma unroll
            for (int m = 0; m < 4; ++m) {
              const f32x4v v = acc[ai][bj][m][n];
              u32x2 pk; pk[0] = pack_bf16(silu_f(v[0]), silu_f(v[1])); pk[1] = pack_bf16(silu_f(v[2]), silu_f(v[3]));
              *(u32x2*)(wb + (bj * 32 + n * 16) * 272 + (ai * 64 + m * 16) * 2) = pk;
            }
    } else {
      const float* rsp = g.rs ? g.rs + g.R0 + wr * 64 + fq * 4 : nullptr;
#pragma unroll
      for (int ai = 0; ai < 2; ++ai)
#pragma unroll
        for (int m = 0; m < 4; ++m) {
          float4 r4 = make_float4(1.f, 1.f, 1.f, 1.f);
          if (rsp) r4 = *(const float4*)(rsp + ai * 128 + m * 16);
#pragma unroll
          for (int bj = 0; bj < 2; ++bj)
#pragma unroll
            for (int n = 0; n < 2; ++n) {
              const f32x4v v = acc[ai][bj][m][n];
              u32x2 pk; pk[0] = pack_bf16(v[0] * r4.x, v[1] * r4.y); pk[1] = pack_bf16(v[2] * r4.z, v[3] * r4.w);
              *(u32x2*)(wb + (bj * 32 + n * 16) * 272 + (ai * 64 + m * 16) * 2) = pk;
            }
        }
    }
  }
  {
    const int ch = lane & 15, rsub = lane >> 4, ai = ch >> 3;
    const int outer0 = g.C0 + wc * 32 + rsub;
    const int inner0 = g.R0 + ai * 128 + wr * 64 + (ch & 7) * 8;
    size_t obase, ostride;
    if (mode == M_TRANS) { obase = ((size_t)(inner0 >> 13) * g.aux + outer0) * 8192 + (inner0 & 8191); ostride = 8192; }
    else { obase = (size_t)outer0 * g.ld + inner0; ostride = (size_t)g.ld; }
    const unsigned char* rb = wreg + rsub * 272 + ch * 16;
    u16* dp = g.d16 + obase;
#pragma unroll
    for (int it = 0; it < 16; ++it) {
      const u32x4 v = *(const u32x4*)(rb + it * 4 * 272);
      *(u32x4*)(dp + (size_t)((it >> 3) * 128 + (it & 7) * 4) * ostride) = v;
    }
  }
}

template <int DK, bool SB, int LDQN, int LDQR, int LDKN, int LDKR, int LDG>
DI void attn_item(const u16* __restrict__ Qn, const u16* __restrict__ Qr,
                  const u16* __restrict__ Kn, const u16* __restrict__ Kr,
                  const u16* __restrict__ Vt, const u16* __restrict__ Gt,
                  u16* __restrict__ Y, int q0, unsigned char* smem, int probe = 0) {
  constexpr int KS = DK / 16;
  constexpr int KROW_B = DK * 2;
  constexpr int KCH = DK / 8;
  constexpr int K_B = 64 * KROW_B;
  constexpr int STAGE_B = K_B + 128 * 128;
  constexpr int NKI = K_B / 8192;
  constexpr int G = NKI + 2;
  volatile __attribute__((address_space(3))) int* sflag = (volatile __attribute__((address_space(3))) int*)(smem + 3 * STAGE_B);
  const int tid = TIDX(), lane = tid & 63, wave = tid >> 6;
  const int r = lane & 31, h = lane >> 5;
  const int qrow = q0 + 32 * wave + r;
  const int qmin = q0 + 32 * wave, qmax = qmin + 31;

  bf16x8 bq[KS];
  {
    const u16* qp = Qn + (unsigned)(qrow * LDQN + 8 * h);
#pragma unroll
    for (int ks = 0; ks < 8; ++ks) bq[ks] = *(const bf16x8*)(qp + 16 * ks);
    if constexpr (!SB) {
      const u16* qp2 = Qr + (unsigned)(qrow * LDQR + 8 * h);
#pragma unroll
      for (int ks = 8; ks < KS; ++ks) bq[ks] = *(const bf16x8*)(qp2 + 16 * (ks - 8));
    }
  }
  f32x16 O[4];
#pragma unroll
  for (int d = 0; d < 4; ++d)
#pragma unroll
    for (int q = 0; q < 16; ++q) O[d][q] = 0.f;
  float m_run = -INFINITY, l_run = 0.f, R = 0.f;
  const int nt = (q0 >> 6) + 4;

  const u16* kbase[NKI]; unsigned isr = 0u; unsigned voff0;
#pragma unroll
  for (int j = 0; j < NKI; ++j) {
    const int L = 64 * (wave + 8 * j) + lane, row = L / KCH, p = L - row * KCH;
    const int c = SB ? (p ^ (row & 15)) : ((p & ~7) | ((p & 7) ^ ((row >> 1) & 7)));
    if (SB || c < 16) { kbase[j] = Kn + (unsigned)(row * LDKN + c * 8); }
    else { kbase[j] = Kr + (unsigned)(row * LDKR + (c - 16) * 8); isr |= 1u << j; }
  }
  {
    const int L = 64 * wave + lane, row = L >> 3, p = L & 7;
    voff0 = (unsigned)(row * 8192 + (p ^ ((row >> 1) & 7)) * 8);
  }
  auto issue_tile = [&](int kt, int st) {
    unsigned char* sKb = smem + st * STAGE_B;
#pragma unroll
    for (int j = 0; j < NKI; ++j) {
      const unsigned kstr = ((isr >> j) & 1u) ? 64u * LDKR : 64u * LDKN;
      __builtin_amdgcn_global_load_lds((const unsigned*)(kbase[j] + (size_t)kt * kstr),
                                       (unsigned*)(sKb + (wave + 8 * j) * 1024), 16, 0, 0);
    }
    const u16* vb_ = Vt + kt * 64;
#pragma unroll
    for (int j = 0; j < 2; ++j)
      __builtin_amdgcn_global_load_lds((const unsigned*)(vb_ + (size_t)j * 64 * 8192 + voff0),
                                       (unsigned*)(sKb + K_B + (wave + 8 * j) * 1024), 16, 0, 0);
  };
  const int s3 = (r >> 1) & 7, s4 = r & 15;

  asm volatile("s_waitcnt vmcnt(0)" ::: "memory");
  __syncthreads();
  issue_tile(SB ? nt - 1 : 0, 0);
  issue_tile(SB ? nt - 2 : 1, 1);
  asm volatile("s_waitcnt vmcnt(%0)" :: "n"(G) : "memory");
  asm volatile("s_waitcnt lgkmcnt(0)" ::: "memory");
  __builtin_amdgcn_s_barrier();
  auto tile_body = [&](int it, auto st_c) -> bool {
    constexpr int ST = decltype(st_c)::value;
    const int kt = SB ? (nt - 1 - it) : it;
    if (it + 2 < nt && !(PROBE_MODE == 3 && probe)) issue_tile(SB ? (nt - 3 - it) : (it + 2), (ST + 2) % 3);
    __builtin_amdgcn_sched_barrier(0);
    const unsigned char* sK = smem + ST * STAGE_B;
    const unsigned char* sV = sK + K_B;
    auto kchunk = [&](int ks) -> int {
      const int c = 2 * ks + h;
      return (SB ? (c ^ s4) : ((c & ~7) | ((c & 7) ^ s3))) * 16;
    };
    const int kbA = SB ? 1 : 0, kbB = SB ? 0 : 1;
    const int keyA = kt * 64 + 32 * kbA, keyB = kt * 64 + 32 * kbB;
    const bool skipA = SB ? (keyA >= qmax) : (keyA > qmax);
    const bool skipB = SB ? (keyB >= qmax) : (keyB > qmax);
    f32x16 SA_, SB_;
    {
      bf16x8 kf[KS];
      if (!skipA) {
        const unsigned char* kp = sK + (32 * kbA + r) * KROW_B;
#pragma unroll
        for (int ks = 0; ks < KS; ++ks) kf[ks] = *(const bf16x8*)(kp + kchunk(ks));
#pragma unroll
        for (int q = 0; q < 16; ++q) SA_[q] = 0.f;
        __builtin_amdgcn_sched_barrier(0);
#pragma unroll
        for (int ks = 0; ks < KS; ++ks) SA_ = MFMA32(kf[ks], bq[ks], SA_);
        __builtin_amdgcn_sched_barrier(0);
      }
      if (!skipB) {
        const unsigned char* kp = sK + (32 * kbB + r) * KROW_B;
#pragma unroll
        for (int ks = 0; ks < KS; ++ks) kf[ks] = *(const bf16x8*)(kp + kchunk(ks));
#pragma unroll
        for (int q = 0; q < 16; ++q) SB_[q] = 0.f;
        __builtin_amdgcn_sched_barrier(0);
#pragma unroll
        for (int ks = 0; ks < KS; ++ks) SB_ = MFMA32(kf[ks], bq[ks], SB_);
        __builtin_amdgcn_sched_barrier(0);
      }
    }
    auto math_pv = [&](f32x16& Sx, const int kb, const int key0) {
      bf16x8 vf[8];
#pragma unroll
      for (int d = 0; d < 4; ++d) vf[d] = *(const bf16x8*)(sV + (32 * d + r) * 128 + (((4 * kb + h) ^ s3) * 16));
      __builtin_amdgcn_sched_barrier(0);
      if constexpr (!SB) {
       if (!(PROBE_MODE == 4 && probe)) {
        if (key0 + 31 > qmin) {
#pragma unroll
          for (int q = 0; q < 16; ++q)
            if (key0 + crow(q, h) > qrow) Sx[q] = -INFINITY;
        }
        float mloc = Sx[0];
#pragma unroll
        for (int q = 1; q < 16; ++q) mloc = fmaxf(mloc, Sx[q]);
        mloc = xh_max(mloc);
        float mnew = m_run, alpha = 1.f;
        const bool need = __builtin_amdgcn_ballot_w64(mloc > m_run + 8.f) != 0ull;
        if (need) {
          mnew = fmaxf(m_run, mloc);
          alpha = __builtin_amdgcn_exp2f(m_run - mnew);
          m_run = mnew;
        }
        typedef float f32x2v __attribute__((ext_vector_type(2)));
        const f32x2v mm = {mnew, mnew};
        f32x2v ls2 = {0.f, 0.f};
#pragma unroll
        for (int q = 0; q < 8; ++q) {
          f32x2v t = {Sx[2 * q], Sx[2 * q + 1]};
          t = t - mm;
          t[0] = __builtin_amdgcn_exp2f(t[0]);
          t[1] = __builtin_amdgcn_exp2f(t[1]);
          Sx[2 * q] = t[0]; Sx[2 * q + 1] = t[1];
          ls2 = ls2 + t;
        }
        const float lsum = ls2[0] + ls2[1];
        l_run = l_run * alpha + lsum;
        if (need) {
#pragma unroll
          for (int d = 0; d < 4; ++d)
#pragma unroll
            for (int q = 0; q < 16; ++q) O[d][q] *= alpha;
        }
       }
      } else {
        f32x16 Lx;
        float gs[4], ps[4];
        if (key0 + 31 < qmin) {
#pragma unroll
          for (int q = 0; q < 16; ++q) {
            const float z0 = Sx[q];
            Lx[q] = -(fmaxf(z0, 0.f) + __builtin_amdgcn_logf(1.f + __builtin_amdgcn_exp2f(-fabsf(z0))));
          }
#pragma unroll
          for (int gq = 0; gq < 4; ++gq) {
            gs[gq] = (Lx[4 * gq] + Lx[4 * gq + 1]) + (Lx[4 * gq + 2] + Lx[4 * gq + 3]);
            ps[gq] = xh_partner(gs[gq], h);
          }
          float run = 0.f;
#pragma unroll
          for (int gq = 3; gq >= 0; --gq) {
            const float own = R + run + (h == 0 ? ps[gq] : 0.f);
            run += gs[gq] + ps[gq];
            const float a3 = own, a2 = a3 + Lx[4 * gq + 3], a1 = a2 + Lx[4 * gq + 2], a0 = a1 + Lx[4 * gq + 1];
            Sx[4 * gq + 0] = __builtin_amdgcn_exp2f(Sx[4 * gq + 0] + Lx[4 * gq + 0] + a0);
            Sx[4 * gq + 1] = __builtin_amdgcn_exp2f(Sx[4 * gq + 1] + Lx[4 * gq + 1] + a1);
            Sx[4 * gq + 2] = __builtin_amdgcn_exp2f(Sx[4 * gq + 2] + Lx[4 * gq + 2] + a2);
            Sx[4 * gq + 3] = __builtin_amdgcn_exp2f(Sx[4 * gq + 3] + Lx[4 * gq + 3] + a3);
          }
          R += run;
        } else {
#pragma unroll
          for (int q = 0; q < 16; ++q) {
            const float z0 = Sx[q];
            const float sp0 = fmaxf(z0, 0.f) + __builtin_amdgcn_logf(1.f + __builtin_amdgcn_exp2f(-fabsf(z0)));
            Lx[q] = (key0 + crow(q, h) < qrow) ? -sp0 : 0.f;
          }
#pragma unroll
          for (int gq = 0; gq < 4; ++gq) {
            gs[gq] = (Lx[4 * gq] + Lx[4 * gq + 1]) + (Lx[4 * gq + 2] + Lx[4 * gq + 3]);
            ps[gq] = xh_partner(gs[gq], h);
          }
          float run = 0.f;
#pragma unroll
          for (int gq = 3; gq >= 0; --gq) {
            const float own = R + run + (h == 0 ? ps[gq] : 0.f);
            run += gs[gq] + ps[gq];
            const int key = key0 + 8 * gq + 4 * h;
            const float a3 = own, a2 = a3 + Lx[4 * gq + 3], a1 = a2 + Lx[4 * gq + 2], a0 = a1 + Lx[4 * gq + 1];
            const float e0 = __builtin_amdgcn_exp2f(Sx[4 * gq + 0] + Lx[4 * gq + 0] + a0);
            const float e1 = __builtin_amdgcn_exp2f(Sx[4 * gq + 1] + Lx[4 * gq + 1] + a1);
            const float e2 = __builtin_amdgcn_exp2f(Sx[4 * gq + 2] + Lx[4 * gq + 2] + a2);
            const float e3 = __builtin_amdgcn_exp2f(Sx[4 * gq + 3] + Lx[4 * gq + 3] + a3);
            Sx[4 * gq + 0] = (key + 0 < qrow) ? e0 : 0.f;
            Sx[4 * gq + 1] = (key + 1 < qrow) ? e1 : 0.f;
            Sx[4 * gq + 2] = (key + 2 < qrow) ? e2 : 0.f;
            Sx[4 * gq + 3] = (key + 3 < qrow) ? e3 : 0.f;
          }
          R += run;
        }
      }
      const bf16x8 pf0 = pack8(Sx, 0), pf1 = pack8(Sx, 1);
      __builtin_amdgcn_sched_barrier(0);
#pragma unroll
      for (int d = 0; d < 4; ++d) vf[4 + d] = *(const bf16x8*)(sV + (32 * d + r) * 128 + (((4 * kb + 2 + h) ^ s3) * 16));
#pragma unroll
      for (int d = 0; d < 4; ++d) O[d] = MFMA32(vf[d], pf0, O[d]);
      __builtin_amdgcn_sched_barrier(0);
#pragma unroll
      for (int d = 0; d < 4; ++d) O[d] = MFMA32(vf[4 + d], pf1, O[d]);
      __builtin_amdgcn_sched_barrier(0);
    };
    if (!skipA) math_pv(SA_, kbA, keyA);
    if (!skipB) math_pv(SB_, kbB, keyB);
    if constexpr (SB) {
      const bool done = (__builtin_amdgcn_ballot_w64(!(R < -150.1f)) == 0ull);
      if (lane == 0) sflag[(it & 1) * 8 + wave] = done ? 1 : 0;
    }
    if (it + 2 < nt) asm volatile("s_waitcnt vmcnt(%0)" :: "n"(G) : "memory");
    else asm volatile("s_waitcnt vmcnt(0)" ::: "memory");
    asm volatile("s_waitcnt lgkmcnt(0)" ::: "memory");
    __builtin_amdgcn_s_barrier();
    if constexpr (SB) {
      const volatile __attribute__((address_space(3))) int* f = sflag + (it & 1) * 8;
      if (f[0] & f[1] & f[2] & f[3] & f[4] & f[5] & f[6] & f[7]) return true;
    }
    return false;
  };
  for (int it = 0; it < nt; it += 3) {
    if (tile_body(it, std::integral_constant<int, 0>{})) break;
    if (it + 1 >= nt) break;
    if (tile_body(it + 1, std::integral_constant<int, 1>{})) break;
    if (it + 2 >= nt) break;
    if (tile_body(it + 2, std::integral_constant<int, 2>{})) break;
  }

  if (PROBE_MODE >= 3 && probe) {
    float sacc = l_run;
#pragma unroll
    for (int d = 0; d < 4; ++d)
#pragma unroll
      for (int q = 0; q < 16; ++q) sacc += O[d][q];
    if (sacc == 1.2345e-30f) Y[0] = 0;
    return;
  }
  float inv = 1.f;
  if constexpr (!SB) {
    const float lt = xh_sum(l_run);
    inv = 1.f / lt;
  }
  const u16* gp16 = Gt + (unsigned)(qrow * LDG + 8 * h);
  u16* yp = Y + (unsigned)(qrow * 2048 + 8 * h);
#pragma unroll
  for (int d = 0; d < 4; ++d)
#pragma unroll
    for (int pq = 0; pq < 2; ++pq) {
      u32x2 oa, ob;
      const u32x4 g16 = *(const u32x4*)(gp16 + 32 * d + 16 * pq);
      const auto s0 = __builtin_amdgcn_permlane32_swap(g16[0], g16[2], false, false);
      const auto s1 = __builtin_amdgcn_permlane32_swap(g16[1], g16[3], false, false);
      {
        const int gq = 2 * pq;
        oa[0] = pack_bf16(O[d][4 * gq + 0] * inv * bf_lo(s0[0]), O[d][4 * gq + 1] * inv * bf_hi(s0[0]));
        oa[1] = pack_bf16(O[d][4 * gq + 2] * inv * bf_lo(s1[0]), O[d][4 * gq + 3] * inv * bf_hi(s1[0]));
      }
      {
        const int gq = 2 * pq + 1;
        ob[0] = pack_bf16(O[d][4 * gq + 0] * inv * bf_lo(s0[1]), O[d][4 * gq + 1] * inv * bf_hi(s0[1]));
        ob[1] = pack_bf16(O[d][4 * gq + 2] * inv * bf_lo(s1[1]), O[d][4 * gq + 3] * inv * bf_hi(s1[1]));
      }
      const auto r0 = __builtin_amdgcn_permlane32_swap(oa[0], ob[0], false, false);
      const auto r1 = __builtin_amdgcn_permlane32_swap(oa[1], ob[1], false, false);
      u32x4 st; st[0] = r0[0]; st[1] = r1[0]; st[2] = r0[1]; st[3] = r1[1];
      *(u32x4*)(yp + 32 * d + 16 * pq) = st;
    }
}

DI void gla_g1(const Params& p, int li, int unit, unsigned char* smem) {
  const int c = unit & 127, bh = unit >> 7, b = bh >> 2, hh = bh & 3;
  const size_t m0 = (size_t)b * S_ + c * 64;
  float* lf = (float*)smem;
  u16* klT = (u16*)(smem + 32768);
  const float* GA = (const float*)(p.ws + E_GA);
  u16* GQ = (u16*)(p.ws + E_GQ);
  u16* GK = (u16*)(p.ws + E_GK);
  const u16* GVT = (const u16*)(p.ws + E_GVT);
  float* EBL = (float*)(p.ws + E_EBL);
  float* SC = (float*)(p.ws + E_SC);
  const float* au_p = p.alpha_up + (size_t)li * 16 * 512;
  const float* bias_p = p.alpha_bias + (size_t)li * 512;
  const int tid = TIDX(), lane = tid & 63, wave = tid >> 6;
  const int r = lane & 31, h = lane >> 5;
  {
    const int d = tid & 127, th = tid >> 7;
    float au[16];
#pragma unroll
    for (int q = 0; q < 16; ++q) au[q] = au_p[q * 512 + hh * 128 + d];
    const float bs = bias_p[hh * 128 + d];
    for (int tt = 0; tt < 16; ++tt) {
      const int t = th * 16 + tt;
      const float4* ga = (const float4*)(GA + (m0 + t) * 16);
      float s = bs;
#pragma unroll
      for (int q = 0; q < 4; ++q) {
        const float4 g4 = ga[q];
        s += g4.x * au[4 * q] + g4.y * au[4 * q + 1] + g4.z * au[4 * q + 2] + g4.w * au[4 * q + 3];
      }
      const float sp = fmaxf(-s, 0.f) + __logf(1.f + __expf(-fabsf(s)));
      lf[t * 128 + d] = -sp * (1.f / 16.f);
    }
  }
  __syncthreads();
  {
    const int d = tid & 127, sg = tid >> 7;
    float run = 0.f;
#pragma unroll
    for (int t = 0; t < 16; ++t) { run += lf[(sg * 16 + t) * 128 + d]; lf[(sg * 16 + t) * 128 + d] = run; }
    __syncthreads();
    float off = 0.f;
    if (sg > 0) off += lf[15 * 128 + d];
    if (sg > 1) off += lf[31 * 128 + d];
    if (sg > 2) off += lf[47 * 128 + d];
    __syncthreads();
    if (sg > 0) {
#pragma unroll
      for (int t = 0; t < 16; ++t) lf[(sg * 16 + t) * 128 + d] += off;
    }
  }
  __syncthreads();
#pragma unroll 1
  for (int i = 0; i < 2; ++i) {
    const int idx = tid + 512 * i;
    const int t = idx >> 4, d0 = (idx & 15) * 8;
    u16* qp = GQ + (m0 + t) * 512 + hh * 128 + d0;
    u16* kp = GK + (m0 + t) * 512 + hh * 128 + d0;
    const u32x4 qv = *(const u32x4*)qp;
    const u32x4 kv = *(const u32x4*)kp;
    u32x4 qo, ko;
#pragma unroll
    for (int jj = 0; jj < 4; ++jj) {
      const float bb0 = lf[t * 128 + d0 + 2 * jj], bb1 = lf[t * 128 + d0 + 2 * jj + 1];
      const float bl0 = lf[63 * 128 + d0 + 2 * jj], bl1 = lf[63 * 128 + d0 + 2 * jj + 1];
      const float q0 = bf_lo(qv[jj]), q1 = bf_hi(qv[jj]);
      const float k0 = bf_lo(kv[jj]), k1 = bf_hi(kv[jj]);
      qo[jj] = pack_bf16(q0 * 0.08838834764831845f * __expf(bb0), q1 * 0.08838834764831845f * __expf(bb1));
      ko[jj] = pack_bf16(k0 * __expf(-bb0), k1 * __expf(-bb1));
      klT[(d0 + 2 * jj) * 72 + t] = to_bf16(k0 * __expf(bl0 - bb0));
      klT[(d0 + 2 * jj + 1) * 72 + t] = to_bf16(k1 * __expf(bl1 - bb1));
    }
    *(u32x4*)qp = qo;
    *(u32x4*)kp = ko;
  }
  if (tid < 128) EBL[(size_t)unit * 128 + tid] = __expf(lf[63 * 128 + tid]);
  __syncthreads();
  {
    f32x16 acc[4];
#pragma unroll
    for (int j = 0; j < 4; ++j)
#pragma unroll
      for (int q = 0; q < 16; ++q) acc[j][q] = 0.f;
    const u16* vp = GVT + ((size_t)(bh * 256 + 32 * wave + r)) * 8192 + c * 64 + 8 * h;
#pragma unroll
    for (int ks = 0; ks < 4; ++ks) {
      const bf16x8 bv = *(const bf16x8*)(vp + 16 * ks);
#pragma unroll
      for (int db = 0; db < 4; ++db) {
        const bf16x8 ak = *(const bf16x8*)(klT + (32 * db + r) * 72 + 16 * ks + 8 * h);
        acc[db] = MFMA32(ak, bv, acc[db]);
      }
    }
    u16* SC16 = (u16*)SC;
    u16* sp = SC16 + ((size_t)unit * 256 + 32 * wave + r) * 128 + 4 * h;
#pragma unroll
    for (int db = 0; db < 4; ++db)
#pragma unroll
      for (int g4 = 0; g4 < 4; ++g4) {
        u32x2 pk;
        pk[0] = pack_bf16(acc[db][4 * g4 + 0], acc[db][4 * g4 + 1]);
        pk[1] = pack_bf16(acc[db][4 * g4 + 2], acc[db][4 * g4 + 3]);
        *(u32x2*)(sp + 32 * db + 8 * g4) = pk;
      }
  }
  __syncthreads();
}

DI void gla_scan(const Params& p) {
  u16* SC16 = (u16*)(p.ws + E_SC);
  const float* EBL = (const float*)(p.ws + E_EBL);
  for (int cp = blockIdx.x * 512 + TIDX(); cp < 131072; cp += gridDim.x * 512) {
    const int bh = cp >> 14, rem = cp & 16383, e = rem >> 6, d2 = (rem & 63) * 2;
    u16* base = SC16 + ((size_t)(bh * 128) * 256 + e) * 128 + d2;
    const float* eb = EBL + (size_t)(bh * 128) * 128 + d2;
    float sx = 0.f, sy = 0.f;
#pragma unroll 8
    for (int c = 0; c < 128; ++c) {
      const unsigned sv = *(const unsigned*)(base + (size_t)c * 32768);
      const float2 f = *(const float2*)(eb + c * 128);
      *(unsigned*)(base + (size_t)c * 32768) = pack_bf16(sx, sy);
      sx = f.x * sx + bf_lo(sv);
      sy = f.y * sy + bf_hi(sv);
    }
  }
}

DI void gla_g3(const Params& p, int li, int unit, unsigned char* smem) {
  const int c = unit & 127, bh = unit >> 7, b = bh >> 2, hh = bh & 3;
  const size_t m0 = (size_t)b * S_ + c * 64;
  float* red = (float*)smem;
  const u16* GQ = (const u16*)(p.ws + E_GQ);
  const u16* GK = (const u16*)(p.ws + E_GK);
  const u16* GVT = (const u16*)(p.ws + E_GVT);
  const u16* GG = (const u16*)(p.ws + E_GG);
  const float* SC = (const float*)(p.ws + E_SC);
  u16* Y = (u16*)(p.ws + OFF_H);
  const float* gn = p.gla_norm + (size_t)li * 256;
  const int tid = TIDX(), lane = tid & 63, wave = tid >> 6;
  const int r = lane & 31, h = lane >> 5;

  bf16x8 bq[2][8];
#pragma unroll
  for (int ib = 0; ib < 2; ++ib)
#pragma unroll
    for (int ks = 0; ks < 8; ++ks)
      bq[ib][ks] = *(const bf16x8*)(GQ + (m0 + 32 * ib + r) * 512 + hh * 128 + 16 * ks + 8 * h);
  f32x16 X00, X01, X11;
#pragma unroll
  for (int q = 0; q < 16; ++q) { X00[q] = 0.f; X01[q] = 0.f; X11[q] = 0.f; }
#pragma unroll
  for (int ks = 0; ks < 8; ++ks) {
    const bf16x8 a0 = *(const bf16x8*)(GK + (m0 + r) * 512 + hh * 128 + 16 * ks + 8 * h);
    const bf16x8 a1 = *(const bf16x8*)(GK + (m0 + 32 + r) * 512 + hh * 128 + 16 * ks + 8 * h);
    X00 = MFMA32(a0, bq[0][ks], X00);
    X01 = MFMA32(a0, bq[1][ks], X01);
    X11 = MFMA32(a1, bq[1][ks], X11);
  }
#pragma unroll
  for (int q = 0; q < 16; ++q) {
    if (crow(q, h) > r) { X00[q] = 0.f; X11[q] = 0.f; }
  }
  f32x16 acc[2];
#pragma unroll
  for (int j = 0; j < 2; ++j)
#pragma unroll
    for (int q = 0; q < 16; ++q) acc[j][q] = 0.f;
  {
    const u16* st = (const u16*)SC + ((size_t)unit * 256 + 32 * wave + r) * 128 + 8 * h;
#pragma unroll
    for (int ks = 0; ks < 8; ++ks) {
      const bf16x8 a = *(const bf16x8*)(st + 16 * ks);
      acc[0] = MFMA32(a, bq[0][ks], acc[0]);
      acc[1] = MFMA32(a, bq[1][ks], acc[1]);
    }
  }
  {
    const u16* vr = GVT + ((size_t)(bh * 256 + 32 * wave + r)) * 8192 + c * 64;
#pragma unroll
    for (int s = 0; s < 2; ++s) {
      const bf16x8 pf00 = pack8(X00, s), pf01 = pack8(X01, s), pf11 = pack8(X11, s);
      {
        const s16x4 lo = *(const s16x4*)(vr + 16 * s + 4 * h);
        const s16x4 hi = *(const s16x4*)(vr + 16 * s + 8 + 4 * h);
        const bf16x8 a = __builtin_shufflevector(lo, hi, 0, 1, 2, 3, 4, 5, 6, 7);
        acc[0] = MFMA32(a, pf00, acc[0]);
        acc[1] = MFMA32(a, pf01, acc[1]);
      }
      {
        const s16x4 lo = *(const s16x4*)(vr + 32 + 16 * s + 4 * h);
        const s16x4 hi = *(const s16x4*)(vr + 32 + 16 * s + 8 + 4 * h);
        const bf16x8 a = __builtin_shufflevector(lo, hi, 0, 1, 2, 3, 4, 5, 6, 7);
        acc[1] = MFMA32(a, pf11, acc[1]);
      }
    }
  }
  float rstd[2];
#pragma unroll
  for (int ib = 0; ib < 2; ++ib) {
    float ss = 0.f;
#pragma unroll
    for (int q = 0; q < 16; ++q) ss += acc[ib][q] * acc[ib][q];
    ss = xh_sum(ss);
    if (h == 0) red[wave * 64 + 32 * ib + r] = ss;
  }
  __syncthreads();
#pragma unroll
  for (int ib = 0; ib < 2; ++ib) {
    float tot = 0.f;
#pragma unroll
    for (int w = 0; w < 8; ++w) tot += red[w * 64 + 32 * ib + r];
    rstd[ib] = rsqrtf(tot * (1.f / 256.f) + 1e-6f);
  }
#pragma unroll
  for (int ib = 0; ib < 2; ++ib)
#pragma unroll
    for (int pq = 0; pq < 2; ++pq) {
      const size_t m = m0 + 32 * ib + r;
      const int e16 = 32 * wave + 16 * pq + 8 * h;
      const u32x4 g16 = *(const u32x4*)(GG + m * 1024 + hh * 256 + e16);
      const auto s0 = __builtin_amdgcn_permlane32_swap(g16[0], g16[2], false, false);
      const auto s1 = __builtin_amdgcn_permlane32_swap(g16[1], g16[3], false, false);
      const float rs = rstd[ib];
      u32x2 oa, ob;
      {
        const int gq = 2 * pq, e = 32 * wave + 8 * gq + 4 * h;
        const float4 g4 = *(const float4*)(gn + e);
        oa[0] = pack_bf16(acc[ib][4 * gq + 0] * rs * g4.x * bf_lo(s0[0]), acc[ib][4 * gq + 1] * rs * g4.y * bf_hi(s0[0]));
        oa[1] = pack_bf16(acc[ib][4 * gq + 2] * rs * g4.z * bf_lo(s1[0]), acc[ib][4 * gq + 3] * rs * g4.w * bf_hi(s1[0]));
      }
      {
        const int gq = 2 * pq + 1, e = 32 * wave + 8 * gq + 4 * h;
        const float4 g4 = *(const float4*)(gn + e);
        ob[0] = pack_bf16(acc[ib][4 * gq + 0] * rs * g4.x * bf_lo(s0[1]), acc[ib][4 * gq + 1] * rs * g4.y * bf_hi(s0[1]));
        ob[1] = pack_bf16(acc[ib][4 * gq + 2] * rs * g4.z * bf_lo(s1[1]), acc[ib][4 * gq + 3] * rs * g4.w * bf_hi(s1[1]));
      }
      const auto r0 = __builtin_amdgcn_permlane32_swap(oa[0], ob[0], false, false);
      const auto r1 = __builtin_amdgcn_permlane32_swap(oa[1], ob[1], false, false);
      u32x4 st; st[0] = r0[0]; st[1] = r1[0]; st[2] = r0[1]; st[3] = r1[1];
      *(u32x4*)(Y + m * 2048 + 1024 + hh * 256 + e16) = st;
    }
  __syncthreads();
}

__device__ const double kInvFreq[32] = {1.0, 0.7498942093324559, 0.5623413251903491, 0.4216965034285822, 0.31622776601683794, 0.23713737056616552, 0.1778279410038923, 0.1333521432163324, 0.1, 0.07498942093324558, 0.05623413251903491, 0.042169650342858224, 0.03162277660168379, 0.023713737056616554, 0.01778279410038923, 0.01333521432163324, 0.01, 0.007498942093324558, 0.005623413251903491, 0.004216965034285823, 0.0031622776601683794, 0.0023713737056616554, 0.0017782794100389228, 0.001333521432163324, 0.001, 0.0007498942093324559, 0.0005623413251903491, 0.00042169650342858224, 0.00031622776601683794, 0.00023713737056616554, 0.00017782794100389227, 0.0001333521432163324};

#define XB_TMO      128
#define XB_XCNT(j)  (256  + 64 * (j))
#define XB_XSUB(j)  (1280 + 64 * (j))
#define XB_XGEN(j)  (2304 + 64 * (j))
#define XB_TOP      3328
#define XB_TOPGEN   3392
#define XCD_BAR_WORDS 3456
#define XB_SPIN_CAP (1u << 20)
#define LAS __attribute__((address_space(3)))
DI unsigned xb_ld(unsigned* p)              { return __hip_atomic_load(p, __ATOMIC_RELAXED, __HIP_MEMORY_SCOPE_AGENT); }
DI unsigned xb_add(unsigned* p, unsigned v) { return __hip_atomic_fetch_add(p, v, __ATOMIC_RELAXED, __HIP_MEMORY_SCOPE_AGENT); }
DI unsigned xb_xcc_id() { return (unsigned)__builtin_amdgcn_s_getreg((3 << 11) | 20) & 0xFu; }
#define XB_SPIN(cond, bar) do { unsigned _sp = 0; while (cond) { __builtin_amdgcn_s_sleep(1); \
    if ((++_sp & 255u) == 0u) { if (xb_ld(&(bar)[XB_TMO])) break; if (_sp > XB_SPIN_CAP) { atomicAdd(&(bar)[XB_TMO], 1u); break; } } } } while (0)
struct XcdBarrier { unsigned* bar; unsigned x; volatile LAS unsigned* st; };
DI XcdBarrier xcd_barrier_post(unsigned* bar, volatile LAS unsigned* st) {
  XcdBarrier b; b.bar = bar; b.x = xb_xcc_id(); b.st = st;
  if (__builtin_amdgcn_workitem_id_x() == 0) (void)xb_add(&bar[XB_XCNT(b.x)], 1u);
  return b;
}
DI void xcd_barrier_complete(unsigned* bar, unsigned x, unsigned& nloc, unsigned& nx) {
  const unsigned G = gridDim.x * gridDim.y * gridDim.z;
  unsigned sum, cnt, mine, sp = 0u;
  for (;;) {
    sum = 0u; cnt = 0u; mine = 0u;
#pragma unroll
    for (unsigned j = 0; j < 16; ++j) { const unsigned c = xb_ld(&bar[XB_XCNT(j)]); sum += c; cnt += (c > 0u) ? 1u : 0u; mine = (j == x) ? c : mine; }
    if (sum == G) break;
    __builtin_amdgcn_s_sleep(1);
    if ((++sp & 255u) == 0u) { if (xb_ld(&bar[XB_TMO])) break; if (sp > XB_SPIN_CAP) { atomicAdd(&bar[XB_TMO], 1u); break; } }
  }
  nloc = mine > 0u ? mine : 1u; nx = cnt > 0u ? cnt : 1u;
}
DI void xcd_barrier(const XcdBarrier& b) {
  asm volatile("s_waitcnt vmcnt(0)" ::: "memory");
  __syncthreads();
  if (__builtin_amdgcn_workitem_id_x() == 0) {
    unsigned* bar = b.bar;
    __builtin_amdgcn_s_waitcnt(0);
    unsigned nloc = b.st[0], nx = b.st[1];
    if (nloc == 0u) { xcd_barrier_complete(bar, b.x, nloc, nx); b.st[0] = nloc; b.st[1] = nx; }
    const unsigned old = xb_add(&bar[XB_XSUB(b.x)], 1u);
    const unsigned gen = old / nloc;
    if (old + 1u == (gen + 1u) * nloc) {
      __builtin_amdgcn_fence(__ATOMIC_RELEASE, "agent");
      asm volatile("s_waitcnt vmcnt(0)" ::: "memory");
      const unsigned og = xb_add(&bar[XB_TOP], 1u);
      const unsigned tg = og / nx;
      if (og + 1u == (tg + 1u) * nx) xb_add(&bar[XB_TOPGEN], 1u);
      else XB_SPIN(xb_ld(&bar[XB_TOPGEN]) == tg, bar);
      __builtin_amdgcn_fence(__ATOMIC_ACQUIRE, "agent");
      xb_add(&bar[XB_XGEN(b.x)], 1u);
      asm volatile("s_waitcnt vmcnt(0)" ::: "memory");
    } else {
      XB_SPIN(xb_ld(&bar[XB_XGEN(b.x)]) == gen, bar);
      __builtin_amdgcn_fence(__ATOMIC_ACQUIRE, "agent");
      asm volatile("s_waitcnt vmcnt(0)" ::: "memory");
    }
  }
  __syncthreads();
}

constexpr int WG_LD = 2052;

DI GemmT gt_init(int K) {
  GemmT g;
  g.A = nullptr; g.B = nullptr; g.K = K; g.lda = K; g.ldb = K;
  g.mode = M_BF16; g.R0 = 0; g.C0 = 0; g.ld = 0; g.aux = 0; g.nact = 256; g.probe = 0; g.perm = 0;
  g.d16 = nullptr; g.d32 = nullptr; g.scale = 1.f; g.rs = nullptr; g.xin = nullptr; g.cs = nullptr; g.sn = nullptr;
  return g;
}

DI void tile_map(int t, int TN, int& tm, int& tn) {
  const int b = t & 255, k = t >> 8;
  const int x = b & 7, j = b >> 3;
  const int G = k * 8 + x;
  const int gpr = TN >> 2;
  const int gm = G / gpr, gn = G - gm * gpr;
  tm = gm * 8 + (j >> 2); tn = gn * 4 + (j & 3);
}

DI void phase_prep(const Params& p, int L, unsigned char* smem) {
  const bool even = (L & 1) == 0;
  const int li = L >> 1;
  u16* WL = (u16*)(p.ws + OFF_WL);
  float* lds = (float*)smem;
  if (L == 0) {
    float* cs = (float*)(p.ws + OFF_COS);
    float* sn = (float*)(p.ws + OFF_SIN);
    for (int i = blockIdx.x * 512 + TIDX(); i < T_ * 32; i += gridDim.x * 512) {
      const int m = i >> 5, f = i & 31;
      const double ang = (double)p.pos[m] * kInvFreq[f];
      const double t = ang * 0.63661977236758134308;
      const double kq = rint(t);
      const double rr = (t - kq) * 1.57079632679489661923;
      const int qd = (int)((long long)kq & 3);
      const double r2 = rr * rr;
      const double sr = rr * (1.0 - r2 / 6.0 * (1.0 - r2 / 20.0 * (1.0 - r2 / 42.0 * (1.0 - r2 / 72.0 * (1.0 - r2 / 110.0 * (1.0 - r2 / 156.0))))));
      const double cr = 1.0 - r2 / 2.0 * (1.0 - r2 / 12.0 * (1.0 - r2 / 30.0 * (1.0 - r2 / 56.0 * (1.0 - r2 / 90.0 * (1.0 - r2 / 132.0 * (1.0 - r2 / 182.0))))));
      const double cc = (qd == 0) ? cr : (qd == 1) ? -sr : (qd == 2) ? -cr : sr;
      const double sv = (qd == 0) ? sr : (qd == 1) ? cr : (qd == 2) ? -sr : -cr;
      cs[i] = (float)cc;
      sn[i] = (float)sv;
    }
  }
  if (even) {
    const float* win = p.w_in_even + (size_t)li * 2048 * 7184;
    const float* wout = p.w_out_even + (size_t)li * 2048 * 2048;
    const int n1 = 28 * 32, n2 = 8 * 32;
    for (int t = blockIdx.x; t < n1 + n2; t += gridDim.x) {
      if (t < n1) convert_tile256(win, 7184, nullptr, WL + WE_IN, 2048, (t & 31) * 64, (t >> 5) * 256, 0, lds);
      else { const int u = t - n1; convert_tile256(wout, 2048, nullptr, WL + WE_OUT, 2048, (u & 31) * 64, (u >> 5) * 256, 0, lds); }
    }
  } else {
    const float* win = p.w_in_odd + (size_t)li * 2048 * 3136;
    const float* wq = p.w_q_up + (size_t)li * 512 * 3072;
    const float* wkv = p.w_kv_up + (size_t)li * 512 * 4096;
    const float* wout = p.w_out_odd + (size_t)li * 2048 * 2048;
    const int n1 = 13 * 32, n2 = 12 * 8, n3 = 16 * 8, n4 = 8 * 32;
    for (int t = blockIdx.x; t < n1 + n2 + n3 + n4; t += gridDim.x) {
      if (t < n1) convert_tile256(win, 3136, nullptr, WL + WO_IN, 2048, (t & 31) * 64, (t >> 5) * 256, 1, lds);
      else if (t < n1 + n2) { const int u = t - n1; convert_tile256(wq, 3072, p.q_norm + (size_t)li * 512, WL + WO_Q, 512, (u & 7) * 64, (u >> 3) * 256, 2, lds); }
      else if (t < n1 + n2 + n3) { const int u = t - n1 - n2; convert_tile256(wkv, 4096, p.kv_norm + (size_t)li * 512, WL + WO_KV, 512, (u & 7) * 64, (u >> 3) * 256, 3, lds); }
      else { const int u = t - n1 - n2 - n3; convert_tile256(wout, 2048, nullptr, WL + WO_OUT, 2048, (u & 31) * 64, (u >> 5) * 256, 0, lds); }
    }
  }
  const float* xin = (L == 0) ? p.x : p.out;
  const float* g = even ? (p.ln_even + (size_t)li * 2048) : (p.ln_odd + (size_t)li * 2048);
  u16* H = (u16*)(p.ws + OFF_H);
  const int wave = TIDX() >> 6;
  if (even) {
    const float* wsrc = p.w_in_even + (size_t)li * 2048 * 7184 + 7168;
    const int tid = TIDX();
    for (int idx = tid; idx < 2048 * 16; idx += 512) {
      const int k = idx >> 4, c = idx & 15;
      lds[c * WG_LD + k] = wsrc[(size_t)k * 7184 + c];
    }
    __syncthreads();
    float* GA = (float*)(p.ws + E_GA);
    for (int row = blockIdx.x * 8 + wave; row < T_; row += gridDim.x * 8)
      norm_row<true>(xin + (size_t)row * 2048, g, H + (size_t)row * 2048, nullptr, lds, GA + (size_t)row * 16);
    __syncthreads();
  } else {
    for (int row = blockIdx.x * 8 + wave; row < T_; row += gridDim.x * 8)
      norm_row<false>(xin + (size_t)row * 2048, g, H + (size_t)row * 2048, nullptr, nullptr, nullptr);
  }
}

DI void phase_gemm_in_even(const Params& p, unsigned char* smem, int probe) {
  const u16* WL = (const u16*)(p.ws + OFF_WL);
  const u16* H = (const u16*)(p.ws + OFF_H);
  const int NT = 28;
  for (int t = blockIdx.x; t < 64 * NT; t += gridDim.x) {
    int tm, tn; tile_map(t, NT, tm, tn);
    GemmT g = gt_init(2048);
    const u16* Wt = WL + WE_IN + (size_t)tn * 256 * 2048;
    const u16* Ht = H + (size_t)tm * 256 * 2048;
    const bool trans = (tn >= 8 && tn < 12) || (tn >= 20 && tn < 24);
    if (trans) { g.A = Ht; g.B = Wt; g.R0 = tm * 256; } else { g.A = Wt; g.B = Ht; g.C0 = tm * 256; }
    if (tn < 4)       { g.mode = M_BF16; g.d16 = (u16*)(p.ws + E_SQ); g.ld = 1024; g.R0 = tn * 256; g.scale = 0.08838834764831845f * 1.4426950408889634f; }
    else if (tn < 8)  { g.mode = M_BF16; g.d16 = (u16*)(p.ws + E_SK); g.ld = 1024; g.R0 = (tn - 4) * 256; }
    else if (tn < 12) { g.mode = M_TRANS; g.d16 = (u16*)(p.ws + E_SVT); g.aux = 1024; g.C0 = (tn - 8) * 256; g.perm = 1; }
    else if (tn < 16) { g.mode = M_SILU; g.d16 = (u16*)(p.ws + E_SG); g.ld = 1024; g.R0 = (tn - 12) * 256; }
    else if (tn < 18) { g.mode = M_BF16; g.d16 = (u16*)(p.ws + E_GQ); g.ld = 512; g.R0 = (tn - 16) * 256; }
    else if (tn < 20) { g.mode = M_BF16; g.d16 = (u16*)(p.ws + E_GK); g.ld = 512; g.R0 = (tn - 18) * 256; }
    else if (tn < 24) { g.mode = M_TRANS; g.d16 = (u16*)(p.ws + E_GVT); g.aux = 1024; g.C0 = (tn - 20) * 256; }
    else              { g.mode = M_SILU; g.d16 = (u16*)(p.ws + E_GG); g.ld = 1024; g.R0 = (tn - 24) * 256; }
    g.probe = probe;
    gemm_tile8(g, smem);
  }
}

DI void phase_gemm_in_odd(const Params& p, unsigned char* smem) {
  const u16* WL = (const u16*)(p.ws + OFF_WL);
  const u16* H = (const u16*)(p.ws + OFF_H);
  const int NT = 12;
  for (int t = blockIdx.x; t < 64 * NT; t += gridDim.x) {
    int tm, tn; tile_map(t, NT, tm, tn);
    GemmT g = gt_init(2048);
    g.A = WL + WO_IN + (size_t)tn * 256 * 2048;
    g.B = H + (size_t)tm * 256 * 2048;
    g.C0 = tm * 256;
    if (tn < 2)      { g.mode = M_BF16; g.d16 = (u16*)(p.ws + O_QL); g.ld = 512; g.R0 = tn * 256; }
    else if (tn < 4) { g.mode = M_BF16; g.d16 = (u16*)(p.ws + O_KVL); g.ld = 512; g.R0 = (tn - 2) * 256; }
    else             { g.mode = M_SILU; g.d16 = (u16*)(p.ws + O_GATE); g.ld = 2048; g.R0 = (tn - 4) * 256; }
    gemm_tile8(g, smem);
  }
}

DI void phase_rstd_kr(const Params& p, unsigned char* smem) {
  for (int t = blockIdx.x; t < 64; t += gridDim.x) {
    GemmT g = gt_init(2048);
    g.A = (const u16*)(p.ws + OFF_WL) + WO_IN + (size_t)3072 * 2048;
    g.B = (const u16*)(p.ws + OFF_H) + (size_t)t * 256 * 2048;
    g.R0 = 0; g.C0 = t * 256; g.nact = 64; g.aux = 64;
    g.mode = M_ROPE; g.d16 = (u16*)(p.ws + O_KR); g.ld = 64;
    g.cs = (const float*)(p.ws + OFF_COS); g.sn = (const float*)(p.ws + OFF_SIN);
    gemm_tile8<true>(g, smem);
  }
  const u16* QL = (const u16*)(p.ws + O_QL);
  const u16* KVL = (const u16*)(p.ws + O_KVL);
  float* RSQ = (float*)(p.ws + O_RSQ);
  float* RSKV = (float*)(p.ws + O_RSKV);
  const int wave = TIDX() >> 6, lane = TIDX() & 63;
  for (int row = blockIdx.x * 8 + wave; row < 2 * T_; row += gridDim.x * 8) {
    const int m = row >> 1;
    const u16* src = (row & 1) ? KVL : QL;
    const u32x4 v = *(const u32x4*)(src + (size_t)m * 512 + lane * 8);
    float ss = 0.f;
#pragma unroll
    for (int q = 0; q < 4; ++q) { const float a = bf_lo(v[q]), b = bf_hi(v[q]); ss += a * a + b * b; }
    ss = wave_sum(ss);
    if (lane == 0) ((row & 1) ? RSKV : RSQ)[m] = rsqrtf(ss * (1.f / 512.f) + 1e-6f);
  }
}

DI void phase_gemm_up(const Params& p, unsigned char* smem) {
  const u16* WL = (const u16*)(p.ws + OFF_WL);
  const u16* QL = (const u16*)(p.ws + O_QL);
  const u16* KVL = (const u16*)(p.ws + O_KVL);
  const float* RSQ = (const float*)(p.ws + O_RSQ);
  const float* RSKV = (const float*)(p.ws + O_RSKV);
  const float qscale = 0.07216878364870322f * 1.4426950408889634f;
  const int NT = 28;
  for (int t = blockIdx.x; t < 64 * NT; t += gridDim.x) {
    int tm, tn; tile_map(t, NT, tm, tn);
    GemmT g = gt_init(512);
    if (tn < 8) {
      g.A = WL + WO_Q + (size_t)tn * 256 * 512; g.B = QL + (size_t)tm * 256 * 512;
      g.mode = M_BF16; g.d16 = (u16*)(p.ws + O_QN); g.ld = 2048; g.R0 = tn * 256; g.C0 = tm * 256; g.rs = RSQ; g.scale = qscale;
    } else if (tn < 12) {
      g.A = WL + WO_Q + (size_t)(2048 + (tn - 8) * 256) * 512; g.B = QL + (size_t)tm * 256 * 512;
      g.mode = M_ROPE; g.d16 = (u16*)(p.ws + O_QR); g.ld = 1024; g.R0 = (tn - 8) * 256; g.C0 = tm * 256; g.aux = 256; g.rs = RSQ; g.scale = qscale;
      g.cs = (const float*)(p.ws + OFF_COS); g.sn = (const float*)(p.ws + OFF_SIN);
    } else if (tn < 20) {
      g.A = WL + WO_KV + (size_t)(tn - 12) * 256 * 512; g.B = KVL + (size_t)tm * 256 * 512;
      g.mode = M_BF16; g.d16 = (u16*)(p.ws + O_KN); g.ld = 2048; g.R0 = (tn - 12) * 256; g.C0 = tm * 256; g.rs = RSKV;
    } else {
      g.A = KVL + (size_t)tm * 256 * 512; g.B = WL + WO_KV + (size_t)(2048 + (tn - 20) * 256) * 512;
      g.mode = M_TRANS; g.d16 = (u16*)(p.ws + O_VT); g.aux = 2048; g.R0 = tm * 256; g.C0 = (tn - 20) * 256; g.rs = RSKV; g.perm = 1;
    }
    gemm_tile8(g, smem);
  }
}

DI void phase_gemm_out(const Params& p, int L, unsigned char* smem) {
  const bool even = (L & 1) == 0;
  const u16* WL = (const u16*)(p.ws + OFF_WL) + (even ? WE_OUT : WO_OUT);
  const u16* Y = (const u16*)(p.ws + OFF_H);
  const float* xin = (L == 0) ? p.x : p.out;
  for (int t = blockIdx.x; t < 64 * 8; t += gridDim.x) {
    int tm, tn; tile_map(t, 8, tm, tn);
    GemmT g = gt_init(2048);
    g.A = WL + (size_t)tn * 256 * 2048; g.B = Y + (size_t)tm * 256 * 2048;
    g.mode = M_RESID; g.R0 = tn * 256; g.C0 = tm * 256; g.d32 = p.out; g.xin = xin;
    gemm_tile8(g, smem);
  }
}

DI int next_item(int* ctr, int* sitem) {
  if (TIDX() == 0) *sitem = atomicAdd(ctr, 1);
  __syncthreads();
  const int it = *sitem;
  __syncthreads();
  return it;
}

DI void phase_even_mix(const Params& p, int L, int ph, unsigned char* smem, int* sitem, bool do_g1) {
  int* ctr = (int*)(p.ws + OFF_CTR) + ph;
  const int li = L >> 1;
  for (;;) {
    const int it = next_item(ctr, sitem);
    if (it >= 1536) break;
    if (it < 512) {
      const int qb = 31 - (it >> 4), bh = it & 15, b = bh >> 3, hh = bh & 7;
      const u16* SQ = (const u16*)(p.ws + E_SQ) + (size_t)b * S_ * 1024 + hh * 128;
      const u16* SK = (const u16*)(p.ws + E_SK) + (size_t)b * S_ * 1024 + hh * 128;
      const u16* SVT = (const u16*)(p.ws + E_SVT) + ((size_t)(b * 1024 + hh * 128)) * 8192;
      const u16* SG = (const u16*)(p.ws + E_SG) + (size_t)b * S_ * 1024 + hh * 128;
      u16* Y = (u16*)(p.ws + OFF_H) + (size_t)b * S_ * 2048 + hh * 128;
      attn_item<128, true, 1024, 0, 1024, 0, 1024>(SQ, nullptr, SK, nullptr, SVT, SG, Y, qb * 256, smem);
    } else {
      if (do_g1) gla_g1(p, li, it - 512, smem);
    }
  }
}

DI void phase_gla_out(const Params& p, int L, int ph, unsigned char* smem, int* sitem) {
  int* ctr = (int*)(p.ws + OFF_CTR) + ph;
  const int li = L >> 1;
  for (;;) {
    const int it = next_item(ctr, sitem);
    if (it >= 1024) break;
    gla_g3(p, li, it, smem);
  }
}

DI void mla_item(const Params& p, int bh, int qb, unsigned char* smem, int probe) {
  const int b = bh >> 4, hh = bh & 15;
  const u16* QN = (const u16*)(p.ws + O_QN) + (size_t)b * S_ * 2048 + hh * 128;
  const u16* QR = (const u16*)(p.ws + O_QR) + (size_t)b * S_ * 1024 + hh * 64;
  const u16* KN = (const u16*)(p.ws + O_KN) + (size_t)b * S_ * 2048 + hh * 128;
  const u16* KR = (const u16*)(p.ws + O_KR) + (size_t)b * S_ * 64;
  const u16* VT = (const u16*)(p.ws + O_VT) + ((size_t)(b * 2048 + hh * 128)) * 8192;
  const u16* GT = (const u16*)(p.ws + O_GATE) + (size_t)b * S_ * 2048 + hh * 128;
  u16* Y = (u16*)(p.ws + OFF_H) + (size_t)b * S_ * 2048 + hh * 128;
  attn_item<192, false, 2048, 1024, 2048, 64, 2048>(QN, QR, KN, KR, VT, GT, Y, qb * 256, smem, probe);
}

DI void phase_mla(const Params& p, int ph, unsigned char* smem, int* sitem, int probe) {
  if (gridDim.x == 256) {
    const int x = blockIdx.x & 7, j = blockIdx.x >> 3, half = j >> 4, jp = j & 15;
#pragma unroll 1
    for (int pass = 0; pass < 2; ++pass) {
      const int bh = 4 * x + 2 * pass + half;
      mla_item(p, bh, 31 - jp, smem, probe);
      mla_item(p, bh, jp, smem, probe);
    }
    return;
  }
  int* ctr = (int*)(p.ws + OFF_CTR) + 64 + (ph % 24) * 8;
  const int x = (int)(xb_xcc_id() & 7u);
  for (;;) {
    if (TIDX() == 0) {
      int it = -1;
      for (int k = 0; k < 8; ++k) {
        const int q = (x + k) & 7;
        const int v = atomicAdd(ctr + q, 1);
        if (v < 128) { it = q * 128 + v; break; }
      }
      *sitem = it;
    }
    __syncthreads();
    const int it = *sitem;
    __syncthreads();
    if (it < 0) break;
    const int q = it >> 7, v = it & 127;
    mla_item(p, 4 * q + (v >> 5), 31 - (v & 31), smem, probe);
  }
}

DI void phase_final(const Params& p) {
  const int wave = TIDX() >> 6;
  for (int row = blockIdx.x * 8 + wave; row < T_; row += gridDim.x * 8)
    norm_row<false>(p.out + (size_t)row * 2048, p.final_norm, nullptr, p.out + (size_t)row * 2048, nullptr, nullptr);
}

__global__ void __launch_bounds__(512, 2) fwd_kernel(Params p_arg, int ph0, int ph1) {
  __shared__ __attribute__((aligned(16))) unsigned char smem[SMEM_BYTES + 64];
  int& sitem = *(int*)(smem + SMEM_BYTES);
  uint4& xb_words = *(uint4*)(smem + SMEM_BYTES + 16);
  cg::grid_group grid = cg::this_grid();
  if (__builtin_amdgcn_workitem_id_x() == 0) xb_words = make_uint4(0u, 0u, 0u, 0u);
  __syncthreads();
  XcdBarrier xb = xcd_barrier_post((unsigned*)(p_arg.ws + OFF_BAR), (volatile LAS unsigned*)&xb_words);
  if (ph1 > 1000) grid.sync();
  typedef const __attribute__((address_space(4))) Params* KP;
  const KP kp0 = (KP)__builtin_amdgcn_kernarg_segment_ptr();
  for (int ph = ph0; ph < ph1; ++ph) {
   for (int rep = 0; rep < 2; ++rep) {
    if (rep == 1) { if (!((REPEAT_MASK >> ph) & 1)) break; xcd_barrier(xb); }
    const int cph = ph + 32 * rep;
    KP kq = kp0;
    asm volatile("" : "+s"(kq));
    const Params& p = *(const Params*)kq;
    if (ph == 24) {
      phase_final(p);
    } else {
      const int L = ph / 6, sub = ph % 6;
      const bool even = (L & 1) == 0;
      if (sub == 0) { if (PH_MASK & 1) phase_prep(p, L, smem); }
      else if (sub == 1) { if (even) { if (PH_MASK & 2) phase_gemm_in_even(p, smem, rep); } else { if (PH_MASK & 4) phase_gemm_in_odd(p, smem); } }
      else if (sub == 2) { if (even) { if (PH_MASK & 8) phase_even_mix(p, L, cph, smem, &sitem, rep == 0); } else { if (PH_MASK & 16) phase_rstd_kr(p, smem); } }
      else if (sub == 3) { if (even) { if (PH_MASK & 32) gla_scan(p); } else { if (PH_MASK & 64) phase_gemm_up(p, smem); } }
      else if (sub == 4) { if (even) { if (PH_MASK & 128) phase_gla_out(p, L, cph, smem, &sitem); } else { if (PH_MASK & 256) phase_mla(p, cph, smem, &sitem, rep); } }
      else { if (PH_MASK & 512) phase_gemm_out(p, L, smem); }
    }
   }
    if (ph + 1 < ph1) xcd_barrier(xb);
  }
}

extern "C" void kernel_launch(void* const* d_in, const int* in_sizes, int n_in, void* d_out, int out_size,
                              void* d_ws, size_t ws_size, hipStream_t stream) {
  static int grid_blocks = 0;
  if (!grid_blocks) {
    int dev = 0, cus = 0, per_cu = 0;
    (void)hipGetDevice(&dev);
    (void)hipDeviceGetAttribute(&cus, hipDeviceAttributeMultiprocessorCount, dev);
    (void)hipOccupancyMaxActiveBlocksPerMultiprocessor(&per_cu, fwd_kernel, 512, 0);
    if (per_cu < 1) per_cu = 1;
    if (per_cu > 1) per_cu = 1;
    grid_blocks = cus * per_cu;
  }
  if (ws_size < WS_NEED) { fprintf(stderr, "workspace too small: %zu\n", ws_size); return; }
  Params p{};
  p.x = (const float*)d_in[0]; p.pos = (const int*)d_in[1];
  p.ln_even = (const float*)d_in[2]; p.w_in_even = (const float*)d_in[3];
  p.alpha_up = (const float*)d_in[4]; p.alpha_bias = (const float*)d_in[5];
  p.gla_norm = (const float*)d_in[6]; p.w_out_even = (const float*)d_in[7];
  p.ln_odd = (const float*)d_in[8]; p.w_in_odd = (const float*)d_in[9];
  p.q_norm = (const float*)d_in[10]; p.w_q_up = (const float*)d_in[11];
  p.kv_norm = (const float*)d_in[12]; p.w_kv_up = (const float*)d_in[13];
  p.w_out_odd = (const float*)d_in[14]; p.final_norm = (const float*)d_in[15];
  p.out = (float*)d_out; p.ws = (unsigned char*)d_ws;
  (void)hipMemsetAsync((unsigned char*)d_ws + OFF_CTR, 0, 16384, stream);
  int a0 = 0, a1 = NPHASE;
  void* args[] = {&p, &a0, &a1};
  hipError_t e = hipLaunchCooperativeKernel((void*)fwd_kernel, dim3(grid_blocks), dim3(512), args, 0, stream);
  if (e != hipSuccess) fprintf(stderr, "cooperative launch failed: %s (grid %d)\n", hipGetErrorString(e), grid_blocks);
}
```
